# Optimizing an MI355X kernel written in HIP

```python
import math
import jax, jax.numpy as jnp
from jax import lax
import numpy as np

D_MODEL = 1024
BATCH = 16
SEQ = 2048
DEPTH = 1

GRID_W = 64
CTX_LEN = 256
EPS = 1e-6
N_MOD = 6

GLA_HEADS = 4
GLA_DK = D_MODEL // 2
GLA_DV = D_MODEL
GLA_HEAD_K = GLA_DK // GLA_HEADS
GLA_HEAD_V = GLA_DV // GLA_HEADS
GLA_GATE_RANK = 16
GLA_GATE_NORM = 16.0
GLA_CHUNK = 64

HY_WIDTH = D_MODEL
HY_SHORT = 3
HY_EMB = 33
HY_ORDER = 64
HY_FAST_DECAY = 0.3
HY_SLOW_DECAY = 1.5
HY_TARGET = 1e-2

N_EXPERTS = 32
TOP_K = 4
D_FF = D_MODEL
SWIGLU_LIMIT = 7.0
SWIGLU_ALPHA = 1.702

IN_SIZES = (GLA_DK, GLA_DK, GLA_DV, GLA_DV, GLA_GATE_RANK, GLA_GATE_RANK, 3 * HY_WIDTH, D_MODEL, D_MODEL)
IN_COLS = GLA_DK * 2 + GLA_DV * 2 + GLA_GATE_RANK * 2 + 3 * HY_WIDTH + 2 * D_MODEL

kernel_name = "hybrid_gla_hyena_moe_dit_block"


def rms_norm(x, w):
    xf = x.astype(jnp.float32)
    y = xf * lax.rsqrt(jnp.mean(xf * xf, axis=-1, keepdims=True) + EPS)
    return (y * w.astype(jnp.float32)).astype(x.dtype)


def ada_params(cvec, w_ada, b_ada):
    m = jax.nn.silu(cvec) @ w_ada + b_ada
    return jnp.split(m[:, None, :], N_MOD, axis=-1)


def split_proj(p):
    idx = np.cumsum(np.array(IN_SIZES))[:-1].tolist()
    return jnp.split(p, idx, axis=-1)


def gla_scan(q, k, v, log_g, s0):
    B, H, L, dk = q.shape
    dv = v.shape[-1]
    n = L // GLA_CHUNK
    C = GLA_CHUNK
    q = q.reshape(B, H, n, C, dk)
    k = k.reshape(B, H, n, C, dk)
    v = v.reshape(B, H, n, C, dv)
    b = jnp.cumsum(log_g.reshape(B, H, n, C, dk), axis=3)
    b_last = b[:, :, :, -1:, :]
    q_dec = q * jnp.exp(b)
    k_inv = k * jnp.exp(-b)
    k_upd = k * jnp.exp(b_last - b)
    mask = jnp.tril(jnp.ones((C, C), dtype=bool))
    att = jnp.where(mask, jnp.einsum('bhnid,bhnjd->bhnij', q_dec, k_inv), 0.0)
    o_intra = jnp.einsum('bhnij,bhnjv->bhniv', att, v)
    upd = jnp.einsum('bhncd,bhncv->bhndv', k_upd, v)
    decay = jnp.exp(b_last[:, :, :, 0, :])

    def step(s, xs):
        q_c, dec_c, upd_c = xs
        o_c = jnp.einsum('bhcd,bhdv->bhcv', q_c, s)
        s = dec_c[..., None] * s + upd_c
        return s, o_c

    xs = (jnp.moveaxis(q_dec, 2, 0), jnp.moveaxis(decay, 2, 0), jnp.moveaxis(upd, 2, 0))
    s_final, o_inter = lax.scan(step, s0, xs)
    o = o_intra + jnp.moveaxis(o_inter, 0, 2)
    return o.reshape(B, H, L, dv), s_final


def gla_bidir(q, k, v, g_f, g_b, s0_f, s0_b):
    o_f, s_f = gla_scan(q, k, v, g_f, s0_f)
    flip = lambda t: jnp.flip(t, axis=2)
    o_b, s_b = gla_scan(flip(q), flip(k), flip(v), flip(g_b), s0_b)
    return o_f + flip(o_b), s_f, s_b


def gla_inputs(q, k, v, r_f, r_b, w_gk_f, b_gk_f, w_gk_b, b_gk_b):
    B, L, _ = q.shape
    heads = lambda t, d: jnp.moveaxis(t.astype(jnp.float32).reshape(B, L, GLA_HEADS, d), 2, 1)
    qh = heads(q, GLA_HEAD_K) * (GLA_HEAD_K ** -0.5)
    kh = heads(k, GLA_HEAD_K)
    vh = heads(v, GLA_HEAD_V)
    g_f = jax.nn.log_sigmoid((r_f @ w_gk_f + b_gk_f).astype(jnp.float32)) / GLA_GATE_NORM
    g_b = jax.nn.log_sigmoid((r_b @ w_gk_b + b_gk_b).astype(jnp.float32)) / GLA_GATE_NORM
    return qh, kh, vh, heads(g_f, GLA_HEAD_K), heads(g_b, GLA_HEAD_K)


def short_conv(u, w, b):
    L = u.shape[1]
    up = jnp.pad(u, ((0, 0), (1, 1), (0, 0)))
    return up[:, :L] * w[0] + up[:, 1:L + 1] * w[1] + up[:, 2:] * w[2] + b


def hyena_kernel(L, w1, b1, w2, b2, w3, b3, w4, freq):
    f32 = jnp.float32
    bands = (HY_EMB - 1) // 2
    pos = jnp.arange(L, dtype=f32)[:, None]
    t = pos / max(L - 1, 1)
    f = jnp.linspace(1e-4, bands - 1, bands, dtype=f32)[None]
    ang = (2.0 * math.pi / L) * pos * f
    z = jnp.concatenate([t, jnp.cos(ang), -jnp.sin(ang)], axis=-1)
    fr = freq.astype(f32)
    h = jnp.sin(fr * (z @ w1.astype(f32) + b1.astype(f32)))
    h = jnp.sin(fr * (h @ w2.astype(f32) + b2.astype(f32)))
    h = jnp.sin(fr * (h @ w3.astype(f32) + b3.astype(f32)))
    h = h @ w4.astype(f32)
    deltas = jnp.abs(jnp.linspace(math.log(HY_TARGET) / HY_SLOW_DECAY,
                                  math.log(HY_TARGET) / HY_FAST_DECAY, HY_WIDTH, dtype=f32))
    window = jnp.exp(-t * deltas[None])
    h_f = h[:, :HY_WIDTH] * window
    h_b = h[:, HY_WIDTH:] * window
    return jnp.concatenate([h_f, jnp.zeros((1, HY_WIDTH), f32), jnp.flip(h_b[1:], axis=0)], axis=0)


def long_conv_bidir(u, k2l, bias):
    L = u.shape[1]
    uf = u.astype(jnp.float32)
    spec = jnp.fft.rfft(uf, n=2 * L, axis=1) * jnp.fft.rfft(k2l, axis=0)[None]
    y = jnp.fft.irfft(spec, n=2 * L, axis=1)[:, :L]
    return y + uf * bias.astype(jnp.float32)


def hyena_branch(u3, grid_rows, lp):
    B, L, C3 = u3.shape
    if grid_rows is not None:
        uc = short_conv(u3.reshape(B * grid_rows, GRID_W, C3), lp["hy_conv_w"], lp["hy_conv_b"]).reshape(B, L, C3)
    else:
        uc = short_conv(u3, lp["hy_conv_w"], lp["hy_conv_b"])
    x0, x1, v = jnp.split(uc, 3, axis=-1)
    k2l = hyena_kernel(L, lp["hy_f_w1"], lp["hy_f_b1"], lp["hy_f_w2"], lp["hy_f_b2"],
                       lp["hy_f_w3"], lp["hy_f_b3"], lp["hy_f_w4"], lp["hy_sin_freq"])
    z = long_conv_bidir(v * x1, k2l, lp["hy_bias"])
    y = x0 * z.astype(x0.dtype)
    return y @ lp["w_hy_out"]


def mixer_pre(h, lp):
    q, k, v, og, r_f, r_b, hy, m_a, m_b = split_proj(h @ lp["w_in"])
    gla_in = gla_inputs(q, k, v, r_f, r_b, lp["w_gk_f"], lp["b_gk_f"], lp["w_gk_b"], lp["b_gk_b"])
    return gla_in, (og, hy, m_a, m_b)


def mixer_post(o_gla, rest, grid_rows, lp):
    og, hy, m_a, m_b = rest
    B, L, _ = og.shape
    o = jnp.moveaxis(o_gla, 1, 2)
    o = rms_norm(o, lp["gla_norm"]).reshape(B, L, GLA_DV).astype(og.dtype)
    branch_a = (o * jax.nn.silu(og)) @ lp["w_gla_out"]
    branch_b = hyena_branch(hy, grid_rows, lp)
    y = jax.nn.sigmoid(m_a) * branch_a + jax.nn.sigmoid(m_b) * branch_b
    return y @ lp["w_out"]


def moe(h, w_router, b_router, w_up, b_up, w_down, b_down):
    B, L, D = h.shape
    t = h.reshape(B * L, D)
    logits = (t @ w_router + b_router).astype(jnp.float32)
    top_val, top_idx = lax.top_k(logits, TOP_K)
    top_w = jax.nn.softmax(top_val, axis=-1)
    gates = jnp.einsum('nk,nke->ne', top_w, jax.nn.one_hot(top_idx, N_EXPERTS, dtype=jnp.float32))
    out = jnp.zeros((B * L, D), jnp.float32)
    for e in range(N_EXPERTS):
        u = t @ w_up[e] + b_up[e]
        glu = jnp.minimum(u[:, 0::2], SWIGLU_LIMIT)
        lin = jnp.clip(u[:, 1::2], -SWIGLU_LIMIT, SWIGLU_LIMIT)
        a = glu * jax.nn.sigmoid(SWIGLU_ALPHA * glu) * (lin + 1.0)
        out = out + gates[:, e:e + 1] * (a @ w_down[e] + b_down[e])
    return out.astype(h.dtype).reshape(B, L, D)


def setup_inputs(seed: int = 0) -> dict:
    key = jax.random.key(seed)
    ks = iter(jax.random.split(key, 40))
    nrm = lambda shape, s: jax.random.normal(next(ks), shape, jnp.float32) * s
    Dp = DEPTH
    E = N_EXPERTS
    return {
        "x": nrm((BATCH, SEQ, D_MODEL), 1.0),
        "c": nrm((BATCH, D_MODEL), 1.0),
        "ctx": nrm((BATCH, CTX_LEN, D_MODEL), 1.0),
        "c_ctx": nrm((D_MODEL,), 1.0),
        "w_ada": nrm((Dp, D_MODEL, N_MOD * D_MODEL), D_MODEL ** -0.5),
        "b_ada": nrm((Dp, N_MOD * D_MODEL), 0.02),
        "norm_mix": 1.0 + nrm((Dp, D_MODEL), 0.02),
        "norm_ffn": 1.0 + nrm((Dp, D_MODEL), 0.02),
        "w_in": nrm((Dp, D_MODEL, IN_COLS), D_MODEL ** -0.5),
        "w_gk_f": nrm((Dp, GLA_GATE_RANK, GLA_DK), GLA_GATE_RANK ** -0.5),
        "b_gk_f": nrm((Dp, GLA_DK), 0.1),
        "w_gk_b": nrm((Dp, GLA_GATE_RANK, GLA_DK), GLA_GATE_RANK ** -0.5),
        "b_gk_b": nrm((Dp, GLA_DK), 0.1),
        "gla_norm": 1.0 + nrm((Dp, GLA_HEAD_V), 0.02),
        "w_gla_out": nrm((Dp, GLA_DV, D_MODEL), GLA_DV ** -0.5),
        "hy_conv_w": nrm((Dp, HY_SHORT, 3 * HY_WIDTH), HY_SHORT ** -0.5),
        "hy_conv_b": nrm((Dp, 3 * HY_WIDTH), 0.02),
        "hy_f_w1": nrm((Dp, HY_EMB, HY_ORDER), HY_EMB ** -0.5),
        "hy_f_b1": nrm((Dp, HY_ORDER), 0.1),
        "hy_f_w2": nrm((Dp, HY_ORDER, HY_ORDER), HY_ORDER ** -0.5),
        "hy_f_b2": nrm((Dp, HY_ORDER), 0.1),
        "hy_f_w3": nrm((Dp, HY_ORDER, HY_ORDER), HY_ORDER ** -0.5),
        "hy_f_b3": nrm((Dp, HY_ORDER), 0.1),
        "hy_f_w4": nrm((Dp, HY_ORDER, 2 * HY_WIDTH), 0.02),
        "hy_sin_freq": 1.0 + nrm((Dp, HY_ORDER), 0.02),
        "hy_bias": nrm((Dp, HY_WIDTH), 0.5),
        "w_hy_out": nrm((Dp, HY_WIDTH, D_MODEL), HY_WIDTH ** -0.5),
        "w_out": nrm((Dp, D_MODEL, D_MODEL), D_MODEL ** -0.5),
        "w_router": nrm((Dp, D_MODEL, E), D_MODEL ** -0.5),
        "b_router": nrm((Dp, E), 0.01),
        "w_up": nrm((Dp, E, D_MODEL, 2 * D_FF), D_MODEL ** -0.5),
        "b_up": nrm((Dp, E, 2 * D_FF), 0.02),
        "w_down": nrm((Dp, E, D_FF, D_MODEL), D_FF ** -0.5),
        "b_down": nrm((Dp, E, D_MODEL), 0.02),
        "norm_final": 1.0 + nrm((D_MODEL,), 0.02),
    }


def reference(x, c, ctx, c_ctx, w_ada, b_ada, norm_mix, norm_ffn, w_in, w_gk_f, b_gk_f, w_gk_b, b_gk_b,
              gla_norm, w_gla_out, hy_conv_w, hy_conv_b, hy_f_w1, hy_f_b1, hy_f_w2, hy_f_b2, hy_f_w3, hy_f_b3,
              hy_f_w4, hy_sin_freq, hy_bias, w_hy_out, w_out, w_router, b_router, w_up, b_up, w_down, b_down,
              norm_final):
    params = dict(w_ada=w_ada, b_ada=b_ada, norm_mix=norm_mix, norm_ffn=norm_ffn, w_in=w_in,
                  w_gk_f=w_gk_f, b_gk_f=b_gk_f, w_gk_b=w_gk_b, b_gk_b=b_gk_b, gla_norm=gla_norm,
                  w_gla_out=w_gla_out, hy_conv_w=hy_conv_w, hy_conv_b=hy_conv_b, hy_f_w1=hy_f_w1,
                  hy_f_b1=hy_f_b1, hy_f_w2=hy_f_w2, hy_f_b2=hy_f_b2, hy_f_w3=hy_f_w3, hy_f_b3=hy_f_b3,
                  hy_f_w4=hy_f_w4, hy_sin_freq=hy_sin_freq, hy_bias=hy_bias, w_hy_out=w_hy_out, w_out=w_out,
                  w_router=w_router, b_router=b_router, w_up=w_up, b_up=b_up, w_down=w_down, b_down=b_down)
    B = x.shape[0]
    rows = x.shape[1] // GRID_W
    xc = ctx
    for i in range(DEPTH):
        lp = {name: arr[i] for name, arr in params.items()}
        last = i == DEPTH - 1
        sh1, sc1, g1, sh2, sc2, g2 = ada_params(c, lp["w_ada"], lp["b_ada"])
        csh1, csc1, cg1, csh2, csc2, cg2 = ada_params(c_ctx[None], lp["w_ada"], lp["b_ada"])

        hx = rms_norm(x, lp["norm_mix"]) * (1.0 + sc1) + sh1
        hc = rms_norm(xc, lp["norm_mix"]) * (1.0 + csc1) + csh1
        gla_x, rest_x = mixer_pre(hx, lp)
        gla_c, rest_c = mixer_pre(hc, lp)
        zero = jnp.zeros((B, GLA_HEADS, GLA_HEAD_K, GLA_HEAD_V), jnp.float32)
        o_c, s_ctx_f, s_ctx_b = gla_bidir(*gla_c, zero, zero)
        o_x, _, _ = gla_bidir(*gla_x, s_ctx_f, s_ctx_b)
        x = x + g1 * mixer_post(o_x, rest_x, rows, lp)

        hx2 = rms_norm(x, lp["norm_ffn"]) * (1.0 + sc2) + sh2
        x = x + g2 * moe(hx2, lp["w_router"], lp["b_router"], lp["w_up"], lp["b_up"], lp["w_down"], lp["b_down"])

        if not last:
            xc = xc + cg1 * mixer_post(o_c, rest_c, None, lp)
            hc2 = rms_norm(xc, lp["norm_ffn"]) * (1.0 + csc2) + csh2
            xc = xc + cg2 * moe(hc2, lp["w_router"], lp["b_router"], lp["w_up"], lp["b_up"], lp["w_down"], lp["b_down"])
    return rms_norm(x, norm_final)
```

```cpp
#include <hip/hip_runtime.h>
#include <cstdio>
#include <cstdint>

#ifndef MK_N_LAUNCHES
#define MK_N_LAUNCHES 0
#endif

namespace pg8 {
#define PG8_LAS __attribute__((address_space(3)))
typedef unsigned short bf16_t;
typedef short bf16x8 __attribute__((ext_vector_type(8)));
typedef float f32x4 __attribute__((ext_vector_type(4)));
typedef unsigned u32x4 __attribute__((ext_vector_type(4)));
constexpr int BM = 256, BK = 64, HALF = 128, HTB = HALF * BK * 2  , STAGE_BYTES = 8 * HTB, NXCD = 8, WGM = 8;

__host__ __device__ __forceinline__ int lds_byte(int r, int c) { const int st = (r >> 4) * 2 + (c >> 5), rr = r & 15, cc = c & 31, ob = rr * 64 + cc * 2; return st * 1024 + (ob ^ (((ob >> 9) & 1) << 5)); }
__host__ __device__ __forceinline__ void stage_rc(int b, int& R, int& C) { const int st = b / 1024, sb = b % 1024, swz = sb ^ (((sb >> 9) & 1) << 5); R = (st >> 1) * 16 + swz / 64; C = (st & 1) * 32 + (swz % 64) / 2; }
__host__ __device__ __forceinline__ int perm32(int rho) { const int n = rho >> 4, i = rho & 15; return 8 * (i >> 2) + 4 * n + (i & 3); }

struct Unit { int pm, pn, e; };

__device__ __forceinline__ void tile_order(int L, int nM, int nN, int& pm, int& pn) {
    const int nwg = nM * nN; int wgid = L;
    { const int q = nwg / NXCD, r = nwg % NXCD, xcd = wgid % NXCD, off = wgid / NXCD; wgid = (xcd < r ? xcd * (q + 1) : r * (q + 1) + (xcd - r) * q) + off; }
    const int nig = WGM * nN, gid = wgid / nig, fm = gid * WGM, gsz = (nM - fm) < WGM ? (nM - fm) : WGM;
    pm = fm + ((wgid % nig) % gsz); pn = (wgid % nig) / gsz;
}

__device__ __forceinline__ unsigned cvt_pk_bf16(float lo, float hi) { unsigned r; asm volatile("v_cvt_pk_bf16_f32 %0, %1, %2" : "=v"(r) : "v"(lo), "v"(hi)); return r; }

template <class Epi, class Sched, bool ALIGN_EPI = false, bool SP2 = false>
__device__ __forceinline__ void gemm_phase(PG8_LAS unsigned char* lds, const int K, const Sched& S, const Epi& E) {
    const int tid = threadIdx.x, wid = __builtin_amdgcn_readfirstlane(tid >> 6), lane = tid & 63, wr = wid >> 2, wc = wid & 3, fr = lane & 15, fq = lane >> 4;
    const int nt = K / BK;
    unsigned voffA[2], voffB[2];
#pragma unroll
    for (int i = 0; i < 2; ++i) { int R, C; stage_rc(tid * 16 + i * 8192, R, C); const int Rb = Epi::PERM ? ((R & ~31) + perm32(R & 31)) : R;
        voffA[i] = (unsigned)(R * K + C) * 2u; voffB[i] = (unsigned)(Rb * K + C) * 2u; }
    const size_t kstep = (size_t)(BK * 2);
    const size_t hstep = (size_t)HALF * K * 2;
    const size_t tstep = 2 * hstep;
    const unsigned ldsw = (unsigned)wid * 1024u;
    const int aoff = lds_byte(wr * 64 + fr, fq * 8), boff = lds_byte(wc * 32 + fr, fq * 8);
#define PG8_SA(b, h) (((b) * 2 + (h)) * HTB)
#define PG8_SB(b, h) ((4 + (b) * 2 + (h)) * HTB)
#define PG8_STAGE(bufoff, gbase, voff) do { _Pragma("unroll") for (int _i = 0; _i < 2; ++_i) \
        __builtin_amdgcn_global_load_lds((const unsigned*)((const char*)(gbase) + (voff)[_i]), (PG8_LAS unsigned*)(lds + (bufoff) + ldsw + _i * 8192), 16, 0, 0); } while (0)
#define PG8_LDA(dst, b, h) do { _Pragma("unroll") for (int m = 0; m < 4; ++m) _Pragma("unroll") for (int k = 0; k < 2; ++k) dst[m][k] = *(const PG8_LAS bf16x8*)(lds + PG8_SA(b, h) + aoff + m * 2048 + k * 1024); } while (0)
#define PG8_LDB(dst, b, h) do { _Pragma("unroll") for (int n = 0; n < 2; ++n) _Pragma("unroll") for (int k = 0; k < 2; ++k) dst[n][k] = *(const PG8_LAS bf16x8*)(lds + PG8_SB(b, h) + boff + n * 2048 + k * 1024); } while (0)
#define PG8_MMA(ai, bj, At, Bt) do { __builtin_amdgcn_s_setprio(1); _Pragma("unroll") for (int m = 0; m < 4; ++m) _Pragma("unroll") for (int n = 0; n < 2; ++n) _Pragma("unroll") for (int k = 0; k < 2; ++k) \
        acc[ai][bj][m][n] = __builtin_amdgcn_mfma_f32_16x16x32_bf16(Bt[n][k], At[m][k], acc[ai][bj][m][n], 0, 0, 0); __builtin_amdgcn_s_setprio(0); } while (0)
#define PG8_WAIT_V(n) asm volatile("s_waitcnt vmcnt(" #n ")" ::: "memory")
#define PG8_WAIT_L(n) asm volatile("s_waitcnt lgkmcnt(" #n ")" ::: "memory")
#define PG8_BAR __builtin_amdgcn_s_barrier()
#define PG8_SCHED __builtin_amdgcn_sched_barrier(0)
    Unit cur, nxt; int ui = 0;
    if (!S.next(0, cur)) return;
    f32x4 acc[2][2][4][2];
#pragma unroll
    for (int a = 0; a < 2; ++a)
#pragma unroll
        for (int b = 0; b < 2; ++b)
#pragma unroll
            for (int m = 0; m < 4; ++m)
#pragma unroll
                for (int n = 0; n < 2; ++n) acc[a][b][m][n] = (f32x4){0.f, 0.f, 0.f, 0.f};
    bf16x8 At[4][2], B0[2][2], B1[2][2];
    const char* cA = S.aptr(cur); const char* cB = S.bptr(cur);
    S.a_ready(cur);
    if constexpr (SP2) {
        PG8_STAGE(PG8_SB(0, 0), cB, voffB); PG8_STAGE(PG8_SB(0, 1), cB + hstep, voffB); PG8_STAGE(PG8_SA(0, 0), cA, voffA); PG8_STAGE(PG8_SA(0, 1), cA + hstep, voffA);
        if (wr == 1) PG8_BAR;
        PG8_WAIT_V(2); PG8_BAR;
        PG8_STAGE(PG8_SB(1, 0), cB + kstep, voffB); PG8_STAGE(PG8_SA(1, 0), cA + kstep, voffA); PG8_STAGE(PG8_SB(1, 1), cB + hstep + kstep, voffB);
        PG8_WAIT_V(6); PG8_BAR;
    } else {
        PG8_STAGE(PG8_SB(0, 0), cB, voffB); PG8_STAGE(PG8_SA(0, 0), cA, voffA); PG8_STAGE(PG8_SB(0, 1), cB + hstep, voffB); PG8_STAGE(PG8_SA(0, 1), cA + hstep, voffA);
        if (wr == 1) PG8_BAR;
        PG8_WAIT_V(4); PG8_BAR;
        PG8_STAGE(PG8_SB(1, 0), cB + kstep, voffB); PG8_STAGE(PG8_SA(1, 0), cA + kstep, voffA); PG8_STAGE(PG8_SB(1, 1), cB + hstep + kstep, voffB);
        PG8_WAIT_V(6); PG8_BAR;
    }
    for (;;) {
        const bool has_next = S.next(ui + 1, nxt);
        const char* nA = has_next ? S.aptr(nxt) : cA; const char* nB = has_next ? S.bptr(nxt) : cB;
        for (int t = 0; t < nt; t += 2) {
            const bool last = (t == nt - 2);
            const char* a1 = cA + (size_t)(t + 1) * kstep;
            const char* a2 = last ? nA : cA + (size_t)(t + 2) * kstep; const char* b2 = last ? nB : cB + (size_t)(t + 2) * kstep;
            const char* a3 = a2 + kstep; const char* b3 = b2 + kstep;
            if (last && has_next) S.a_ready(nxt);
            if constexpr (SP2) {
            PG8_LDB(B0, 0, 0); PG8_LDB(B1, 0, 1); PG8_SCHED; PG8_LDA(At, 0, 0); PG8_STAGE(PG8_SA(1, 1), a1 + hstep, voffA);
            PG8_WAIT_V(8); PG8_WAIT_L(0); PG8_BAR; PG8_MMA(0, 0, At, B0); PG8_MMA(0, 1, At, B1); PG8_BAR; PG8_SCHED;
            PG8_LDA(At, 0, 1); PG8_STAGE(PG8_SB(0, 0), b2, voffB); PG8_STAGE(PG8_SB(0, 1), b2 + hstep, voffB); PG8_STAGE(PG8_SA(0, 0), a2, voffA);
            PG8_WAIT_V(8); PG8_WAIT_L(0); PG8_BAR; PG8_MMA(1, 0, At, B0); PG8_MMA(1, 1, At, B1); PG8_BAR; PG8_SCHED;
            PG8_LDB(B0, 1, 0); PG8_LDB(B1, 1, 1); PG8_SCHED; PG8_LDA(At, 1, 0); PG8_STAGE(PG8_SA(0, 1), a2 + hstep, voffA);
            PG8_WAIT_V(8); PG8_WAIT_L(0); PG8_BAR; PG8_MMA(0, 0, At, B0); PG8_MMA(0, 1, At, B1); PG8_BAR; PG8_SCHED;
            PG8_LDA(At, 1, 1); PG8_STAGE(PG8_SB(1, 0), b3, voffB); PG8_STAGE(PG8_SB(1, 1), b3 + hstep, voffB); PG8_STAGE(PG8_SA(1, 0), a3, voffA);
            PG8_WAIT_V(8); PG8_WAIT_L(0); PG8_BAR; PG8_MMA(1, 0, At, B0); PG8_MMA(1, 1, At, B1); PG8_BAR; PG8_SCHED;
            } else {
            PG8_LDB(B0, 0, 0); PG8_SCHED; PG8_LDA(At, 0, 0); PG8_STAGE(PG8_SA(1, 1), a1 + hstep, voffA);
            PG8_WAIT_L(8); PG8_BAR; PG8_WAIT_L(0); PG8_MMA(0, 0, At, B0); PG8_BAR; PG8_SCHED;
            PG8_LDB(B1, 0, 1); PG8_STAGE(PG8_SB(0, 0), b2, voffB);
            PG8_BAR; PG8_WAIT_L(0); PG8_MMA(0, 1, At, B1); PG8_BAR;
            PG8_LDA(At, 0, 1); PG8_STAGE(PG8_SA(0, 0), a2, voffA);
            PG8_BAR; PG8_WAIT_L(0); PG8_MMA(1, 0, At, B0); PG8_BAR; PG8_SCHED;
            PG8_STAGE(PG8_SB(0, 1), b2 + hstep, voffB);
            PG8_WAIT_V(6); PG8_BAR; PG8_MMA(1, 1, At, B1); PG8_BAR;
            PG8_LDB(B0, 1, 0); PG8_SCHED; PG8_LDA(At, 1, 0); PG8_STAGE(PG8_SA(0, 1), a2 + hstep, voffA);
            PG8_WAIT_L(8); PG8_BAR; PG8_WAIT_L(0); PG8_MMA(0, 0, At, B0); PG8_BAR; PG8_SCHED;
            PG8_LDB(B1, 1, 1); PG8_STAGE(PG8_SB(1, 0), b3, voffB);
            PG8_BAR; PG8_WAIT_L(0); PG8_MMA(0, 1, At, B1); PG8_BAR;
            PG8_LDA(At, 1, 1); PG8_STAGE(PG8_SA(1, 0), a3, voffA);
            PG8_BAR; PG8_WAIT_L(0); PG8_MMA(1, 0, At, B0); PG8_BAR; PG8_SCHED;
            PG8_STAGE(PG8_SB(1, 1), b3 + hstep, voffB);
            PG8_WAIT_V(6); PG8_BAR; PG8_MMA(1, 1, At, B1); PG8_BAR;
            }
        }
        if constexpr (ALIGN_EPI) { if (wr == 0) PG8_BAR; }
        if constexpr (!Epi::AFTER_DRAIN) { E(acc, cur, wr, wc, fr, fq); S.done(cur); }
        if (!has_next) break;
#pragma unroll
        for (int a = 0; a < 2; ++a)
#pragma unroll
            for (int b = 0; b < 2; ++b)
#pragma unroll
                for (int m = 0; m < 4; ++m)
#pragma unroll
                    for (int n = 0; n < 2; ++n) acc[a][b][m][n] = (f32x4){0.f, 0.f, 0.f, 0.f};
        cur = nxt; cA = nA; cB = nB; ++ui;
        if constexpr (ALIGN_EPI) { if (wr == 1) PG8_BAR; }
    }
    PG8_WAIT_V(0);
    if constexpr (!ALIGN_EPI) { if (wr == 0) PG8_BAR; }
    PG8_BAR;
    if constexpr (Epi::AFTER_DRAIN) { E.fused(acc, cur, wr, wc, fr, fq, lds, wid, lane); S.done(cur); }
#undef PG8_SA
#undef PG8_SB
#undef PG8_STAGE
#undef PG8_LDA
#undef PG8_LDB
#undef PG8_MMA
#undef PG8_WAIT_V
#undef PG8_WAIT_L
#undef PG8_BAR
#undef PG8_SCHED
}

}

constexpr int NB = 16, SEQ = 2048, D = 1024, CTXL = 256;
constexpr int NTOK = NB * SEQ, NCTX = NB * CTXL, NROW = NTOK + NCTX;
constexpr int NT1 = 33, N1 = NT1 * 256;
constexpr int NE = 32, TOPK = 4, DFF = 1024;
constexpr int MAXTILES = 544, MAXROWS = MAXTILES * 256;
constexpr float EPS = 1e-6f;
constexpr int NWAVES = 8;
constexpr int HRL = 4104;

constexpr size_t KiB = 1024, MiB = 1u << 20;
constexpr size_t WS_CTL = 0, CTL_ZERO_BYTES = 1 * MiB;
constexpr size_t WS_MOD = 1 * MiB;
constexpr size_t WS_TOKE = 1536 * KiB, WS_TOKW = 2048 * KiB, WS_PAIRPOS = 2560 * KiB, WS_ROWTOK = 3072 * KiB, WS_ROWW = 3840 * KiB;
constexpr size_t WS_HR = 5 * MiB;
constexpr size_t WS_WB1 = 13824 * KiB;
constexpr size_t WS_WG = 30 * MiB, WS_WH = 32 * MiB, WS_WO = 34 * MiB;
constexpr size_t WS_WUP = 36 * MiB, WS_WDN = 164 * MiB;
constexpr size_t WS_HX = 228 * MiB, WS_KB = 300 * MiB, WS_VB = 336 * MiB, WS_RF = 408 * MiB, WS_QB = 408 * MiB + 4608 * KiB;
constexpr size_t WS_OG = WS_QB + 32 * MiB, WS_HY = WS_OG + 64 * MiB, WS_MA = WS_HY + 192 * MiB, WS_MB = WS_MA + 64 * MiB;
constexpr size_t WS_OF = WS_MB + 64 * MiB, WS_OB = WS_OF + 64 * MiB, WS_UT = WS_OB + 64 * MiB, WS_END = WS_UT + 64 * MiB;
constexpr size_t WS_X0C = WS_HX, WS_ZT = WS_HY, WS_GA = WS_KB, WS_YH = WS_KB + 64 * MiB, WS_YA = WS_HY, WS_YM = WS_HY + 128 * MiB;
constexpr size_t WS_H2 = WS_HX, WS_AX = 292 * MiB, WS_Y = WS_AX, WS_ACT = 564 * MiB;
static_assert(WS_WB1 + (size_t)N1 * 1024 * 2 <= WS_WG && WS_HR + (size_t)1024 * HRL * 2 <= WS_WB1, "ws map 1");
static_assert(WS_RF + (size_t)NROW * 32 * 4 <= WS_QB && WS_END <= 1024 * MiB && WS_YH + 64 * MiB <= WS_OG, "ws map 2");
static_assert(WS_ACT + (size_t)MAXROWS * 1024 * 2 <= WS_END && WS_AX + (size_t)MAXROWS * 1024 * 2 <= WS_ACT && WS_H2 + 64 * MiB <= WS_AX, "ws map 3");
static_assert(WS_ROWTOK + (size_t)MAXROWS * 4 <= WS_ROWW && WS_ROWW + (size_t)MAXROWS * 4 <= WS_HR, "ws map 4");
constexpr int CW_CNT = 64, CW_CUR = 128, CW_BAR = 4096;

constexpr int LDS_BYTES = 163840;
constexpr int LDSCTL_OFF = 159744;
constexpr int LC_BAR = 0  , LC_OFF = 8  , LC_HIST = 48  , LC_LCNT = 80  , LC_BASE = 112  , LC_T2E = 160  ;
static_assert((LC_T2E + MAXTILES) * 4 <= 4096, "LDS control area");

#define GAS __attribute__((address_space(1)))
#define LAS __attribute__((address_space(3)))
typedef unsigned short bf16;
typedef unsigned v4u __attribute__((ext_vector_type(4)));
typedef unsigned v2u __attribute__((ext_vector_type(2)));
typedef float f32x4 __attribute__((ext_vector_type(4)));
typedef float f32x16 __attribute__((ext_vector_type(16)));
typedef short bf16x8 __attribute__((ext_vector_type(8)));
#define LDS_WAIT() asm volatile("s_waitcnt lgkmcnt(0)" ::: "memory")
__device__ __forceinline__ unsigned f2bf(float f) { unsigned u = __builtin_bit_cast(unsigned, f); return (u + 0x7fffu + ((u >> 16) & 1u)) >> 16; }
__device__ __forceinline__ unsigned pk2(float lo, float hi) { return f2bf(lo) | (f2bf(hi) << 16); }
__device__ __forceinline__ float bf2f(unsigned h) { return __builtin_bit_cast(float, h << 16); }
__device__ __forceinline__ float bflo(unsigned w) { return __builtin_bit_cast(float, w << 16); }
__device__ __forceinline__ float bfhi(unsigned w) { return __builtin_bit_cast(float, w & 0xffff0000u); }
__device__ __forceinline__ float wave_sum(float v) {
#pragma unroll
    for (int o = 1; o < 64; o <<= 1) v += __shfl_xor(v, o);
    return v;
}
__device__ __forceinline__ float sigmoidf_(float x) { return __builtin_amdgcn_rcpf(1.f + __expf(-x)); }

#define XB_TMO      128
#define XB_XCNT(j)  (256  + 64 * (j))
#define XB_XSUB(j)  (1280 + 64 * (j))
#define XB_XGEN(j)  (2304 + 64 * (j))
#define XB_TOP      3328
#define XB_TOPGEN   3392
#define XCD_BAR_WORDS 3456
#define XB_SPIN_CAP (1u << 18)
__device__ __forceinline__ unsigned xb_ld(unsigned* p)              { return __hip_atomic_load(p, __ATOMIC_RELAXED, __HIP_MEMORY_SCOPE_AGENT); }
__device__ __forceinline__ unsigned xb_add(unsigned* p, unsigned v) { return __hip_atomic_fetch_add(p, v, __ATOMIC_RELAXED, __HIP_MEMORY_SCOPE_AGENT); }
__device__ __forceinline__ unsigned xb_xcc_id() { return (unsigned)__builtin_amdgcn_s_getreg((3 << 11) | 20) & 0xFu; }
#define XB_SPIN(cond, bar) do { unsigned _sp = 0; while (cond) { __builtin_amdgcn_s_sleep(1); \
    if ((++_sp & 255u) == 0u) { if (xb_ld(&(bar)[XB_TMO])) break; if (_sp > XB_SPIN_CAP) { atomicAdd(&(bar)[XB_TMO], 1u); break; } } } } while (0)
struct XcdBarrier { unsigned* bar; unsigned x; volatile LAS unsigned* st; };
__device__ __forceinline__ XcdBarrier xcd_barrier_post(unsigned* bar, volatile LAS unsigned* st) {
    XcdBarrier b; b.bar = bar; b.x = xb_xcc_id(); b.st = st;
    if (threadIdx.x == 0) (void)xb_add(&bar[XB_XCNT(b.x)], 1u);
    return b;
}
__device__ __forceinline__ void xcd_barrier_complete(unsigned* bar, unsigned x, unsigned& nloc, unsigned& nx) {
    const unsigned G = gridDim.x * gridDim.y * gridDim.z;
    unsigned sum, cnt, mine, sp = 0u;
    for (;;) {
        sum = 0u; cnt = 0u; mine = 0u;
#pragma unroll
        for (unsigned j = 0; j < 16; ++j) { const unsigned c = xb_ld(&bar[XB_XCNT(j)]); sum += c; cnt += (c > 0u) ? 1u : 0u; mine = (j == x) ? c : mine; }
        if (sum == G) break;
        __builtin_amdgcn_s_sleep(1);
        if ((++sp & 255u) == 0u) { if (xb_ld(&bar[XB_TMO])) break; if (sp > XB_SPIN_CAP) { atomicAdd(&bar[XB_TMO], 1u); break; } }
    }
    nloc = mine > 0u ? mine : 1u; nx = cnt > 0u ? cnt : 1u;
}
__device__ __forceinline__ void xcd_barrier(const XcdBarrier& b) {
    asm volatile("s_waitcnt vmcnt(0)" ::: "memory");
    __syncthreads();
    if (threadIdx.x == 0) {
        unsigned* bar = b.bar;
        __builtin_amdgcn_s_waitcnt(0);
        unsigned nloc = b.st[0], nx = b.st[1];
        if (nloc == 0u) { xcd_barrier_complete(bar, b.x, nloc, nx); b.st[0] = nloc; b.st[1] = nx; }
        const unsigned old = xb_add(&bar[XB_XSUB(b.x)], 1u);
        const unsigned gen = old / nloc;
        if (old + 1u == (gen + 1u) * nloc) {
            __builtin_amdgcn_fence(__ATOMIC_RELEASE, "agent");
            asm volatile("s_waitcnt vmcnt(0)" ::: "memory");
            const unsigned og = xb_add(&bar[XB_TOP], 1u);
            const unsigned tg = og / nx;
            if (og + 1u == (tg + 1u) * nx) xb_add(&bar[XB_TOPGEN], 1u);
            else XB_SPIN(xb_ld(&bar[XB_TOPGEN]) == tg, bar);
            __builtin_amdgcn_fence(__ATOMIC_ACQUIRE, "agent");
            xb_add(&bar[XB_XGEN(b.x)], 1u);
            asm volatile("s_waitcnt vmcnt(0)" ::: "memory");
        } else {
            XB_SPIN(xb_ld(&bar[XB_XGEN(b.x)]) == gen, bar);
            __builtin_amdgcn_fence(__ATOMIC_ACQUIRE, "agent");
            asm volatile("s_waitcnt vmcnt(0)" ::: "memory");
        }
    }
    __syncthreads();
}

struct Frame {
    LAS unsigned char* lds;
    volatile LAS unsigned* LC;
    unsigned* ctl;
    int tid, lane, wave, vcu, G;
    const float* in[35]; float* out; unsigned char* ws;
};
enum { I_X = 0, I_C, I_CTX, I_CCTX, I_WADA, I_BADA, I_NMIX, I_NFFN, I_WIN, I_WGKF, I_BGKF, I_WGKB, I_BGKB, I_GLAN, I_WGLAO, I_HCW, I_HCB, I_HW1, I_HB1, I_HW2, I_HB2, I_HW3, I_HB3,
       I_HW4, I_HFREQ, I_HBIAS, I_WHYO, I_WOUT, I_WRT, I_BRT, I_WUP, I_BUP, I_WDN, I_BDN, I_NFIN };

namespace pg8 {
struct Sched1 {
    const char* A; const char* B; int G, c;
    __device__ __forceinline__ bool next(int i, Unit& u) const {
        const int L = i * G + c; u.e = 0;
        if (L < 128 * NT1) { tile_order(L, 128, NT1, u.pm, u.pn); return true; }
        const int L2 = L - 128 * NT1; if (L2 >= 16 * 7) return false;
        u.pm = 128 + (L2 & 15); u.pn = L2 >> 4; return true;
    }
    __device__ __forceinline__ const char* aptr(const Unit& u) const { return A + (size_t)u.pm * (256 * 1024 * 2); }
    __device__ __forceinline__ const char* bptr(const Unit& u) const { return B + (size_t)u.pn * (256 * 1024 * 2); }
    __device__ __forceinline__ void a_ready(const Unit&) const {}
    __device__ __forceinline__ void done(const Unit&) const {}
};
struct SchedStd {
    const char* A; const char* B; int nM, nN, G, c;
    __device__ __forceinline__ bool next(int i, Unit& u) const {
        const int L = i * G + c; u.e = 0; if (L >= nM * nN) return false;
        tile_order(L, nM, nN, u.pm, u.pn); return true;
    }
    __device__ __forceinline__ const char* aptr(const Unit& u) const { return A + (size_t)u.pm * (256 * 1024 * 2); }
    __device__ __forceinline__ const char* bptr(const Unit& u) const { return B + (size_t)u.pn * (256 * 1024 * 2); }
    __device__ __forceinline__ void a_ready(const Unit&) const {}
    __device__ __forceinline__ void done(const Unit&) const {}
};
struct SchedMoE {
    const char* A; const char* B; int nM, nN, G, c; size_t estride; const volatile PG8_LAS unsigned* t2e;
    __device__ __forceinline__ bool next(int i, Unit& u) const {
        const int L = i * G + c; if (L >= nM * nN) { u.e = 0; return false; }
        tile_order(L, nM, nN, u.pm, u.pn); u.e = (int)t2e[u.pm]; return true;
    }
    __device__ __forceinline__ const char* aptr(const Unit& u) const { return A + (size_t)u.pm * (256 * 1024 * 2); }
    __device__ __forceinline__ const char* bptr(const Unit& u) const { return B + (size_t)u.e * estride + (size_t)u.pn * (256 * 1024 * 2); }
    __device__ __forceinline__ void a_ready(const Unit&) const {}
    __device__ __forceinline__ void done(const Unit&) const {}
};

__device__ __forceinline__ float act_apply(float x, int act) { const float s = __builtin_amdgcn_rcpf(1.f + __expf(-x)); return act == 1 ? x * s : s; }

struct Epi1 {
    static constexpr bool PERM = true, AFTER_DRAIN = false;
    bf16_t *Kb, *Vb, *Qb, *OGb, *HYb, *MAb, *MBb; float* Rf;
    __device__ __forceinline__ void operator()(const f32x4 (&acc)[2][2][4][2], const Unit& u, int wr, int wc, int fr, int fq) const {
        const int pn = u.pn; const int row0 = u.pm * BM + wr * 64 + fr;
        if (pn == 6) {
            if (wc == 0) {
#pragma unroll
                for (int ai = 0; ai < 2; ++ai)
#pragma unroll
                    for (int m = 0; m < 4; ++m) { float* rp = Rf + (size_t)(row0 + ai * HALF + m * 16) * 32 + 8 * fq;
                        *(f32x4*)rp = acc[ai][0][m][0]; *(f32x4*)(rp + 4) = acc[ai][0][m][1]; }
            }
            return;
        }
        bf16_t* dst; int ld, c0, act = 0;
        if (pn < 2) { dst = Kb; ld = 512; c0 = 256 * pn; }
        else if (pn < 6) { dst = Vb; ld = 1024; c0 = 256 * (pn - 2); }
        else if (pn < 9) { dst = Qb; ld = 512; c0 = 256 * (pn - 7); }
        else if (pn < 13) { dst = OGb; ld = 1024; c0 = 256 * (pn - 9); act = 1; }
        else if (pn < 25) { dst = HYb; ld = 3072; c0 = 256 * (pn - 13); }
        else if (pn < 29) { dst = MAb; ld = 1024; c0 = 256 * (pn - 25); act = 2; }
        else { dst = MBb; ld = 1024; c0 = 256 * (pn - 29); act = 2; }
        const int col0 = c0 + wc * 32 + 8 * fq;
#pragma unroll
        for (int ai = 0; ai < 2; ++ai)
#pragma unroll
            for (int m = 0; m < 4; ++m) { bf16_t* rowp = dst + (size_t)(row0 + ai * HALF + m * 16) * ld + col0;
#pragma unroll
                for (int bj = 0; bj < 2; ++bj) { f32x4 v0 = acc[ai][bj][m][0], v1 = acc[ai][bj][m][1];
                    if (act) {
#pragma unroll
                        for (int j = 0; j < 4; ++j) { v0[j] = act_apply(v0[j], act); v1[j] = act_apply(v1[j], act); } }
                    u32x4 w; w.x = cvt_pk_bf16(v0[0], v0[1]); w.y = cvt_pk_bf16(v0[2], v0[3]); w.z = cvt_pk_bf16(v1[0], v1[1]); w.w = cvt_pk_bf16(v1[2], v1[3]);
                    *(u32x4*)(rowp + bj * HALF) = w; } }
    }
};
__device__ __forceinline__ void unpack8(const u32x4 w, float (&f)[8]) {
    f[0] = __builtin_bit_cast(float, w.x << 16); f[1] = __builtin_bit_cast(float, w.x & 0xffff0000u); f[2] = __builtin_bit_cast(float, w.y << 16); f[3] = __builtin_bit_cast(float, w.y & 0xffff0000u);
    f[4] = __builtin_bit_cast(float, w.z << 16); f[5] = __builtin_bit_cast(float, w.z & 0xffff0000u); f[6] = __builtin_bit_cast(float, w.w << 16); f[7] = __builtin_bit_cast(float, w.w & 0xffff0000u);
}
template <int MODE> struct EpiGate {
    static constexpr bool PERM = true, AFTER_DRAIN = false;
    const bf16_t* gate; float* YA; bf16_t* YM;
    __device__ __forceinline__ void operator()(const f32x4 (&acc)[2][2][4][2], const Unit& u, int wr, int wc, int fr, int fq) const {
        const int row0 = u.pm * BM + wr * 64 + fr, col0 = u.pn * BM + wc * 32 + 8 * fq;
#pragma unroll
        for (int ai = 0; ai < 2; ++ai)
#pragma unroll
            for (int m = 0; m < 4; ++m) { const size_t ro = (size_t)(row0 + ai * HALF + m * 16) * 1024 + col0;
#pragma unroll
                for (int bj = 0; bj < 2; ++bj) { const size_t o = ro + bj * HALF;
                    float g[8]; unpack8(*(const u32x4*)(gate + o), g);
                    f32x4 v0 = acc[ai][bj][m][0], v1 = acc[ai][bj][m][1];
#pragma unroll
                    for (int j = 0; j < 4; ++j) { v0[j] *= g[j]; v1[j] *= g[4 + j]; }
                    if (MODE == 0) { *(f32x4*)(YA + o) = v0; *(f32x4*)(YA + o + 4) = v1; }
                    else { const f32x4 a0 = *(const f32x4*)(YA + o), a1 = *(const f32x4*)(YA + o + 4); v0 += a0; v1 += a1;
                        u32x4 w; w.x = cvt_pk_bf16(v0[0], v0[1]); w.y = cvt_pk_bf16(v0[2], v0[3]); w.z = cvt_pk_bf16(v1[0], v1[1]); w.w = cvt_pk_bf16(v1[2], v1[3]);
                        *(u32x4*)(YM + o) = w; } } }
    }
};
struct EpiRes {
    static constexpr bool PERM = true, AFTER_DRAIN = false;
    const float* x; const float* mod; float* out;
    __device__ __forceinline__ void operator()(const f32x4 (&acc)[2][2][4][2], const Unit& u, int wr, int wc, int fr, int fq) const {
        const int row0 = u.pm * BM + wr * 64 + fr, col0 = u.pn * BM + wc * 32 + 8 * fq;
        const float* g1 = mod + (size_t)(u.pm >> 3) * 6144 + 2048 + col0;
        f32x4 gv[2][2];
#pragma unroll
        for (int bj = 0; bj < 2; ++bj) { gv[bj][0] = *(const f32x4*)(g1 + bj * HALF); gv[bj][1] = *(const f32x4*)(g1 + bj * HALF + 4); }
#pragma unroll
        for (int ai = 0; ai < 2; ++ai)
#pragma unroll
            for (int m = 0; m < 4; ++m) { const size_t ro = (size_t)(row0 + ai * HALF + m * 16) * 1024 + col0;
#pragma unroll
                for (int bj = 0; bj < 2; ++bj) { const size_t o = ro + bj * HALF;
                    const f32x4 x0 = *(const f32x4*)(x + o), x1 = *(const f32x4*)(x + o + 4);
                    *(f32x4*)(out + o) = x0 + gv[bj][0] * acc[ai][bj][m][0]; *(f32x4*)(out + o + 4) = x1 + gv[bj][1] * acc[ai][bj][m][1]; } }
    }
};
struct EpiUp {
    static constexpr bool PERM = true, AFTER_DRAIN = false;
    const float* b_up; bf16_t* ACT;
    __device__ __forceinline__ void operator()(const f32x4 (&acc)[2][2][4][2], const Unit& u, int wr, int wc, int fr, int fq) const {
        const int row0 = u.pm * BM + wr * 64 + fr, f0 = u.pn * 128 + wc * 32 + 8 * fq;
        const float* bp = b_up + (size_t)u.e * 2048 + 2 * f0;
        f32x4 bb[4];
#pragma unroll
        for (int q = 0; q < 4; ++q) bb[q] = *(const f32x4*)(bp + 4 * q);
        float bg[8], bl[8];
#pragma unroll
        for (int q = 0; q < 4; ++q) { bg[2 * q] = bb[q][0]; bl[2 * q] = bb[q][1]; bg[2 * q + 1] = bb[q][2]; bl[2 * q + 1] = bb[q][3]; }
#pragma unroll
        for (int ai = 0; ai < 2; ++ai)
#pragma unroll
            for (int m = 0; m < 4; ++m) { bf16_t* rowp = ACT + (size_t)(row0 + ai * HALF + m * 16) * 1024 + f0;
                float r[8];
#pragma unroll
                for (int n = 0; n < 2; ++n)
#pragma unroll
                    for (int j = 0; j < 4; ++j) { float gl = acc[ai][0][m][n][j] + bg[4 * n + j], li = acc[ai][1][m][n][j] + bl[4 * n + j];
                        gl = fminf(gl, 7.f); li = fminf(fmaxf(li, -7.f), 7.f);
                        r[4 * n + j] = gl * __builtin_amdgcn_rcpf(1.f + __expf(-1.702f * gl)) * (li + 1.f); }
                u32x4 w; w.x = cvt_pk_bf16(r[0], r[1]); w.y = cvt_pk_bf16(r[2], r[3]); w.z = cvt_pk_bf16(r[4], r[5]); w.w = cvt_pk_bf16(r[6], r[7]);
                *(u32x4*)rowp = w; }
    }
};
struct EpiDown {
    static constexpr bool PERM = true, AFTER_DRAIN = false;
    const float* b_dn; const float* roww; bf16_t* Y;
    __device__ __forceinline__ void operator()(const f32x4 (&acc)[2][2][4][2], const Unit& u, int wr, int wc, int fr, int fq) const {
        const int row0 = u.pm * BM + wr * 64 + fr, col0 = u.pn * BM + wc * 32 + 8 * fq;
        const float* bp = b_dn + (size_t)u.e * 1024 + col0;
        f32x4 bv[2][2];
#pragma unroll
        for (int bj = 0; bj < 2; ++bj) { bv[bj][0] = *(const f32x4*)(bp + bj * HALF); bv[bj][1] = *(const f32x4*)(bp + bj * HALF + 4); }
#pragma unroll
        for (int ai = 0; ai < 2; ++ai)
#pragma unroll
            for (int m = 0; m < 4; ++m) { const int row = row0 + ai * HALF + m * 16; const float rw = roww[row]; bf16_t* rowp = Y + (size_t)row * 1024 + col0;
#pragma unroll
                for (int bj = 0; bj < 2; ++bj) { const f32x4 v0 = (acc[ai][bj][m][0] + bv[bj][0]) * rw, v1 = (acc[ai][bj][m][1] + bv[bj][1]) * rw;
                    u32x4 w; w.x = cvt_pk_bf16(v0[0], v0[1]); w.y = cvt_pk_bf16(v0[2], v0[3]); w.z = cvt_pk_bf16(v1[0], v1[1]); w.w = cvt_pk_bf16(v1[2], v1[3]);
                    *(u32x4*)(rowp + bj * HALF) = w; } }
    }
};
}

template <class RowMap>
__device__ __forceinline__ void p0_transpose_item(const float* W, int K, int N, bf16* WT, LAS float* scr, int item, int lane, const RowMap& rm) {
    const int nblk = N / 32, kb = item / nblk, nb = item % nblk, k0 = 64 * kb, n0 = 32 * nb;
#pragma unroll 8
    for (int i = 0; i < 32; ++i) { const int kk = 2 * i + (lane >> 5); scr[kk * 33 + (lane & 31)] = W[(size_t)(k0 + kk) * N + n0 + (lane & 31)]; }
    LDS_WAIT(); asm volatile("" ::: "memory");
    const int c = lane & 7;
#pragma unroll
    for (int j = 0; j < 4; ++j) { const int n = (lane >> 3) + 8 * j; const LAS float* s = scr + (8 * c) * 33 + n; float sc; const int drow = rm(n0 + n, sc);
        v4u o; o.x = pk2(s[0 * 33] * sc, s[1 * 33] * sc); o.y = pk2(s[2 * 33] * sc, s[3 * 33] * sc); o.z = pk2(s[4 * 33] * sc, s[5 * 33] * sc); o.w = pk2(s[6 * 33] * sc, s[7 * 33] * sc);
        *(v4u*)(WT + (size_t)drow * K + k0 + 8 * c) = o; }
    LDS_WAIT(); asm volatile("" ::: "memory");
}
struct RmId { __device__ __forceinline__ int operator()(int n, float& sc) const { sc = 1.f; return n; } };
struct RmWin {
    __device__ __forceinline__ int operator()(int n, float& sc) const {
        sc = 1.f;
        if (n < 512) { sc = 0.08838834764831845f; return 7 * 256 + n; }
        if (n < 1024) return n - 512;
        if (n < 2048) return 2 * 256 + (n - 1024);
        if (n < 3072) return 9 * 256 + (n - 2048);
        if (n < 3104) return 6 * 256 + (n - 3072);
        if (n < 6176) return 13 * 256 + (n - 3104);
        if (n < 7200) return 25 * 256 + (n - 6176);
        return 29 * 256 + (n - 7200);
    }
};
struct RmUp {
    __device__ __forceinline__ int operator()(int n, float& sc) const { sc = 1.f; const int f = n >> 1; return 256 * (f >> 7) + 128 * (n & 1) + (f & 127); }
};

__device__ __forceinline__ float hy_mlp(const Frame& F, int t) {
    const int lane = F.lane;
    const float tn = (float)t * (1.f / 2047.f);
    float zv = 0.f;
    if (lane == 0) zv = tn;
    else if (lane <= 32) { const int i = (lane - 1) & 15; const float f = 1e-4f + (float)i * ((15.f - 1e-4f) / 15.f); const float rev = (float)t * f * (1.f / 2048.f);
        zv = (lane <= 16) ? __builtin_amdgcn_cosf(rev) : -__builtin_amdgcn_sinf(rev); }
    const float fr = F.in[I_HFREQ][lane];
    const float inv2pi = 0.15915494309189535f;
    float a = F.in[I_HB1][lane];
    for (int i = 0; i < 33; ++i) a += __shfl(zv, i) * F.in[I_HW1][i * 64 + lane];
    float h = __builtin_amdgcn_sinf(fr * a * inv2pi);
    a = F.in[I_HB2][lane];
    for (int i = 0; i < 64; ++i) a += __shfl(h, i) * F.in[I_HW2][i * 64 + lane];
    h = __builtin_amdgcn_sinf(fr * a * inv2pi);
    a = F.in[I_HB3][lane];
    for (int i = 0; i < 64; ++i) a += __shfl(h, i) * F.in[I_HW3][i * 64 + lane];
    return __builtin_amdgcn_sinf(fr * a * inv2pi);
}

__device__ __forceinline__ void p0_prologue(Frame& F) {
    const int blk = blockIdx.x;
    for (int item = blk; item < 96; item += F.G) {
        LAS float* scr = (LAS float*)(F.lds + F.wave * 16384);
        const int k0 = 128 * F.wave;
        for (int idx = F.lane; idx < 17 * 128; idx += 64) { const int b = idx >> 7, kk = idx & 127;
            const float cv = (b < 16) ? F.in[I_C][b * 1024 + k0 + kk] : F.in[I_CCTX][k0 + kk];
            scr[idx] = cv * sigmoidf_(cv); }
        LDS_WAIT(); asm volatile("" ::: "memory");
        float acc[17];
#pragma unroll
        for (int b = 0; b < 17; ++b) acc[b] = 0.f;
        const float* wp = F.in[I_WADA] + (size_t)k0 * 6144 + 64 * item + F.lane;
#pragma unroll 8
        for (int kk = 0; kk < 128; ++kk) { const float wv = wp[(size_t)kk * 6144];
#pragma unroll
            for (int b = 0; b < 17; ++b) acc[b] += scr[b * 128 + kk] * wv; }
#pragma unroll
        for (int b = 0; b < 17; ++b) scr[2176 + b * 64 + F.lane] = acc[b];
        __syncthreads();
        for (int o = F.tid; o < 17 * 64; o += 512) { float s = F.in[I_BADA][64 * item + (o & 63)];
#pragma unroll
            for (int w = 0; w < 8; ++w) s += ((LAS float*)(F.lds + w * 16384))[2176 + o];
            ((float*)(F.ws + WS_MOD))[(size_t)(o >> 6) * 6144 + 64 * item + (o & 63)] = s; }
        __syncthreads();
    }
    for (int m = blk; m < 256; m += F.G) {
        LAS float* HS = (LAS float*)F.lds;
        LAS bf16* T = (LAS bf16*)(F.lds + 4096);
        { const float h3 = hy_mlp(F, 8 * m + F.wave); HS[F.wave * 64 + F.lane] = h3; }
        if (F.wave == 0) { const float h3 = hy_mlp(F, 8 * m + 8); HS[8 * 64 + F.lane] = h3; }
        __syncthreads();
        const int cidx = 256 * F.wave + 4 * F.lane;
        f32x4 acc[9];
#pragma unroll
        for (int p = 0; p < 9; ++p) acc[p] = (f32x4){0.f, 0.f, 0.f, 0.f};
        const float* w4 = F.in[I_HW4] + cidx;
#pragma unroll 4
        for (int i = 0; i < 64; ++i) { const f32x4 wv = *(const f32x4*)(w4 + (size_t)i * 2048);
#pragma unroll
            for (int p = 0; p < 9; ++p) acc[p] += HS[p * 64 + i] * wv; }
        const bool fwd = F.wave < 4;
        const float a0 = -3.0701134573253944f, a1 = -15.350567286626972f;
#pragma unroll
        for (int cc = 0; cc < 4; ++cc) { const int c = (cidx & 1023) + cc; const float delta = fabsf(a0 + (float)c * ((a1 - a0) / 1023.f));
            if (fwd) {
#pragma unroll
                for (int p = 1; p < 9; ++p) { const int t = 8 * m + p; const float val = (t < 2048) ? acc[p][cc] * __expf(-(float)t * (1.f / 2047.f) * delta) : 0.f; T[c * 8 + (8 - p)] = (bf16)f2bf(val); }
                if (m == 0) T[(1024 + c) * 8 + 0] = (bf16)f2bf(acc[0][cc] + F.in[I_HBIAS][c]);
            } else {
#pragma unroll
                for (int p = 0; p < 8; ++p) { const int t = 8 * m + p; const float val = acc[p][cc] * __expf(-(float)t * (1.f / 2047.f) * delta); if (!(m == 0 && p == 0)) T[(1024 + c) * 8 + p] = (bf16)f2bf(val); }
            }
        }
        __syncthreads();
        bf16* HR = (bf16*)(F.ws + WS_HR);
        for (int ri = F.tid; ri < 2048; ri += 512) { const int dir = ri >> 10, c = ri & 1023, g = dir ? 256 + m : 255 - m;
            *(v4u*)(HR + (size_t)c * HRL + 8 * g) = *(const LAS v4u*)(T + ri * 8); }
        if (m == 255) for (int c = F.tid; c < 1024; c += 512) *(v4u*)(HR + (size_t)c * HRL + 4096) = (v4u){0u, 0u, 0u, 0u};
        __syncthreads();
    }
    {
        LAS float* scr = (LAS float*)(F.lds + F.wave * 16384);
        const int gw = F.vcu * NWAVES + F.wave, NGW = F.G * NWAVES;
        constexpr int I_IN = 16 * 257, I_SQ = 16 * 32, I_UP = 16 * 64, I_DN = 16 * 32;
        constexpr int NITEMS = I_IN + 3 * I_SQ + NE * (I_UP + I_DN);
        for (int it = gw; it < NITEMS; it += NGW) {
            int r = it;
            if (r < I_IN) { p0_transpose_item(F.in[I_WIN], 1024, 8224, (bf16*)(F.ws + WS_WB1), scr, r, F.lane, RmWin()); continue; } r -= I_IN;
            if (r < I_SQ) { p0_transpose_item(F.in[I_WGLAO], 1024, 1024, (bf16*)(F.ws + WS_WG), scr, r, F.lane, RmId()); continue; } r -= I_SQ;
            if (r < I_SQ) { p0_transpose_item(F.in[I_WHYO], 1024, 1024, (bf16*)(F.ws + WS_WH), scr, r, F.lane, RmId()); continue; } r -= I_SQ;
            if (r < I_SQ) { p0_transpose_item(F.in[I_WOUT], 1024, 1024, (bf16*)(F.ws + WS_WO), scr, r, F.lane, RmId()); continue; } r -= I_SQ;
            if (r < NE * I_UP) { const int e = r / I_UP; p0_transpose_item(F.in[I_WUP] + (size_t)e * 1024 * 2048, 1024, 2048, (bf16*)(F.ws + WS_WUP) + (size_t)e * 2048 * 1024, scr, r % I_UP, F.lane, RmUp()); continue; } r -= NE * I_UP;
            { const int e = r / I_DN; p0_transpose_item(F.in[I_WDN] + (size_t)e * 1024 * 1024, 1024, 1024, (bf16*)(F.ws + WS_WDN) + (size_t)e * 1024 * 1024, scr, r % I_DN, F.lane, RmId()); }
        }
    }
}

__device__ __forceinline__ void p1_norm(Frame& F) {
    const int gw = F.vcu * NWAVES + F.wave, NGW = F.G * NWAVES;
    const float* mod = (const float*)(F.ws + WS_MOD);
    bf16* HX = (bf16*)(F.ws + WS_HX);
    for (int row = gw; row < NROW; row += NGW) {
        const float* xr = row < NTOK ? F.in[I_X] + (size_t)row * 1024 : F.in[I_CTX] + (size_t)(row - NTOK) * 1024;
        const int b = row < NTOK ? (row >> 11) : 16;
        const float* mb = mod + (size_t)b * 6144;
        f32x4 v[4]; float ss = 0.f;
#pragma unroll
        for (int j = 0; j < 4; ++j) { v[j] = *(const f32x4*)(xr + 4 * F.lane + 256 * j); ss += (v[j].x * v[j].x + v[j].y * v[j].y) + (v[j].z * v[j].z + v[j].w * v[j].w); }
        const float rs = __builtin_amdgcn_rsqf(wave_sum(ss) * (1.f / 1024.f) + EPS);
#pragma unroll
        for (int j = 0; j < 4; ++j) { const int col = 4 * F.lane + 256 * j;
            const f32x4 w = *(const f32x4*)(F.in[I_NMIX] + col), sh = *(const f32x4*)(mb + col), sc = *(const f32x4*)(mb + 1024 + col);
            const f32x4 y = (v[j] * rs) * w * (sc + 1.f) + sh;
            v2u o; o.x = pk2(y.x, y.y); o.y = pk2(y.z, y.w);
            *(v2u*)(HX + (size_t)row * 1024 + col) = o; }
    }
}

constexpr int GL_QD = 0, GL_KI = 17408, GL_KUT = 34816, GL_VT = 53248, GL_ATT = 71680, GL_ST = 80896, GL_RCH = 115712, GL_TOT = 119808, GL_DEC = 121856;
__device__ __forceinline__ f32x4 mfma16(bf16x8 a, bf16x8 b, f32x4 c) { return __builtin_amdgcn_mfma_f32_16x16x32_bf16(a, b, c, 0, 0, 0); }
__device__ __forceinline__ void gla_unit(Frame& F, int u) {
    const int dvh = u & 1, dir = (u >> 1) & 1, h = (u >> 2) & 3, b = u >> 4;
    const int tid = F.tid, lane = F.lane, w = F.wave, fr = lane & 15, fq = lane >> 4;
    const int d = tid & 127, rg = tid >> 7;
    LAS unsigned char* L = F.lds;
    const bf16* Qb = (const bf16*)(F.ws + WS_QB); const bf16* Kb = (const bf16*)(F.ws + WS_KB); const bf16* Vb = (const bf16*)(F.ws + WS_VB);
    const float* Rf = (const float*)(F.ws + WS_RF);
    bf16* O = (bf16*)(F.ws + (dir ? WS_OB : WS_OF));
    float wgk[16];
    { const float* wg = F.in[dir ? I_WGKB : I_WGKF] + 128 * h + d;
#pragma unroll
      for (int m = 0; m < 16; ++m) wgk[m] = wg[m * 512]; }
    const float bgk = F.in[dir ? I_BGKB : I_BGKF][128 * h + d];
    f32x4 S[8];
#pragma unroll
    for (int mt = 0; mt < 8; ++mt) S[mt] = (f32x4){0.f, 0.f, 0.f, 0.f};
    for (int i = tid; i < 34816 / 16; i += 512) *(LAS v4u*)(L + GL_ST + 16 * i) = (v4u){0u, 0u, 0u, 0u};
    __syncthreads();
    for (int s = 0; s < 36; ++s) {
        const bool isctx = s < 4;
        const int ci = isctx ? (dir ? 3 - s : s) : (dir ? 31 - (s - 4) : (s - 4));
        const int rowbase = isctx ? (NTOK + b * 256 + 64 * ci) : (b * 2048 + 64 * ci);
        if (tid < 256) { const int row = tid >> 2, part = tid & 3;
            *(LAS f32x4*)(L + GL_RCH + (row * 16 + 4 * part) * 4) = *(const f32x4*)(Rf + (size_t)(rowbase + row) * 32 + 16 * dir + 4 * part); }
        unsigned short kq[16], kk_[16], kv[16];
#pragma unroll
        for (int ii = 0; ii < 16; ++ii) { const size_t r = (size_t)(rowbase + 16 * rg + ii);
            kk_[ii] = Kb[r * 512 + 128 * h + d];
            kv[ii] = Vb[r * 1024 + 256 * h + 128 * dvh + d];
            kq[ii] = isctx ? (unsigned short)0 : Qb[r * 512 + 128 * h + d]; }
        __syncthreads();
        float g[16], tot = 0.f;
#pragma unroll
        for (int ii = 0; ii < 16; ++ii) { const LAS float* rr = (const LAS float*)(L + GL_RCH) + (16 * rg + ii) * 16; float a = bgk;
#pragma unroll
            for (int m = 0; m < 16; ++m) a += rr[m] * wgk[m];
            const float ls = fminf(a, 0.f) - __logf(1.f + __expf(-fabsf(a)));
            g[ii] = ls * (1.f / 16.f); tot += g[ii]; }
        ((LAS float*)(L + GL_TOT))[rg * 128 + d] = tot;
        __syncthreads();
        float off = 0.f, btot = 0.f;
#pragma unroll
        for (int r2 = 0; r2 < 4; ++r2) { const float tv = ((const LAS float*)(L + GL_TOT))[r2 * 128 + d]; btot += tv; if (dir ? (r2 > rg) : (r2 < rg)) off += tv; }
        float bcum[16];
        if (!dir) { float run = off;
#pragma unroll
            for (int ii = 0; ii < 16; ++ii) { run += g[ii]; bcum[ii] = run; } }
        else { float run = off;
#pragma unroll
            for (int ii = 15; ii >= 0; --ii) { run += g[ii]; bcum[ii] = run; } }
        { unsigned ku[8], vv[8];
#pragma unroll
          for (int ii = 0; ii < 16; ii += 2) {
              const float k0 = bf2f(kk_[ii]), k1 = bf2f(kk_[ii + 1]);
              ku[ii >> 1] = pk2(k0 * __expf(btot - bcum[ii]), k1 * __expf(btot - bcum[ii + 1]));
              vv[ii >> 1] = (unsigned)kv[ii] | ((unsigned)kv[ii + 1] << 16); }
          *(LAS v4u*)(L + GL_KUT + d * 144 + rg * 32) = (v4u){ku[0], ku[1], ku[2], ku[3]}; *(LAS v4u*)(L + GL_KUT + d * 144 + rg * 32 + 16) = (v4u){ku[4], ku[5], ku[6], ku[7]};
          *(LAS v4u*)(L + GL_VT + d * 144 + rg * 32) = (v4u){vv[0], vv[1], vv[2], vv[3]}; *(LAS v4u*)(L + GL_VT + d * 144 + rg * 32 + 16) = (v4u){vv[4], vv[5], vv[6], vv[7]}; }
        if (!isctx) {
#pragma unroll
            for (int ii = 0; ii < 16; ++ii) { const int i = 16 * rg + ii; const float e = __expf(bcum[ii]);
                *(LAS bf16*)(L + GL_QD + i * 272 + 2 * d) = (bf16)f2bf(bf2f(kq[ii]) * e);
                *(LAS bf16*)(L + GL_KI + i * 272 + 2 * d) = (bf16)f2bf(bf2f(kk_[ii]) * __builtin_amdgcn_rcpf(e)); }
        }
        if (rg == 0) ((LAS float*)(L + GL_DEC))[d] = __expf(btot);
        __syncthreads();
        if (!isctx) {
#pragma unroll
            for (int tt = 0; tt < 2; ++tt) { const int t = 2 * w + tt, jt = t >> 2, it = t & 3;
                f32x4 a4 = (f32x4){0.f, 0.f, 0.f, 0.f};
                const bool skip = dir ? (jt < it) : (jt > it);
                if (!skip) {
#pragma unroll
                    for (int ks = 0; ks < 4; ++ks) { const bf16x8 a = *(const LAS bf16x8*)(L + GL_KI + (16 * jt + fr) * 272 + (32 * ks + 8 * fq) * 2);
                        const bf16x8 bb = *(const LAS bf16x8*)(L + GL_QD + (16 * it + fr) * 272 + (32 * ks + 8 * fq) * 2); a4 = mfma16(a, bb, a4); }
                    const int i = 16 * it + fr;
#pragma unroll
                    for (int rgi = 0; rgi < 4; ++rgi) { const int j = 16 * jt + 4 * fq + rgi; const bool keep = dir ? (j >= i) : (j <= i); a4[rgi] = keep ? a4[rgi] : 0.f; }
                }
                v2u o; o.x = pk2(a4[0], a4[1]); o.y = pk2(a4[2], a4[3]);
                *(LAS v2u*)(L + GL_ATT + (16 * it + fr) * 144 + (16 * jt + 4 * fq) * 2) = o; }
            __syncthreads();
#pragma unroll
            for (int it = 0; it < 4; ++it) { f32x4 a4 = (f32x4){0.f, 0.f, 0.f, 0.f};
#pragma unroll
                for (int ks = 0; ks < 2; ++ks) { const bf16x8 a = *(const LAS bf16x8*)(L + GL_VT + (16 * w + fr) * 144 + (32 * ks + 8 * fq) * 2);
                    const bf16x8 bb = *(const LAS bf16x8*)(L + GL_ATT + (16 * it + fr) * 144 + (32 * ks + 8 * fq) * 2); a4 = mfma16(a, bb, a4); }
#pragma unroll
                for (int ks = 0; ks < 4; ++ks) { const bf16x8 a = *(const LAS bf16x8*)(L + GL_ST + (16 * w + fr) * 272 + (32 * ks + 8 * fq) * 2);
                    const bf16x8 bb = *(const LAS bf16x8*)(L + GL_QD + (16 * it + fr) * 272 + (32 * ks + 8 * fq) * 2); a4 = mfma16(a, bb, a4); }
                v2u o; o.x = pk2(a4[0], a4[1]); o.y = pk2(a4[2], a4[3]);
                *(v2u*)(O + (size_t)(rowbase + 16 * it + fr) * 1024 + 256 * h + 128 * dvh + 16 * w + 4 * fq) = o; }
        }
#pragma unroll
        for (int mt = 0; mt < 8; ++mt) { const f32x4 dc = *(const LAS f32x4*)(L + GL_DEC + (16 * mt + 4 * fq) * 4);
            f32x4 a4 = S[mt] * dc;
#pragma unroll
            for (int ks = 0; ks < 2; ++ks) { const bf16x8 a = *(const LAS bf16x8*)(L + GL_KUT + (16 * mt + fr) * 144 + (32 * ks + 8 * fq) * 2);
                const bf16x8 bb = *(const LAS bf16x8*)(L + GL_VT + (16 * w + fr) * 144 + (32 * ks + 8 * fq) * 2); a4 = mfma16(a, bb, a4); }
            S[mt] = a4;
            v2u o; o.x = pk2(a4[0], a4[1]); o.y = pk2(a4[2], a4[3]);
            *(LAS v2u*)(L + GL_ST + (16 * w + fr) * 272 + (16 * mt + 4 * fq) * 2) = o; }
        __syncthreads();
    }
}

__device__ __forceinline__ void hy_prep(Frame& F) {
    const bf16* HY = (const bf16*)(F.ws + WS_HY); bf16* X0C = (bf16*)(F.ws + WS_X0C); bf16* UT = (bf16*)(F.ws + WS_UT);
    const float* cw = F.in[I_HCW]; const float* cb_ = F.in[I_HCB];
    LAS unsigned char* L = F.lds;
    const int tl = F.tid >> 3, cg = F.tid & 7;
    for (int it = blockIdx.x; it < 8192; it += F.G) {
        const int b = it >> 9, gr = (it >> 4) & 31, cb = it & 15, row0 = b * 2048 + 64 * gr, c0 = 64 * cb;
        float res[3][8];
#pragma unroll
        for (int gi = 0; gi < 3; ++gi) { const int col = 1024 * gi + c0 + 8 * cg;
            const bf16* p = HY + (size_t)(row0 + tl) * 3072 + col;
            const pg8::u32x4 cur = *(const pg8::u32x4*)p;
            pg8::u32x4 prv = (pg8::u32x4){0u, 0u, 0u, 0u}, nxt = (pg8::u32x4){0u, 0u, 0u, 0u};
            if (tl > 0) prv = *(const pg8::u32x4*)(p - 3072);
            if (tl < 63) nxt = *(const pg8::u32x4*)(p + 3072);
            float fc[8], fp[8], fn[8]; pg8::unpack8(cur, fc); pg8::unpack8(prv, fp); pg8::unpack8(nxt, fn);
#pragma unroll
            for (int ch = 0; ch < 8; ++ch) res[gi][ch] = cw[col + ch] * fp[ch] + cw[3072 + col + ch] * fc[ch] + cw[6144 + col + ch] * fn[ch] + cb_[col + ch]; }
        { v4u o; o.x = pk2(res[0][0], res[0][1]); o.y = pk2(res[0][2], res[0][3]); o.z = pk2(res[0][4], res[0][5]); o.w = pk2(res[0][6], res[0][7]);
          *(v4u*)(X0C + (size_t)(row0 + tl) * 1024 + c0 + 8 * cg) = o; }
#pragma unroll
        for (int ch = 0; ch < 8; ++ch) *(LAS bf16*)(L + (8 * cg + ch) * 144 + 2 * tl) = (bf16)f2bf(res[2][ch] * res[1][ch]);
        __syncthreads();
        { const int cl = F.tid >> 3, piece = F.tid & 7;
          *(v4u*)(UT + ((size_t)(c0 + cl) * 16 + b) * 2048 + 64 * gr + 8 * piece) = *(const LAS v4u*)(L + cl * 144 + 16 * piece); }
        __syncthreads();
    }
}

constexpr int CV_UL = 0, CV_UB = 4240, CV_HC = 16 * CV_UB, CV_HS = 8208;
__device__ __forceinline__ void hy_conv(Frame& F) {
    const bf16* UT = (const bf16*)(F.ws + WS_UT); const bf16* HR = (const bf16*)(F.ws + WS_HR); bf16* ZT = (bf16*)(F.ws + WS_ZT);
    LAS unsigned char* L = F.lds;
    const int tid = F.tid, lane = F.lane, w = F.wave;
    const int r = lane & 31, hk = lane >> 5, msh = (8 - (r & 7)) & 7;
    const int abase = CV_HC + msh * CV_HS + (2048 - r + 8 * hk - msh) * 2;
    const int bbase = CV_UL + (lane & 15) * CV_UB + 64 + ((lane & 31) >> 4) * 64 + 16 * hk;
    for (int c = blockIdx.x; c < 1024; c += F.G) {
#pragma unroll
        for (int kk = 0; kk < 8; ++kk) { const int p = tid + 512 * kk, b = p >> 8, o16 = p & 255;
            *(LAS v4u*)(L + CV_UL + b * CV_UB + 64 + 16 * o16) = *(const v4u*)(UT + ((size_t)c * 16 + b) * 2048 + 8 * o16); }
        if (tid < 128) { const int b = tid >> 3, wh = (tid >> 2) & 1, q4 = tid & 3; *(LAS v4u*)(L + CV_UL + b * CV_UB + (wh ? 4160 : 0) + 16 * q4) = (v4u){0u, 0u, 0u, 0u}; }
        { const bf16* g = HR + (size_t)c * HRL + 8 * tid; const v4u v0 = *(const v4u*)g, v1 = *(const v4u*)(g + 8);
          unsigned W[8];
#pragma unroll
          for (int q = 0; q < 4; ++q) { W[q] = v0[q]; W[4 + q] = v1[q]; }
#pragma unroll
          for (int m = 0; m < 8; ++m) { v4u o;
#pragma unroll
              for (int q = 0; q < 4; ++q) o[q] = (m & 1) ? ((W[(m >> 1) + q] >> 16) | (W[(m >> 1) + q + 1] << 16)) : W[(m >> 1) + q];
              *(LAS v4u*)(L + CV_HC + m * CV_HS + 16 * tid) = o; } }
        __syncthreads();
        f32x16 acc[4];
#pragma unroll
        for (int i = 0; i < 4; ++i)
#pragma unroll
            for (int q = 0; q < 16; ++q) acc[i][q] = 0.f;
        for (int dl = 8 * w - 63; dl <= 8 * w + 7; ++dl) {
            const bf16x8 A0 = *(const LAS bf16x8*)(L + abase - 64 * dl), A1 = *(const LAS bf16x8*)(L + abase - 64 * dl + 32);
#pragma unroll
            for (int i = 0; i < 4; ++i) { const int q0 = 8 * w + 2 * i - dl;
                if (q0 >= -1 && q0 <= 63) {
                    const bf16x8 B0 = *(const LAS bf16x8*)(L + bbase + q0 * 64), B1 = *(const LAS bf16x8*)(L + bbase + q0 * 64 + 32);
                    acc[i] = __builtin_amdgcn_mfma_f32_32x32x16_bf16(A0, B0, acc[i], 0, 0, 0);
                    acc[i] = __builtin_amdgcn_mfma_f32_32x32x16_bf16(A1, B1, acc[i], 0, 0, 0); } }
        }
        { const int qs = (lane & 31) >> 4, bb = lane & 15;
#pragma unroll
          for (int i = 0; i < 4; ++i) { const int p = 8 * w + 2 * i + qs; bf16* zp = ZT + ((size_t)c * 16 + bb) * 2048 + 32 * p + 4 * hk;
#pragma unroll
              for (int g4 = 0; g4 < 4; ++g4) { v2u o; o.x = pk2(acc[i][4 * g4], acc[i][4 * g4 + 1]); o.y = pk2(acc[i][4 * g4 + 2], acc[i][4 * g4 + 3]); *(v2u*)(zp + 8 * g4) = o; } } }
        __syncthreads();
    }
}

__device__ __forceinline__ void p5_post(Frame& F) {
    const int gw = F.vcu * NWAVES + F.wave, NGW = F.G * NWAVES, lane = F.lane;
    { const bf16* Of = (const bf16*)(F.ws + WS_OF); const bf16* Ob = (const bf16*)(F.ws + WS_OB); const bf16* OG = (const bf16*)(F.ws + WS_OG); bf16* GA = (bf16*)(F.ws + WS_GA);
      const f32x4 gn = *(const f32x4*)(F.in[I_GLAN] + 4 * lane);
      for (int row = gw; row < NTOK; row += NGW) {
#pragma unroll
          for (int j = 0; j < 4; ++j) { const size_t o = (size_t)row * 1024 + 256 * j + 4 * lane;
              const v2u a = *(const v2u*)(Of + o), bb = *(const v2u*)(Ob + o), gg = *(const v2u*)(OG + o);
              f32x4 v; v.x = bflo(a.x) + bflo(bb.x); v.y = bfhi(a.x) + bfhi(bb.x); v.z = bflo(a.y) + bflo(bb.y); v.w = bfhi(a.y) + bfhi(bb.y);
              const float ss = wave_sum((v.x * v.x + v.y * v.y) + (v.z * v.z + v.w * v.w));
              const float rs = __builtin_amdgcn_rsqf(ss * (1.f / 256.f) + EPS);
              const f32x4 og = (f32x4){bflo(gg.x), bfhi(gg.x), bflo(gg.y), bfhi(gg.y)};
              const f32x4 y = (v * rs) * gn * og;
              v2u ov; ov.x = pk2(y.x, y.y); ov.y = pk2(y.z, y.w); *(v2u*)(GA + o) = ov; } } }
    { const bf16* ZT = (const bf16*)(F.ws + WS_ZT); const bf16* X0C = (const bf16*)(F.ws + WS_X0C); bf16* YH = (bf16*)(F.ws + WS_YH);
      LAS unsigned char* L = F.lds;
      for (int it = blockIdx.x; it < 8192; it += F.G) {
          const int b = it >> 9, tb = (it >> 4) & 31, cb = it & 15, row0 = b * 2048 + 64 * tb, c0 = 64 * cb;
          { const int cl = F.tid >> 3, piece = F.tid & 7;
            *(LAS v4u*)(L + cl * 144 + 16 * piece) = *(const v4u*)(ZT + ((size_t)(c0 + cl) * 16 + b) * 2048 + 64 * tb + 8 * piece); }
          __syncthreads();
          { const int tl = F.tid >> 3, cg = F.tid & 7;
            const pg8::u32x4 xv = *(const pg8::u32x4*)(X0C + (size_t)(row0 + tl) * 1024 + c0 + 8 * cg); float xf[8]; pg8::unpack8(xv, xf);
            float y[8];
#pragma unroll
            for (int ch = 0; ch < 8; ++ch) y[ch] = xf[ch] * bf2f(*(const LAS bf16*)(L + (8 * cg + ch) * 144 + 2 * tl));
            v4u o; o.x = pk2(y[0], y[1]); o.y = pk2(y[2], y[3]); o.z = pk2(y[4], y[5]); o.w = pk2(y[6], y[7]);
            *(v4u*)(YH + (size_t)(row0 + tl) * 1024 + c0 + 8 * cg) = o; }
          __syncthreads();
      } }
}

constexpr int RT_STRIDE = 1028;
__device__ __forceinline__ void p9_router(Frame& F) {
    LAS float* WR = (LAS float*)F.lds;
    for (int it = 0; it < 64; ++it) { const int idx = F.tid + 512 * it, k = idx >> 5, e = idx & 31; WR[e * RT_STRIDE + k] = F.in[I_WRT][idx]; }
    if (F.tid < 32) F.LC[LC_HIST + F.tid] = 0u;
    __syncthreads();
    const int gw = F.vcu * NWAVES + F.wave, NGW = F.G * NWAVES, lane = F.lane;
    const float* mod = (const float*)(F.ws + WS_MOD);
    bf16* H2 = (bf16*)(F.ws + WS_H2); int* toke = (int*)(F.ws + WS_TOKE); float* tokw = (float*)(F.ws + WS_TOKW);
    for (int row = gw; row < NTOK; row += NGW) {
        const float* xr = F.out + (size_t)row * 1024; const float* mb = mod + (size_t)(row >> 11) * 6144;
        f32x4 v[4]; float ss = 0.f;
#pragma unroll
        for (int j = 0; j < 4; ++j) { v[j] = *(const f32x4*)(xr + 4 * lane + 256 * j); ss += (v[j].x * v[j].x + v[j].y * v[j].y) + (v[j].z * v[j].z + v[j].w * v[j].w); }
        const float rs = __builtin_amdgcn_rsqf(wave_sum(ss) * (1.f / 1024.f) + EPS);
#pragma unroll
        for (int j = 0; j < 4; ++j) { const int col = 4 * lane + 256 * j;
            const f32x4 wv = *(const f32x4*)(F.in[I_NFFN] + col), sh = *(const f32x4*)(mb + 3072 + col), sc = *(const f32x4*)(mb + 4096 + col);
            v[j] = (v[j] * rs) * wv * (sc + 1.f) + sh;
            v2u o; o.x = pk2(v[j].x, v[j].y); o.y = pk2(v[j].z, v[j].w); *(v2u*)(H2 + (size_t)row * 1024 + col) = o; }
        float lg[32];
#pragma unroll
        for (int e = 0; e < 32; ++e) { float p = 0.f;
#pragma unroll
            for (int j = 0; j < 4; ++j) { const f32x4 wv = *(const LAS f32x4*)(WR + e * RT_STRIDE + 4 * lane + 256 * j); p += (v[j].x * wv.x + v[j].y * wv.y) + (v[j].z * wv.z + v[j].w * wv.w); }
            lg[e] = wave_sum(p) + F.in[I_BRT][e]; }
        int bi[4]; float bv[4];
#pragma unroll
        for (int k = 0; k < 4; ++k) { float best = -3.0e38f; int bidx = 0;
#pragma unroll
            for (int e = 0; e < 32; ++e) { if (lg[e] > best) { best = lg[e]; bidx = e; } }
#pragma unroll
            for (int e = 0; e < 32; ++e) lg[e] = (e == bidx) ? -3.4e38f : lg[e];
            bi[k] = bidx; bv[k] = best; }
        const float e1 = __expf(bv[1] - bv[0]), e2 = __expf(bv[2] - bv[0]), e3 = __expf(bv[3] - bv[0]); const float inv = 1.f / (1.f + e1 + e2 + e3);
        if (lane == 0) { *(int4*)(toke + (size_t)row * 4) = make_int4(bi[0], bi[1], bi[2], bi[3]); *(f32x4*)(tokw + (size_t)row * 4) = (f32x4){inv, e1 * inv, e2 * inv, e3 * inv};
#pragma unroll
            for (int k = 0; k < 4; ++k) __hip_atomic_fetch_add((LAS unsigned*)&F.LC[LC_HIST + bi[k]], 1u, __ATOMIC_RELAXED, __HIP_MEMORY_SCOPE_WORKGROUP); }
    }
    __syncthreads();
    if (F.tid < 32) atomicAdd(F.ctl + CW_CNT + F.tid, (unsigned)F.LC[LC_HIST + F.tid]);
}

__device__ __forceinline__ int moe_offsets(Frame& F) {
    __syncthreads();
    if (F.tid == 0) { unsigned o = 0;
        for (int e = 0; e < 32; ++e) { F.LC[LC_OFF + e] = o; const unsigned c = __hip_atomic_load(F.ctl + CW_CNT + e, __ATOMIC_RELAXED, __HIP_MEMORY_SCOPE_AGENT); const unsigned nt = (c + 255u) >> 8;
            for (unsigned t = 0; t < nt; ++t) F.LC[LC_T2E + (o >> 8) + t] = (unsigned)e; o += nt << 8; }
        F.LC[LC_OFF + 32] = o; }
    __syncthreads();
    return (int)(F.LC[LC_OFF + 32] >> 8);
}

__device__ __forceinline__ void p10_scatter(Frame& F) {
    (void)moe_offsets(F);
    const int* toke = (const int*)(F.ws + WS_TOKE); const float* tokw = (const float*)(F.ws + WS_TOKW);
    int* pairpos = (int*)(F.ws + WS_PAIRPOS); int* rowtok = (int*)(F.ws + WS_ROWTOK); float* roww = (float*)(F.ws + WS_ROWW);
    const bf16* H2 = (const bf16*)(F.ws + WS_H2); bf16* AX = (bf16*)(F.ws + WS_AX);
    LAS int* PP = (LAS int*)F.lds; LAS int* PT = (LAS int*)(F.lds + 2048);
    for (int chunk = blockIdx.x; chunk < 256; chunk += F.G) {
        if (F.tid < 32) F.LC[LC_LCNT + F.tid] = 0u;
        __syncthreads();
        const int tok = chunk * 128 + (F.tid >> 2), k = F.tid & 3;
        const int e = toke[(size_t)tok * 4 + k];
        const unsigned lrank = __hip_atomic_fetch_add((LAS unsigned*)&F.LC[LC_LCNT + e], 1u, __ATOMIC_RELAXED, __HIP_MEMORY_SCOPE_WORKGROUP);
        __syncthreads();
        if (F.tid < 32) F.LC[LC_BASE + F.tid] = atomicAdd(F.ctl + CW_CUR + F.tid, (unsigned)F.LC[LC_LCNT + F.tid]);
        __syncthreads();
        const int pos = (int)(F.LC[LC_OFF + e] + F.LC[LC_BASE + e] + lrank);
        rowtok[pos] = tok; roww[pos] = tokw[(size_t)tok * 4 + k]; pairpos[(size_t)tok * 4 + k] = pos;
        PP[F.tid] = pos; PT[F.tid] = tok;
        __syncthreads();
        for (int i = 0; i < 64; ++i) { const int pi = F.wave * 64 + i; const int ps = PP[pi], tk = PT[pi];
            const v4u a = *(const v4u*)(H2 + (size_t)tk * 1024 + 8 * F.lane), bq = *(const v4u*)(H2 + (size_t)tk * 1024 + 512 + 8 * F.lane);
            *(v4u*)(AX + (size_t)ps * 1024 + 8 * F.lane) = a; *(v4u*)(AX + (size_t)ps * 1024 + 512 + 8 * F.lane) = bq; }
        __syncthreads();
    }
}

__device__ __forceinline__ void p13_final(Frame& F) {
    const int gw = F.vcu * NWAVES + F.wave, NGW = F.G * NWAVES, lane = F.lane;
    const float* mod = (const float*)(F.ws + WS_MOD); const int* pairpos = (const int*)(F.ws + WS_PAIRPOS); const bf16* Y = (const bf16*)(F.ws + WS_Y);
    for (int row = gw; row < NTOK; row += NGW) {
        float* xr = F.out + (size_t)row * 1024; const float* g2 = mod + (size_t)(row >> 11) * 6144 + 5120;
        const int4 pp = *(const int4*)(pairpos + (size_t)row * 4);
        f32x4 v[4]; float ss = 0.f;
#pragma unroll
        for (int j = 0; j < 4; ++j) { const int col = 4 * lane + 256 * j;
            const v2u y0 = *(const v2u*)(Y + (size_t)pp.x * 1024 + col), y1 = *(const v2u*)(Y + (size_t)pp.y * 1024 + col), y2 = *(const v2u*)(Y + (size_t)pp.z * 1024 + col), y3 = *(const v2u*)(Y + (size_t)pp.w * 1024 + col);
            f32x4 m; m.x = (bflo(y0.x) + bflo(y1.x)) + (bflo(y2.x) + bflo(y3.x)); m.y = (bfhi(y0.x) + bfhi(y1.x)) + (bfhi(y2.x) + bfhi(y3.x));
            m.z = (bflo(y0.y) + bflo(y1.y)) + (bflo(y2.y) + bflo(y3.y)); m.w = (bfhi(y0.y) + bfhi(y1.y)) + (bfhi(y2.y) + bfhi(y3.y));
            v[j] = *(const f32x4*)(xr + col) + *(const f32x4*)(g2 + col) * m;
            ss += (v[j].x * v[j].x + v[j].y * v[j].y) + (v[j].z * v[j].z + v[j].w * v[j].w); }
        const float rs = __builtin_amdgcn_rsqf(wave_sum(ss) * (1.f / 1024.f) + EPS);
#pragma unroll
        for (int j = 0; j < 4; ++j) { const int col = 4 * lane + 256 * j; *(f32x4*)(xr + col) = (v[j] * rs) * *(const f32x4*)(F.in[I_NFIN] + col); }
    }
}

constexpr int N_PHASES = 14;
struct Args { const float* in[35]; float* out; unsigned char* ws; int ph_lo, ph_hi; };
__global__ void __launch_bounds__(NWAVES * 64, 2) fwd(Args args) {
    extern __shared__ __attribute__((aligned(16))) unsigned char lds[];
    Frame F;
    F.lds = (LAS unsigned char*)lds;
    F.LC = (volatile LAS unsigned*)(F.lds + LDSCTL_OFF);
    F.tid = threadIdx.x; F.lane = F.tid & 63; F.wave = __builtin_amdgcn_readfirstlane(F.tid >> 6);
    F.G = gridDim.x; { const int bx = blockIdx.x; F.vcu = (F.G % 8 == 0) ? (bx % 8) * (F.G / 8) + bx / 8 : bx; }
    F.ws = args.ws; F.out = args.out; F.ctl = (unsigned*)(args.ws + WS_CTL);
#pragma unroll
    for (int i = 0; i < 35; ++i) F.in[i] = args.in[i];
    for (int u = F.tid; u < (LDS_BYTES - LDSCTL_OFF) / 4; u += NWAVES * 64) ((LAS unsigned*)(F.lds + LDSCTL_OFF))[u] = 0u;
    __syncthreads();
    const int lo = args.ph_lo, hi = args.ph_hi;
    XcdBarrier bar; bar.bar = F.ctl + CW_BAR; bar.x = 0; bar.st = nullptr;
    if (hi - lo > 1) bar = xcd_barrier_post(F.ctl + CW_BAR, F.LC + LC_BAR);
#define IN(k) (lo <= (k) && (k) < hi)
#define SEAM(k) do { if (IN(k) && IN((k) + 1)) xcd_barrier(bar); } while (0)
    unsigned char* ws = args.ws;
    LAS unsigned char* ring = F.lds;

    if (IN(0)) { p0_prologue(F); } SEAM(0);
    if (IN(1)) { p1_norm(F); } SEAM(1);
    if (IN(2)) {
        pg8::Sched1 S{(const char*)(ws + WS_HX), (const char*)(ws + WS_WB1), F.G, (int)blockIdx.x};
        pg8::Epi1 E{(bf16*)(ws + WS_KB), (bf16*)(ws + WS_VB), (bf16*)(ws + WS_QB), (bf16*)(ws + WS_OG), (bf16*)(ws + WS_HY), (bf16*)(ws + WS_MA), (bf16*)(ws + WS_MB), (float*)(ws + WS_RF)};
        pg8::gemm_phase<pg8::Epi1, pg8::Sched1, true, true>(ring, 1024, S, E);
    } SEAM(2);
    if (IN(3)) { for (int u = blockIdx.x; u < 256; u += F.G) gla_unit(F, u); hy_prep(F); } SEAM(3);
    if (IN(4)) { hy_conv(F); } SEAM(4);
    if (IN(5)) { p5_post(F); } SEAM(5);
    if (IN(6)) {
        pg8::SchedStd S{(const char*)(ws + WS_GA), (const char*)(ws + WS_WG), 128, 4, F.G, (int)blockIdx.x};
        pg8::EpiGate<0> E{(const bf16*)(ws + WS_MA), (float*)(ws + WS_YA), nullptr};
        pg8::gemm_phase<pg8::EpiGate<0>, pg8::SchedStd, true, true>(ring, 1024, S, E);
    } SEAM(6);
    if (IN(7)) {
        pg8::SchedStd S{(const char*)(ws + WS_YH), (const char*)(ws + WS_WH), 128, 4, F.G, (int)blockIdx.x};
        pg8::EpiGate<1> E{(const bf16*)(ws + WS_MB), (float*)(ws + WS_YA), (bf16*)(ws + WS_YM)};
        pg8::gemm_phase<pg8::EpiGate<1>, pg8::SchedStd, true, true>(ring, 1024, S, E);
    } SEAM(7);
    if (IN(8)) {
        pg8::SchedStd S{(const char*)(ws + WS_YM), (const char*)(ws + WS_WO), 128, 4, F.G, (int)blockIdx.x};
        pg8::EpiRes E{F.in[I_X], (const float*)(ws + WS_MOD), F.out};
        pg8::gemm_phase<pg8::EpiRes, pg8::SchedStd, true, true>(ring, 1024, S, E);
    } SEAM(8);
    if (IN(9)) { p9_router(F); } SEAM(9);
    if (IN(10)) { p10_scatter(F); } SEAM(10);
    if (IN(11)) {
        const int nt = moe_offsets(F);
        pg8::SchedMoE S{(const char*)(ws + WS_AX), (const char*)(ws + WS_WUP), nt, 8, F.G, (int)blockIdx.x, (size_t)2048 * 1024 * 2, (const volatile LAS unsigned*)(F.LC + LC_T2E)};
        pg8::EpiUp E{F.in[I_BUP], (bf16*)(ws + WS_ACT)};
        pg8::gemm_phase<pg8::EpiUp, pg8::SchedMoE, true, true>(ring, 1024, S, E);
    } SEAM(11);
    if (IN(12)) {
        const int nt = moe_offsets(F);
        pg8::SchedMoE S{(const char*)(ws + WS_ACT), (const char*)(ws + WS_WDN), nt, 4, F.G, (int)blockIdx.x, (size_t)1024 * 1024 * 2, (const volatile LAS unsigned*)(F.LC + LC_T2E)};
        pg8::EpiDown E{F.in[I_BDN], (const float*)(ws + WS_ROWW), (bf16*)(ws + WS_Y)};
        pg8::gemm_phase<pg8::EpiDown, pg8::SchedMoE, true, true>(ring, 1024, S, E);
    } SEAM(12);
    if (IN(13)) { p13_final(F); }
#undef IN
#undef SEAM
}

extern "C" void kernel_launch(void* const* d_in, const int* in_sizes, int n_in, void* d_out, int out_size, void* d_ws, size_t ws_size, hipStream_t stream) {
    static int grid = 0;
    if (grid == 0) {
        if (n_in != 35 || in_sizes[0] != NTOK * D || out_size != NTOK * D || ws_size < WS_END) {
            fprintf(stderr, "kernel_launch: unexpected shapes (n_in %d, in0 %d, out %d, ws %zu < %zu); nothing launched\n", n_in, n_in > 0 ? in_sizes[0] : -1, out_size, ws_size, (size_t)WS_END); grid = -1; return; }
        int dev = 0, cus = 0, per_cu = 0;
        if (hipGetDevice(&dev) != hipSuccess || hipDeviceGetAttribute(&cus, hipDeviceAttributeMultiprocessorCount, dev) != hipSuccess) { grid = -1; return; }
        if (hipFuncSetAttribute((const void*)fwd, hipFuncAttributeMaxDynamicSharedMemorySize, LDS_BYTES) != hipSuccess) { fprintf(stderr, "kernel_launch: hipFuncSetAttribute failed\n"); grid = -1; return; }
        if (hipOccupancyMaxActiveBlocksPerMultiprocessor(&per_cu, (const void*)fwd, NWAVES * 64, LDS_BYTES) != hipSuccess || per_cu < 1)
            fprintf(stderr, "kernel_launch: note: occupancy query reports %d workgroups per CU\n", per_cu);
        (void)hipGetLastError();
        grid = cus;
    }
    if (grid < 0) return;
    if (hipMemsetAsync((char*)d_ws + WS_CTL, 0, CTL_ZERO_BYTES, stream) != hipSuccess) return;
    Args a{};
    for (int i = 0; i < 35; ++i) a.in[i] = (const float*)d_in[i];
    a.out = (float*)d_out; a.ws = (unsigned char*)d_ws;
#if MK_N_LAUNCHES == 1
    a.ph_lo = 0; a.ph_hi = N_PHASES;
    hipLaunchKernelGGL(fwd, dim3(grid), dim3(NWAVES * 64), LDS_BYTES, stream, a);
#else
    for (int k = 0; k < N_PHASES; ++k) { a.ph_lo = k; a.ph_hi = k + 1; hipLaunchKernelGGL(fwd, dim3(grid), dim3(NWAVES * 64), LDS_BYTES, stream, a); }
#endif
}
```

```cpp
#include <hip/hip_runtime.h>
#include <cstdio>
#include <cstdint>

#ifndef MK_N_LAUNCHES
#define MK_N_LAUNCHES 1
#endif
#ifndef SCAN_DUP
#define SCAN_DUP 0
#endif
#ifndef PROBE_PHASE
#define PROBE_PHASE -1
#endif

namespace pg8 {
#define PG8_LAS __attribute__((address_space(3)))
typedef unsigned short bf16_t;
typedef short bf16x8 __attribute__((ext_vector_type(8)));
typedef float f32x4 __attribute__((ext_vector_type(4)));
typedef unsigned u32x4 __attribute__((ext_vector_type(4)));
constexpr int BM = 256, BK = 64, HALF = 128, HTB = HALF * BK * 2  , STAGE_BYTES = 8 * HTB, NXCD = 8, WGM = 8;

__host__ __device__ __forceinline__ int lds_byte(int r, int c) { const int st = (r >> 4) * 2 + (c >> 5), rr = r & 15, cc = c & 31, ob = rr * 64 + cc * 2; return st * 1024 + (ob ^ (((ob >> 9) & 1) << 5)); }
__host__ __device__ __forceinline__ void stage_rc(int b, int& R, int& C) { const int st = b / 1024, sb = b % 1024, swz = sb ^ (((sb >> 9) & 1) << 5); R = (st >> 1) * 16 + swz / 64; C = (st & 1) * 32 + (swz % 64) / 2; }
__host__ __device__ __forceinline__ int perm32(int rho) { const int n = rho >> 4, i = rho & 15; return 8 * (i >> 2) + 4 * n + (i & 3); }

struct Unit { int pm, pn, e; };

__device__ __forceinline__ void tile_order(int L, int nM, int nN, int& pm, int& pn) {
    const int nwg = nM * nN; int wgid = L;
    { const int q = nwg / NXCD, r = nwg % NXCD, xcd = wgid % NXCD, off = wgid / NXCD; wgid = (xcd < r ? xcd * (q + 1) : r * (q + 1) + (xcd - r) * q) + off; }
    const int nig = WGM * nN, gid = wgid / nig, fm = gid * WGM, gsz = (nM - fm) < WGM ? (nM - fm) : WGM;
    pm = fm + ((wgid % nig) % gsz); pn = (wgid % nig) / gsz;
}

typedef int i32x8 __attribute__((ext_vector_type(8)));
typedef int i32x4_ __attribute__((ext_vector_type(4)));
__device__ __forceinline__ i32x8 cat8(bf16x8 a, bf16x8 b) { return __builtin_shufflevector(__builtin_bit_cast(i32x4_, a), __builtin_bit_cast(i32x4_, b), 0, 1, 2, 3, 4, 5, 6, 7); }
__device__ __forceinline__ void mfma_fp8_inplace(f32x4& acc, const i32x8 a, const i32x8 b) { asm volatile("v_mfma_f32_16x16x128_f8f6f4 %0, %1, %2, %0" : "+v"(acc) : "v"(a), "v"(b)); }
template <int N> __device__ __forceinline__ void wait_vm() { asm volatile("s_waitcnt vmcnt(%0)" :: "n"(N) : "memory"); }
__device__ __forceinline__ unsigned cvt_pk_bf16(float lo, float hi) { unsigned r; asm volatile("v_cvt_pk_bf16_f32 %0, %1, %2" : "=v"(r) : "v"(lo), "v"(hi)); return r; }

template <class Epi, class Sched, bool ALIGN_EPI = false, bool SP2 = false, bool FP8 = false>
__device__ __forceinline__ void gemm_phase(PG8_LAS unsigned char* lds, const int K, const Sched& S, const Epi& E) {
    const int tid = threadIdx.x, wid = __builtin_amdgcn_readfirstlane(tid >> 6), lane = tid & 63, wr = wid >> 2, wc = wid & 3, fr = lane & 15, fq = lane >> 4;
    const int nt = K / BK;
    unsigned voffA[2], voffB[2];
#pragma unroll
    for (int i = 0; i < 2; ++i) { int R, C; stage_rc(tid * 16 + i * 8192, R, C); const int Rb = Epi::PERM ? ((R & ~31) + perm32(R & 31)) : R;
        voffA[i] = (unsigned)(R * K + C) * 2u; voffB[i] = (unsigned)(Rb * K + C) * 2u; }
    const unsigned kstep = (unsigned)(BK * 2);
    const unsigned hstep = (unsigned)HALF * K * 2;
    const unsigned tstep = 2 * hstep; (void)tstep;
    const __amdgpu_buffer_rsrc_t rsA = __builtin_amdgcn_make_buffer_rsrc((void*)S.A, 0, -1, 0x00020000), rsB = __builtin_amdgcn_make_buffer_rsrc((void*)S.B, 0, -1, 0x00020000);
    const unsigned ldsw = (unsigned)wid * 1024u;
    const int aoff = lds_byte(wr * 64 + fr, fq * 8), boff = lds_byte(wc * 32 + fr, fq * 8);
#define PG8_SA(b, h) (((b) * 2 + (h)) * HTB)
#define PG8_SB(b, h) ((4 + (b) * 2 + (h)) * HTB)
#define PG8_STAGE_R(rs, bufoff, soff, voff) do { _Pragma("unroll") for (int _i = 0; _i < 2; ++_i) \
        __builtin_amdgcn_raw_ptr_buffer_load_lds((rs), (PG8_LAS void*)(lds + (bufoff) + ldsw + _i * 8192), 16, (int)(voff)[_i], (int)(soff), 0, 0); } while (0)
#define PG8_STAGE(bufoff, gbase, voff) PG8_STAGE_R(PG8_RS_##voff, bufoff, gbase, voff)
#define PG8_RS_voffA rsA
#define PG8_RS_voffB rsB
#define PG8_LDA(dst, b, h) do { _Pragma("unroll") for (int m = 0; m < 4; ++m) _Pragma("unroll") for (int k = 0; k < 2; ++k) dst[m][k] = *(const PG8_LAS bf16x8*)(lds + PG8_SA(b, h) + aoff + m * 2048 + k * 1024); } while (0)
#define PG8_LDB(dst, b, h) do { _Pragma("unroll") for (int n = 0; n < 2; ++n) _Pragma("unroll") for (int k = 0; k < 2; ++k) dst[n][k] = *(const PG8_LAS bf16x8*)(lds + PG8_SB(b, h) + boff + n * 2048 + k * 1024); } while (0)
#define PG8_MMA(ai, bj, At, Bt) do { __builtin_amdgcn_s_setprio(1); _Pragma("unroll") for (int m = 0; m < 4; ++m) _Pragma("unroll") for (int n = 0; n < 2; ++n) { \
        if constexpr (FP8) { mfma_fp8_inplace(acc[ai][bj][m][n], cat8(Bt[n][0], Bt[n][1]), cat8(At[m][0], At[m][1])); } \
        else { _Pragma("unroll") for (int k = 0; k < 2; ++k) acc[ai][bj][m][n] = __builtin_amdgcn_mfma_f32_16x16x32_bf16(Bt[n][k], At[m][k], acc[ai][bj][m][n], 0, 0, 0); } } \
        __builtin_amdgcn_s_setprio(0); } while (0)
#define PG8_WAIT_V(n) asm volatile("s_waitcnt vmcnt(" #n ")" ::: "memory")
#define PG8_WAIT_L(n) asm volatile("s_waitcnt lgkmcnt(" #n ")" ::: "memory")
#define PG8_BAR __builtin_amdgcn_s_barrier()
#define PG8_SCHED __builtin_amdgcn_sched_barrier(0)
    Unit cur, nxt; int ui = 0;
    if (!S.next(0, cur)) return;
    f32x4 acc[2][2][4][2];
#pragma unroll
    for (int a = 0; a < 2; ++a)
#pragma unroll
        for (int b = 0; b < 2; ++b)
#pragma unroll
            for (int m = 0; m < 4; ++m)
#pragma unroll
                for (int n = 0; n < 2; ++n) acc[a][b][m][n] = (f32x4){0.f, 0.f, 0.f, 0.f};
    bf16x8 At[4][2], B0[2][2], B1[2][2];
    unsigned cA = S.aoff(cur), cB = S.boff(cur);
    S.a_ready(cur);
    if constexpr (SP2) {
        PG8_STAGE(PG8_SB(0, 0), cB, voffB); PG8_STAGE(PG8_SB(0, 1), cB + hstep, voffB); PG8_STAGE(PG8_SA(0, 0), cA, voffA); PG8_STAGE(PG8_SA(0, 1), cA + hstep, voffA);
        if (wr == 1) PG8_BAR;
        PG8_WAIT_V(2); PG8_BAR;
        PG8_STAGE(PG8_SB(1, 0), cB + kstep, voffB); PG8_STAGE(PG8_SA(1, 0), cA + kstep, voffA); PG8_STAGE(PG8_SB(1, 1), cB + hstep + kstep, voffB);
        PG8_WAIT_V(6); PG8_BAR;
    } else {
        PG8_STAGE(PG8_SB(0, 0), cB, voffB); PG8_STAGE(PG8_SA(0, 0), cA, voffA); PG8_STAGE(PG8_SB(0, 1), cB + hstep, voffB); PG8_STAGE(PG8_SA(0, 1), cA + hstep, voffA);
        if (wr == 1) PG8_BAR;
        PG8_WAIT_V(4); PG8_BAR;
        PG8_STAGE(PG8_SB(1, 0), cB + kstep, voffB); PG8_STAGE(PG8_SA(1, 0), cA + kstep, voffA); PG8_STAGE(PG8_SB(1, 1), cB + hstep + kstep, voffB);
        PG8_WAIT_V(6); PG8_BAR;
    }
    for (;;) {
        const bool has_next = S.next(ui + 1, nxt);
        const unsigned nA = has_next ? S.aoff(nxt) : cA, nB = has_next ? S.boff(nxt) : cB;
        constexpr int KREP = (PROBE_PHASE == 300 + Epi::ID) ? 2 : 1;
#pragma nounroll
        for (int krep = 0; krep < KREP; ++krep) {
        if (KREP == 2 && krep == 1) {
#pragma unroll
        for (int a = 0; a < 2; ++a)
#pragma unroll
            for (int b = 0; b < 2; ++b)
#pragma unroll
                for (int m = 0; m < 4; ++m)
#pragma unroll
                    for (int n = 0; n < 2; ++n) acc[a][b][m][n] = (f32x4){0.f, 0.f, 0.f, 0.f};
        }
        for (int t = 0; t < nt; t += 2) {
            const bool last = (t == nt - 2);
            const unsigned a1 = cA + (unsigned)(t + 1) * kstep;
            const unsigned nA_ = (KREP == 2 && krep == 0) ? cA : nA, nB_ = (KREP == 2 && krep == 0) ? cB : nB;
            const unsigned a2 = last ? nA_ : cA + (unsigned)(t + 2) * kstep, b2 = last ? nB_ : cB + (unsigned)(t + 2) * kstep;
            const unsigned a3 = a2 + kstep, b3 = b2 + kstep;
            if (last && has_next) S.a_ready(nxt);
            if constexpr (SP2) {
            PG8_LDB(B0, 0, 0); PG8_LDB(B1, 0, 1); PG8_SCHED; PG8_LDA(At, 0, 0); PG8_STAGE(PG8_SA(1, 1), a1 + hstep, voffA);
            PG8_WAIT_V(8); PG8_WAIT_L(0); PG8_BAR; PG8_MMA(0, 0, At, B0); PG8_MMA(0, 1, At, B1); PG8_BAR; PG8_SCHED;
            PG8_LDA(At, 0, 1); PG8_STAGE(PG8_SB(0, 0), b2, voffB); PG8_STAGE(PG8_SB(0, 1), b2 + hstep, voffB); PG8_STAGE(PG8_SA(0, 0), a2, voffA);
            PG8_WAIT_V(8); PG8_WAIT_L(0); PG8_BAR; PG8_MMA(1, 0, At, B0); PG8_MMA(1, 1, At, B1); PG8_BAR; PG8_SCHED;
            PG8_LDB(B0, 1, 0); PG8_LDB(B1, 1, 1); PG8_SCHED; PG8_LDA(At, 1, 0); PG8_STAGE(PG8_SA(0, 1), a2 + hstep, voffA);
            PG8_WAIT_V(8); PG8_WAIT_L(0); PG8_BAR; PG8_MMA(0, 0, At, B0); PG8_MMA(0, 1, At, B1); PG8_BAR; PG8_SCHED;
            PG8_LDA(At, 1, 1); PG8_STAGE(PG8_SB(1, 0), b3, voffB); PG8_STAGE(PG8_SB(1, 1), b3 + hstep, voffB); PG8_STAGE(PG8_SA(1, 0), a3, voffA);
            PG8_WAIT_V(8); PG8_WAIT_L(0); PG8_BAR; PG8_MMA(1, 0, At, B0); PG8_MMA(1, 1, At, B1); PG8_BAR; PG8_SCHED;
            } else {
            PG8_LDB(B0, 0, 0); PG8_SCHED; PG8_LDA(At, 0, 0); PG8_STAGE(PG8_SA(1, 1), a1 + hstep, voffA);
            PG8_WAIT_L(8); PG8_BAR; PG8_WAIT_L(0); PG8_MMA(0, 0, At, B0); PG8_BAR; PG8_SCHED;
            PG8_LDB(B1, 0, 1); PG8_STAGE(PG8_SB(0, 0), b2, voffB);
            PG8_BAR; PG8_WAIT_L(0); PG8_MMA(0, 1, At, B1); PG8_BAR;
            PG8_LDA(At, 0, 1); PG8_STAGE(PG8_SA(0, 0), a2, voffA);
            PG8_BAR; PG8_WAIT_L(0); PG8_MMA(1, 0, At, B0); PG8_BAR; PG8_SCHED;
            PG8_STAGE(PG8_SB(0, 1), b2 + hstep, voffB);
            PG8_WAIT_V(6); PG8_BAR; PG8_MMA(1, 1, At, B1); PG8_BAR;
            PG8_LDB(B0, 1, 0); PG8_SCHED; PG8_LDA(At, 1, 0); PG8_STAGE(PG8_SA(0, 1), a2 + hstep, voffA);
            PG8_WAIT_L(8); PG8_BAR; PG8_WAIT_L(0); PG8_MMA(0, 0, At, B0); PG8_BAR; PG8_SCHED;
            PG8_LDB(B1, 1, 1); PG8_STAGE(PG8_SB(1, 0), b3, voffB);
            PG8_BAR; PG8_WAIT_L(0); PG8_MMA(0, 1, At, B1); PG8_BAR;
            PG8_LDA(At, 1, 1); PG8_STAGE(PG8_SA(1, 0), a3, voffA);
            PG8_BAR; PG8_WAIT_L(0); PG8_MMA(1, 0, At, B0); PG8_BAR; PG8_SCHED;
            PG8_STAGE(PG8_SB(1, 1), b3 + hstep, voffB);
            PG8_WAIT_V(6); PG8_BAR; PG8_MMA(1, 1, At, B1); PG8_BAR;
            }
        }
        }
        if constexpr (FP8) {
            asm volatile("s_nop 15\n\ts_nop 15" : "+v"(acc[0][0][0][0]), "+v"(acc[0][0][0][1]));
#pragma unroll
            for (int a = 0; a < 2; ++a)
#pragma unroll
                for (int b = 0; b < 2; ++b)
#pragma unroll
                    for (int m = 0; m < 4; ++m) asm volatile("" : "+v"(acc[a][b][m][0]), "+v"(acc[a][b][m][1]));
        }
        if constexpr (ALIGN_EPI) { if (wr == 0) PG8_BAR; }
        if constexpr (!Epi::AFTER_DRAIN) { E(acc, cur, wr, wc, fr, fq); if constexpr (PROBE_PHASE == 200 + Epi::ID) { asm volatile("" ::: "memory"); E(acc, cur, wr, wc, fr, fq); } S.done(cur); }
        if (!has_next) break;
        if (!E.keep(cur)) {
#pragma unroll
        for (int a = 0; a < 2; ++a)
#pragma unroll
            for (int b = 0; b < 2; ++b)
#pragma unroll
                for (int m = 0; m < 4; ++m)
#pragma unroll
                    for (int n = 0; n < 2; ++n) acc[a][b][m][n] = (f32x4){0.f, 0.f, 0.f, 0.f};
        }
        cur = nxt; cA = nA; cB = nB; ++ui;
        if constexpr (ALIGN_EPI) { if (wr == 1) PG8_BAR; }
    }
    PG8_WAIT_V(0);
    if constexpr (!ALIGN_EPI) { if (wr == 0) PG8_BAR; }
    PG8_BAR;
    if constexpr (Epi::AFTER_DRAIN) { E.fused(acc, cur, wr, wc, fr, fq, lds, wid, lane); S.done(cur); }
#undef PG8_SA
#undef PG8_SB
#undef PG8_STAGE
#undef PG8_LDA
#undef PG8_LDB
#undef PG8_MMA
#undef PG8_WAIT_V
#undef PG8_WAIT_L
#undef PG8_BAR
#undef PG8_SCHED
}

template <class Epi, class Sched, bool FP8 = false>
__device__ __forceinline__ void gemm_phase_sp(PG8_LAS unsigned char* lds, const int K, const Sched& S, const Epi& E) {
    const int tid = threadIdx.x, wid = __builtin_amdgcn_readfirstlane(tid >> 6), lane = tid & 63, wr = wid >> 2, wc = wid & 3, fr = lane & 15, fq = lane >> 4;
    const int nt = K / BK;
    unsigned voffA[2], voffB[2];
#pragma unroll
    for (int i = 0; i < 2; ++i) { int R, C; stage_rc(tid * 16 + i * 8192, R, C); const int Rb = Epi::PERM ? ((R & ~31) + perm32(R & 31)) : R;
        voffA[i] = (unsigned)(R * K + C) * 2u; voffB[i] = (unsigned)(Rb * K + C) * 2u; }
    const unsigned kstep = (unsigned)(BK * 2);
    const unsigned hstep = (unsigned)HALF * K * 2;
    const unsigned tstep = 2 * hstep; (void)tstep;
    const __amdgpu_buffer_rsrc_t rsA = __builtin_amdgcn_make_buffer_rsrc((void*)S.A, 0, -1, 0x00020000), rsB = __builtin_amdgcn_make_buffer_rsrc((void*)S.B, 0, -1, 0x00020000);
    const unsigned ldsw = (unsigned)wid * 1024u;
    const int aoff = lds_byte(wr * 64 + fr, fq * 8), boff = lds_byte(wc * 32 + fr, fq * 8);
#define PG8_SA(b, h) (((b) * 2 + (h)) * HTB)
#define PG8_SB(b, h) ((4 + (b) * 2 + (h)) * HTB)
#define PG8_STAGE_R(rs, bufoff, soff, voff) do { _Pragma("unroll") for (int _i = 0; _i < 2; ++_i) \
        __builtin_amdgcn_raw_ptr_buffer_load_lds((rs), (PG8_LAS void*)(lds + (bufoff) + ldsw + _i * 8192), 16, (int)(voff)[_i], (int)(soff), 0, 0); } while (0)
#define PG8_STAGE(bufoff, gbase, voff) PG8_STAGE_R(PG8_RS_##voff, bufoff, gbase, voff)
#define PG8_RS_voffA rsA
#define PG8_RS_voffB rsB
#define PG8_LDA(dst, b, h) do { _Pragma("unroll") for (int m = 0; m < 4; ++m) _Pragma("unroll") for (int k = 0; k < 2; ++k) dst[m][k] = *(const PG8_LAS bf16x8*)(lds + PG8_SA(b, h) + aoff + m * 2048 + k * 1024); } while (0)
#define PG8_LDB(dst, b, h) do { _Pragma("unroll") for (int n = 0; n < 2; ++n) _Pragma("unroll") for (int k = 0; k < 2; ++k) dst[n][k] = *(const PG8_LAS bf16x8*)(lds + PG8_SB(b, h) + boff + n * 2048 + k * 1024); } while (0)
#define PG8_MMA(ai, bj, At, Bt) do { __builtin_amdgcn_s_setprio(1); _Pragma("unroll") for (int m = 0; m < 4; ++m) _Pragma("unroll") for (int n = 0; n < 2; ++n) { \
        if constexpr (FP8) { mfma_fp8_inplace(acc[ai][bj][m][n], cat8(Bt[n][0], Bt[n][1]), cat8(At[m][0], At[m][1])); } \
        else { _Pragma("unroll") for (int k = 0; k < 2; ++k) acc[ai][bj][m][n] = __builtin_amdgcn_mfma_f32_16x16x32_bf16(Bt[n][k], At[m][k], acc[ai][bj][m][n], 0, 0, 0); } } \
        __builtin_amdgcn_s_setprio(0); } while (0)
#define PG8_WAIT_V(n) asm volatile("s_waitcnt vmcnt(" #n ")" ::: "memory")
#define PG8_WAIT_L(n) asm volatile("s_waitcnt lgkmcnt(" #n ")" ::: "memory")
#define PG8_BAR __builtin_amdgcn_s_barrier()
#define PG8_SCHED __builtin_amdgcn_sched_barrier(0)
    static_assert(!Epi::AFTER_DRAIN, "split epilogue");
    Unit cur, nxt, prv; int ui = 0; bool pend = false;
    if (!S.next(0, cur)) return;
    prv = cur;
    f32x4 acc[2][2][4][2];
#pragma unroll
    for (int a = 0; a < 2; ++a)
#pragma unroll
        for (int b = 0; b < 2; ++b)
#pragma unroll
            for (int m = 0; m < 4; ++m)
#pragma unroll
                for (int n = 0; n < 2; ++n) acc[a][b][m][n] = (f32x4){0.f, 0.f, 0.f, 0.f};
    bf16x8 At[4][2], B0[2][2], B1[2][2];
    unsigned cA = S.aoff(cur), cB = S.boff(cur);
    S.a_ready(cur);
#define PG8_EPI_HALF(un, h) do { \
        if constexpr (FP8) { asm volatile("s_nop 15\n\ts_nop 15" : "+v"(acc[h][0][0][0]), "+v"(acc[h][0][0][1])); \
            _Pragma("unroll") for (int b_ = 0; b_ < 2; ++b_) _Pragma("unroll") for (int m_ = 0; m_ < 4; ++m_) asm volatile("" : "+v"(acc[h][b_][m_][0]), "+v"(acc[h][b_][m_][1])); } \
        E(acc, un, wr, wc, fr, fq, h, h + 1); \
        if (!E.keep(un)) { _Pragma("unroll") for (int b_ = 0; b_ < 2; ++b_) _Pragma("unroll") for (int m_ = 0; m_ < 4; ++m_) _Pragma("unroll") for (int n_ = 0; n_ < 2; ++n_) acc[h][b_][m_][n_] = (f32x4){0.f, 0.f, 0.f, 0.f}; } \
        if constexpr (FP8) { _Pragma("unroll") for (int b_ = 0; b_ < 2; ++b_) _Pragma("unroll") for (int m_ = 0; m_ < 4; ++m_) asm volatile("s_nop 1" : "+v"(acc[h][b_][m_][0]), "+v"(acc[h][b_][m_][1])); } \
    } while (0)
    PG8_STAGE(PG8_SB(0, 0), cB, voffB); PG8_STAGE(PG8_SB(0, 1), cB + hstep, voffB); PG8_STAGE(PG8_SA(0, 0), cA, voffA); PG8_STAGE(PG8_SA(0, 1), cA + hstep, voffA);
    if (wr == 1) PG8_BAR;
    PG8_WAIT_V(2); PG8_BAR;
    PG8_STAGE(PG8_SB(1, 0), cB + kstep, voffB); PG8_STAGE(PG8_SA(1, 0), cA + kstep, voffA); PG8_STAGE(PG8_SB(1, 1), cB + hstep + kstep, voffB);
    PG8_WAIT_V(6); PG8_BAR;
    for (;;) {
        const bool has_next = S.next(ui + 1, nxt);
        const unsigned nA = has_next ? S.aoff(nxt) : cA, nB = has_next ? S.boff(nxt) : cB;
        for (int t = 0; t < nt; t += 2) {
            const bool last = (t == nt - 2);
            const unsigned a1 = cA + (unsigned)(t + 1) * kstep;
            const unsigned a2 = last ? nA : cA + (unsigned)(t + 2) * kstep, b2 = last ? nB : cB + (unsigned)(t + 2) * kstep;
            const unsigned a3 = a2 + kstep, b3 = b2 + kstep;
            if (last && has_next) S.a_ready(nxt);
            const bool rlxB = (t == 0) && pend && E.relax_ok(prv), rlxA = last && E.relax_ok(cur);
            if (t == 0 && pend) { PG8_SCHED; PG8_EPI_HALF(prv, 1); S.done(prv); pend = false; PG8_SCHED; }
            PG8_LDB(B0, 0, 0); PG8_LDB(B1, 0, 1); PG8_SCHED; PG8_LDA(At, 0, 0); PG8_STAGE(PG8_SA(1, 1), a1 + hstep, voffA);
            if (rlxB) wait_vm<8 + 2 * Epi::NSTH>(); else wait_vm<8>();
            PG8_WAIT_L(0); PG8_BAR; PG8_MMA(0, 0, At, B0); PG8_MMA(0, 1, At, B1); PG8_BAR; PG8_SCHED;
            PG8_LDA(At, 0, 1); PG8_STAGE(PG8_SB(0, 0), b2, voffB); PG8_STAGE(PG8_SB(0, 1), b2 + hstep, voffB); PG8_STAGE(PG8_SA(0, 0), a2, voffA);
            if (rlxB) wait_vm<8 + Epi::NSTH>(); else wait_vm<8>();
            PG8_WAIT_L(0); PG8_BAR; PG8_MMA(1, 0, At, B0); PG8_MMA(1, 1, At, B1); PG8_BAR; PG8_SCHED;
            PG8_LDB(B0, 1, 0); PG8_LDB(B1, 1, 1); PG8_SCHED; PG8_LDA(At, 1, 0); PG8_STAGE(PG8_SA(0, 1), a2 + hstep, voffA);
            PG8_WAIT_V(8); PG8_WAIT_L(0); PG8_BAR; PG8_MMA(0, 0, At, B0); PG8_MMA(0, 1, At, B1); PG8_BAR; PG8_SCHED;
            if (last) { PG8_SCHED; PG8_EPI_HALF(cur, 0); PG8_SCHED; }
            PG8_LDA(At, 1, 1); PG8_STAGE(PG8_SB(1, 0), b3, voffB); PG8_STAGE(PG8_SB(1, 1), b3 + hstep, voffB); PG8_STAGE(PG8_SA(1, 0), a3, voffA);
            if (rlxA) wait_vm<8 + Epi::NSTH>(); else wait_vm<8>();
            PG8_WAIT_L(0); PG8_BAR; PG8_MMA(1, 0, At, B0); PG8_MMA(1, 1, At, B1); PG8_BAR; PG8_SCHED;
        }
        prv = cur; pend = true;
        if (!has_next) break;
        cur = nxt; cA = nA; cB = nB; ++ui;
    }
    PG8_EPI_HALF(prv, 1); S.done(prv);
    PG8_WAIT_V(0);
    if (wr == 0) PG8_BAR;
    PG8_BAR;
#undef PG8_EPI_HALF
#undef PG8_SA
#undef PG8_SB
#undef PG8_STAGE
#undef PG8_LDA
#undef PG8_LDB
#undef PG8_MMA
#undef PG8_WAIT_V
#undef PG8_WAIT_L
#undef PG8_BAR
#undef PG8_SCHED
}

}

constexpr int NB = 16, SEQ = 2048, D = 1024, CTXL = 256;
constexpr int NTOK = NB * SEQ, NCTX = NB * CTXL, NROW = NTOK + NCTX;
constexpr int NT1 = 33, N1 = NT1 * 256;
constexpr int NE = 32, TOPK = 4, DFF = 1024;
constexpr int MAXTILES = 544, MAXROWS = MAXTILES * 256;
constexpr float EPS = 1e-6f;
constexpr int NWAVES = 8;
constexpr int HRL = 4104;

constexpr size_t KiB = 1024, MiB = 1u << 20;
constexpr size_t WS_CTL = 0, CTL_ZERO_BYTES = 1 * MiB;
constexpr size_t WS_MOD = 1 * MiB;
constexpr size_t WS_TOKE = 1536 * KiB, WS_TOKW = 2048 * KiB, WS_PAIRPOS = 2560 * KiB, WS_ROWTOK = 3072 * KiB, WS_ROWW = 3840 * KiB;
constexpr size_t WS_HR = 5 * MiB;
constexpr size_t WS_WB1 = 13824 * KiB;
constexpr size_t WS_WG = 30 * MiB, WS_WH = 32 * MiB, WS_WO = 34 * MiB;
constexpr size_t WS_WUP = 68 * MiB, WS_WDN = 168 * MiB;
constexpr size_t WS_HX = 228 * MiB, WS_KB = 300 * MiB, WS_VB = 336 * MiB, WS_RF = 408 * MiB, WS_QB = 408 * MiB + 4608 * KiB;
constexpr size_t WS_OG = WS_QB + 32 * MiB, WS_HY = WS_OG + 64 * MiB, WS_MA = WS_HY + 192 * MiB, WS_MB = WS_MA + 64 * MiB;
constexpr size_t WS_OF = WS_MB + 64 * MiB, WS_OB = WS_OF + 64 * MiB, WS_UT = WS_OB + 64 * MiB, WS_END = WS_UT + 64 * MiB;
constexpr size_t WS_X0C = WS_HX, WS_ZT = WS_HY, WS_GA = WS_KB, WS_YH = WS_KB + 64 * MiB, WS_YA = WS_HY, WS_YM = WS_HY + 128 * MiB;
constexpr size_t WS_HX8 = 36 * MiB, WS_WB8 = 68 * MiB;
constexpr size_t WS_QD = 36 * MiB, WS_ATT = 207 * MiB, WS_KUT = 132 * MiB, WS_DEC = 204 * MiB;
static_assert(WS_DEC + 2 * (size_t)576 * 4 * 128 * 4 <= WS_ATT && WS_ATT + 2 * (size_t)512 * 4 * 4096 <= WS_HX && WS_QD + 2 * (size_t)NTOK * 512 <= WS_WUP && WS_WUP + (size_t)NE * 2048 * 1024 <= WS_KUT, "ws map gla");
static_assert(WS_KUT + 2 * (size_t)576 * 4 * 64 * 128 <= WS_WDN && WS_WDN + (size_t)NE * 1024 * 1024 <= WS_DEC && WS_WB8 + (size_t)32 * 256 * 1024 <= WS_KUT, "ws map gla 2");
constexpr size_t WS_XM = 428 * MiB;
constexpr size_t WS_H8 = WS_HX, WS_AX = 292 * MiB, WS_Y = WS_AX, WS_ACT = 564 * MiB;
static_assert(WS_WB1 + (size_t)N1 * 1024 * 2 <= WS_WG && WS_HR + (size_t)1024 * HRL * 2 <= WS_WB1, "ws map 1");
static_assert(WS_RF + (size_t)NROW * 32 * 4 <= WS_QB && WS_END <= 1024 * MiB && WS_YH + 64 * MiB <= WS_OG, "ws map 2");
static_assert(WS_ACT + (size_t)MAXROWS * 1024 <= WS_END && WS_Y + (size_t)MAXROWS * 1024 <= WS_ACT && WS_H8 + 32 * MiB <= WS_AX, "ws map 3");
static_assert(WS_ROWTOK + (size_t)MAXROWS * 4 <= WS_ROWW && WS_ROWW + (size_t)MAXROWS * 4 <= WS_HR, "ws map 4");
constexpr int CW_CNT = 64, CW_CUR = 128, CW_BAR = 4096;

constexpr int LDS_BYTES = 163840;
constexpr int LDSCTL_OFF = 159744;
constexpr int LC_BAR = 0  , LC_OFF = 8  , LC_HIST = 48  , LC_LCNT = 80  , LC_BASE = 112  , LC_T2E = 160  ;
static_assert((LC_T2E + MAXTILES) * 4 <= 4096, "LDS control area");

#define GAS __attribute__((address_space(1)))
#define LAS __attribute__((address_space(3)))
typedef unsigned short bf16;
typedef unsigned v4u __attribute__((ext_vector_type(4)));
typedef unsigned v2u __attribute__((ext_vector_type(2)));
typedef float f32x4 __attribute__((ext_vector_type(4)));
typedef float f32x16 __attribute__((ext_vector_type(16)));
typedef short bf16x8 __attribute__((ext_vector_type(8)));
#define LDS_WAIT() asm volatile("s_waitcnt lgkmcnt(0)" ::: "memory")
typedef __bf16 hwbf16x2 __attribute__((ext_vector_type(2)));
typedef float hwf32x2 __attribute__((ext_vector_type(2)));
__device__ __forceinline__ unsigned f2bf(float f) { return (unsigned)__builtin_bit_cast(unsigned short, (__bf16)f); }
__device__ __forceinline__ unsigned pk2(float lo, float hi) { return __builtin_bit_cast(unsigned, __builtin_convertvector((hwf32x2){lo, hi}, hwbf16x2)); }
__device__ __forceinline__ float bf2f(unsigned h) { return __builtin_bit_cast(float, h << 16); }
__device__ __forceinline__ float bflo(unsigned w) { return __builtin_bit_cast(float, w << 16); }
__device__ __forceinline__ float bfhi(unsigned w) { return __builtin_bit_cast(float, w & 0xffff0000u); }
#define DPP_ADD(v, ctrl) ((v) + __builtin_bit_cast(float, __builtin_amdgcn_update_dpp(0, __builtin_bit_cast(int, (v)), (ctrl), 0xf, 0xf, true)))
__device__ __forceinline__ float wave_sum(float v) {
    v = DPP_ADD(v, 0xB1);
    v = DPP_ADD(v, 0x4E);
    v = DPP_ADD(v, 0x141);
    v = DPP_ADD(v, 0x140);
    const float r0 = __builtin_bit_cast(float, __builtin_amdgcn_readlane(__builtin_bit_cast(int, v), 0)), r1 = __builtin_bit_cast(float, __builtin_amdgcn_readlane(__builtin_bit_cast(int, v), 16));
    const float r2 = __builtin_bit_cast(float, __builtin_amdgcn_readlane(__builtin_bit_cast(int, v), 32)), r3 = __builtin_bit_cast(float, __builtin_amdgcn_readlane(__builtin_bit_cast(int, v), 48));
    return (r0 + r1) + (r2 + r3);
}
__device__ __forceinline__ float sigmoidf_(float x) { return __builtin_amdgcn_rcpf(1.f + __expf(-x)); }

#define XB_TMO      128
#define XB_XCNT(j)  (256  + 64 * (j))
#define XB_XSUB(j)  (1280 + 64 * (j))
#define XB_XGEN(j)  (2304 + 64 * (j))
#define XB_TOP      3328
#define XB_TOPGEN   3392
#define XCD_BAR_WORDS 3456
#define XB_SPIN_CAP (1u << 18)
__device__ __forceinline__ unsigned xb_ld(unsigned* p)              { return __hip_atomic_load(p, __ATOMIC_RELAXED, __HIP_MEMORY_SCOPE_AGENT); }
__device__ __forceinline__ unsigned xb_add(unsigned* p, unsigned v) { return __hip_atomic_fetch_add(p, v, __ATOMIC_RELAXED, __HIP_MEMORY_SCOPE_AGENT); }
__device__ __forceinline__ unsigned xb_xcc_id() { return (unsigned)__builtin_amdgcn_s_getreg((3 << 11) | 20) & 0xFu; }
#define XB_SPIN(cond, bar) do { unsigned _sp = 0; while (cond) { __builtin_amdgcn_s_sleep(1); \
    if ((++_sp & 255u) == 0u) { if (xb_ld(&(bar)[XB_TMO])) break; if (_sp > XB_SPIN_CAP) { atomicAdd(&(bar)[XB_TMO], 1u); break; } } } } while (0)
struct XcdBarrier { unsigned* bar; unsigned x; volatile LAS unsigned* st; };
__device__ __forceinline__ XcdBarrier xcd_barrier_post(unsigned* bar, volatile LAS unsigned* st) {
    XcdBarrier b; b.bar = bar; b.x = xb_xcc_id(); b.st = st;
    if (threadIdx.x == 0) (void)xb_add(&bar[XB_XCNT(b.x)], 1u);
    return b;
}
__device__ __forceinline__ void xcd_barrier_complete(unsigned* bar, unsigned x, unsigned& nloc, unsigned& nx) {
    const unsigned G = gridDim.x * gridDim.y * gridDim.z;
    unsigned sum, cnt, mine, sp = 0u;
    for (;;) {
        sum = 0u; cnt = 0u; mine = 0u;
#pragma unroll
        for (unsigned j = 0; j < 16; ++j) { const unsigned c = xb_ld(&bar[XB_XCNT(j)]); sum += c; cnt += (c > 0u) ? 1u : 0u; mine = (j == x) ? c : mine; }
        if (sum == G) break;
        __builtin_amdgcn_s_sleep(1);
        if ((++sp & 255u) == 0u) { if (xb_ld(&bar[XB_TMO])) break; if (sp > XB_SPIN_CAP) { atomicAdd(&bar[XB_TMO], 1u); break; } }
    }
    nloc = mine > 0u ? mine : 1u; nx = cnt > 0u ? cnt : 1u;
}
__device__ __forceinline__ void xcd_barrier(const XcdBarrier& b) {
    asm volatile("s_waitcnt vmcnt(0)" ::: "memory");
    __syncthreads();
    if (threadIdx.x == 0) {
        unsigned* bar = b.bar;
        __builtin_amdgcn_s_waitcnt(0);
        unsigned nloc = b.st[0], nx = b.st[1];
        if (nloc == 0u) { xcd_barrier_complete(bar, b.x, nloc, nx); b.st[0] = nloc; b.st[1] = nx; }
        const unsigned old = xb_add(&bar[XB_XSUB(b.x)], 1u);
        const unsigned gen = old / nloc;
        if (old + 1u == (gen + 1u) * nloc) {
            __builtin_amdgcn_fence(__ATOMIC_RELEASE, "agent");
            asm volatile("s_waitcnt vmcnt(0)" ::: "memory");
            const unsigned og = xb_add(&bar[XB_TOP], 1u);
            const unsigned tg = og / nx;
            if (og + 1u == (tg + 1u) * nx) xb_add(&bar[XB_TOPGEN], 1u);
            else XB_SPIN(xb_ld(&bar[XB_TOPGEN]) == tg, bar);
            __builtin_amdgcn_fence(__ATOMIC_ACQUIRE, "agent");
            xb_add(&bar[XB_XGEN(b.x)], 1u);
            asm volatile("s_waitcnt vmcnt(0)" ::: "memory");
        } else {
            XB_SPIN(xb_ld(&bar[XB_XGEN(b.x)]) == gen, bar);
            __builtin_amdgcn_fence(__ATOMIC_ACQUIRE, "agent");
            asm volatile("s_waitcnt vmcnt(0)" ::: "memory");
        }
    }
    __syncthreads();
}

struct Frame {
    LAS unsigned char* lds;
    volatile LAS unsigned* LC;
    unsigned* ctl;
    int tid, lane, wave, vcu, G;
    const float* in[35]; float* out; unsigned char* ws;
};
enum { I_X = 0, I_C, I_CTX, I_CCTX, I_WADA, I_BADA, I_NMIX, I_NFFN, I_WIN, I_WGKF, I_BGKF, I_WGKB, I_BGKB, I_GLAN, I_WGLAO, I_HCW, I_HCB, I_HW1, I_HB1, I_HW2, I_HB2, I_HW3, I_HB3,
       I_HW4, I_HFREQ, I_HBIAS, I_WHYO, I_WOUT, I_WRT, I_BRT, I_WUP, I_BUP, I_WDN, I_BDN, I_NFIN };

namespace pg8 {
#ifndef G1CFG
#define G1CFG 5
#endif
constexpr int NBF1 = G1CFG == 0 ? 21 : G1CFG == 1 ? 9 : G1CFG == 2 ? 5 : G1CFG == 3 ? 1 : G1CFG == 4 ? 17 : 13, NF81 = G1CFG == 0 ? 12 : G1CFG == 1 ? 24 : G1CFG == 2 ? 28 : G1CFG == 3 ? 32 : G1CFG == 4 ? 16 : 20;
struct Sched1 {
    const char* A; const char* B; int G, c;
    __device__ __forceinline__ bool next(int i, Unit& u) const {
        const int L = i * G + c; u.e = 0;
        if (L < 128 * NBF1) { int pn; tile_order(L, 128, NBF1, u.pm, pn);
            u.pn = G1CFG == 0 ? (pn < 9 ? pn : pn + 4) : G1CFG == 1 ? pn : G1CFG == 2 ? (pn < 2 ? pn : pn + 4) : G1CFG == 3 ? 6 : G1CFG == 4 ? (pn < 2 ? pn : pn < 5 ? pn + 4 : pn + 8) : (pn == 0 ? 6 : pn + 12); return true; }
        const int L2 = L - 128 * NBF1; if (L2 >= 16 * 7) return false;
        u.pm = 128 + (L2 & 15); u.pn = L2 >> 4; return true;
    }
    __device__ __forceinline__ unsigned aoff(const Unit& u) const { return (unsigned)u.pm * (256u * 1024 * 2); }
    __device__ __forceinline__ unsigned boff(const Unit& u) const { return (unsigned)u.pn * (256u * 1024 * 2); }
    __device__ __forceinline__ void a_ready(const Unit&) const {}
    __device__ __forceinline__ void done(const Unit&) const {}
};
struct SchedG8 {
    const char* A; const char* B; int G, c;
    __device__ __forceinline__ bool next(int i, Unit& u) const {
        const int L = i * G + c; u.e = 0; if (L >= 128 * NF81) return false;
        tile_order(L, 128, NF81, u.pm, u.pn); if (G1CFG >= 4 && u.pn >= 12) u.pn += 12; return true;
    }
    __device__ __forceinline__ unsigned aoff(const Unit& u) const { return (unsigned)u.pm * (256u * 1024); }
    __device__ __forceinline__ unsigned boff(const Unit& u) const { return (unsigned)u.pn * (256u * 1024); }
    __device__ __forceinline__ void a_ready(const Unit&) const {}
    __device__ __forceinline__ void done(const Unit&) const {}
};
struct SchedStd {
    const char* A; const char* B; int nM, nN, G, c;
    __device__ __forceinline__ bool next(int i, Unit& u) const {
        const int L = i * G + c; u.e = 0; if (L >= nM * nN) return false;
        tile_order(L, nM, nN, u.pm, u.pn); return true;
    }
    __device__ __forceinline__ unsigned aoff(const Unit& u) const { return (unsigned)u.pm * (256u * 1024 * 2); }
    __device__ __forceinline__ unsigned boff(const Unit& u) const { return (unsigned)u.pn * (256u * 1024 * 2); }
    __device__ __forceinline__ void a_ready(const Unit&) const {}
    __device__ __forceinline__ void done(const Unit&) const {}
};
struct SchedMoE {
    const char* A; const char* B; int nM, nN, G, c; unsigned estride; const volatile PG8_LAS unsigned* t2e;
    __device__ __forceinline__ bool next(int i, Unit& u) const {
        const int L = i * G + c; if (L >= nM * nN) { u.e = 0; return false; }
        tile_order(L, nM, nN, u.pm, u.pn); u.e = (int)t2e[u.pm]; return true;
    }
    __device__ __forceinline__ unsigned aoff(const Unit& u) const { return (unsigned)u.pm * (256u * 1024); }
    __device__ __forceinline__ unsigned boff(const Unit& u) const { return (unsigned)u.e * estride + (unsigned)u.pn * (256u * 1024); }
    __device__ __forceinline__ void a_ready(const Unit&) const {}
    __device__ __forceinline__ void done(const Unit&) const {}
};

constexpr float WSCALE = 32.f, WSCALE_INV = 1.f / 32.f;
__device__ __forceinline__ float act_apply(float x, int act) { const float s = __builtin_amdgcn_rcpf(1.f + __expf(-x)); return act == 1 ? x * s : s; }

struct Epi1 {
    static constexpr bool PERM = true, AFTER_DRAIN = false; static constexpr int ID = 1; static constexpr int NSTH = 8; __device__ __forceinline__ bool relax_ok(const Unit& u) const { return u.pn != 6; }
    bf16_t *Kb, *Vb, *Qb, *OGb, *HYb, *MAb, *MBb; float* Rf;
    __device__ __forceinline__ bool keep(const Unit&) const { return false; }
    __device__ __forceinline__ void operator()(f32x4 (&acc)[2][2][4][2], const Unit& u, int wr, int wc, int fr, int fq, const int AI0 = 0, const int AI1 = 2) const {
        const int pn = u.pn; const int row0 = u.pm * BM + wr * 64 + fr;
        if (pn == 6) {
            if (wc == 0) {
#pragma unroll
                for (int ai = AI0; ai < AI1; ++ai)
#pragma unroll
                    for (int m = 0; m < 4; ++m) { float* rp = Rf + (size_t)(row0 + ai * HALF + m * 16) * 32 + 8 * fq;
                        *(f32x4*)rp = acc[ai][0][m][0]; *(f32x4*)(rp + 4) = acc[ai][0][m][1]; }
            }
            return;
        }
        if (pn >= 2 && pn < 6) {
            unsigned char* og8 = (unsigned char*)Vb; const int col0 = 256 * (pn - 2) + wc * 32 + 8 * fq;
#pragma unroll
            for (int ai = AI0; ai < AI1; ++ai)
#pragma unroll
                for (int m = 0; m < 4; ++m) { unsigned char* rowp = og8 + (size_t)(row0 + ai * HALF + m * 16) * 1024 + col0;
#pragma unroll
                    for (int bj = 0; bj < 2; ++bj) { const f32x4 v0 = acc[ai][bj][m][0], v1 = acc[ai][bj][m][1]; int w0 = 0, w1 = 0;
                        w0 = __builtin_amdgcn_cvt_pk_fp8_f32(v0[0], v0[1], w0, false); w0 = __builtin_amdgcn_cvt_pk_fp8_f32(v0[2], v0[3], w0, true);
                        w1 = __builtin_amdgcn_cvt_pk_fp8_f32(v1[0], v1[1], w1, false); w1 = __builtin_amdgcn_cvt_pk_fp8_f32(v1[2], v1[3], w1, true);
                        typedef int i32x2_ __attribute__((ext_vector_type(2))); *(i32x2_*)(rowp + bj * HALF) = (i32x2_){w0, w1}; } }
            return;
        }
        bf16_t* dst; int ld, c0, act = 0;
        if (pn < 2) { dst = Kb; ld = 512; c0 = 256 * pn; }
        else if (pn < 6) { dst = Vb; ld = 1024; c0 = 256 * (pn - 2); }
        else if (pn < 9) { dst = Qb; ld = 512; c0 = 256 * (pn - 7); }
        else if (pn < 13) { dst = OGb; ld = 1024; c0 = 256 * (pn - 9); }
        else if (pn < 25) { dst = HYb; ld = 3072; c0 = 256 * (pn - 13); }
        else if (pn < 29) { dst = MAb; ld = 1024; c0 = 256 * (pn - 25); act = 2; }
        else { dst = MBb; ld = 1024; c0 = 256 * (pn - 29); act = 2; }
        const int col0 = c0 + wc * 32 + 8 * fq;
#pragma unroll
        for (int ai = AI0; ai < AI1; ++ai)
#pragma unroll
            for (int m = 0; m < 4; ++m) { bf16_t* rowp = dst + (size_t)(row0 + ai * HALF + m * 16) * ld + col0;
#pragma unroll
                for (int bj = 0; bj < 2; ++bj) { f32x4 v0 = acc[ai][bj][m][0], v1 = acc[ai][bj][m][1];
                    if (act) {
#pragma unroll
                        for (int j = 0; j < 4; ++j) { v0[j] = act_apply(v0[j], act); v1[j] = act_apply(v1[j], act); } }
                    u32x4 w; w.x = cvt_pk_bf16(v0[0], v0[1]); w.y = cvt_pk_bf16(v0[2], v0[3]); w.z = cvt_pk_bf16(v1[0], v1[1]); w.w = cvt_pk_bf16(v1[2], v1[3]);
                    *(u32x4*)(rowp + bj * HALF) = w; } }
    }
};

struct EpiG8 {
    static constexpr bool PERM = true, AFTER_DRAIN = false; static constexpr int ID = 2; static constexpr int NSTH = 8; __device__ __forceinline__ bool relax_ok(const Unit& u) const { return true; }
    unsigned char* OG8; bf16_t* MAb; bf16_t* MBb; bf16_t* HYb; unsigned char* V8; bf16_t* Kb; bf16_t* Qb;
    __device__ __forceinline__ bool keep(const Unit&) const { return false; }
    __device__ __forceinline__ void operator()(f32x4 (&acc)[2][2][4][2], const Unit& u, int wr, int wc, int fr, int fq, const int AI0 = 0, const int AI1 = 2) const {
        const int pn = u.pn, row0 = u.pm * BM + wr * 64 + fr, col0 = 256 * (pn & 3) + wc * 32 + 8 * fq;
        if (pn < 4 || (pn >= 24 && pn < 28)) {
            unsigned char* o8 = pn < 4 ? OG8 : V8;
#pragma unroll
            for (int ai = AI0; ai < AI1; ++ai)
#pragma unroll
                for (int m = 0; m < 4; ++m) { unsigned char* rowp = o8 + (size_t)(row0 + ai * HALF + m * 16) * 1024 + col0;
#pragma unroll
                    for (int bj = 0; bj < 2; ++bj) { const f32x4 v0 = acc[ai][bj][m][0] * WSCALE_INV, v1 = acc[ai][bj][m][1] * WSCALE_INV; int w0 = 0, w1 = 0;
                        w0 = __builtin_amdgcn_cvt_pk_fp8_f32(v0[0], v0[1], w0, false); w0 = __builtin_amdgcn_cvt_pk_fp8_f32(v0[2], v0[3], w0, true);
                        w1 = __builtin_amdgcn_cvt_pk_fp8_f32(v1[0], v1[1], w1, false); w1 = __builtin_amdgcn_cvt_pk_fp8_f32(v1[2], v1[3], w1, true);
                        typedef int i32x2_ __attribute__((ext_vector_type(2))); *(i32x2_*)(rowp + bj * HALF) = (i32x2_){w0, w1}; } }
            return;
        }
        bf16_t* dst = pn < 8 ? MAb : MBb; int ld = 1024; float sc = WSCALE_INV;
        if (pn >= 12) {
            if (pn < 24) { dst = HYb + 256 * (pn - 12) - 256 * (pn & 3); ld = 3072; }
            else if (pn < 30) { dst = Kb + 256 * (pn - 28) - 256 * (pn & 3); ld = 512; }
            else { dst = Qb + 256 * (pn - 30) - 256 * (pn & 3); ld = 512; sc = WSCALE_INV * 0.08838834764831845f; }
        }
#pragma unroll
        for (int ai = AI0; ai < AI1; ++ai)
#pragma unroll
            for (int m = 0; m < 4; ++m) { bf16_t* rowp = dst + (size_t)(row0 + ai * HALF + m * 16) * ld + col0;
#pragma unroll
                for (int bj = 0; bj < 2; ++bj) { const f32x4 v0 = acc[ai][bj][m][0] * sc, v1 = acc[ai][bj][m][1] * sc;
                    u32x4 w; w.x = cvt_pk_bf16(v0[0], v0[1]); w.y = cvt_pk_bf16(v0[2], v0[3]); w.z = cvt_pk_bf16(v1[0], v1[1]); w.w = cvt_pk_bf16(v1[2], v1[3]);
                    *(u32x4*)(rowp + bj * HALF) = w; } }
    }
};
__device__ __forceinline__ void unpack8(const u32x4 w, float (&f)[8]) {
    f[0] = __builtin_bit_cast(float, w.x << 16); f[1] = __builtin_bit_cast(float, w.x & 0xffff0000u); f[2] = __builtin_bit_cast(float, w.y << 16); f[3] = __builtin_bit_cast(float, w.y & 0xffff0000u);
    f[4] = __builtin_bit_cast(float, w.z << 16); f[5] = __builtin_bit_cast(float, w.z & 0xffff0000u); f[6] = __builtin_bit_cast(float, w.w << 16); f[7] = __builtin_bit_cast(float, w.w & 0xffff0000u);
}
template <int MODE> struct EpiGate {
    static constexpr bool PERM = true, AFTER_DRAIN = false; static constexpr int ID = 3; static constexpr int NSTH = 8; __device__ __forceinline__ bool relax_ok(const Unit& u) const { return false; }
    const bf16_t* gate; float* YA; bf16_t* YM;
    __device__ __forceinline__ bool keep(const Unit&) const { return false; }
    __device__ __forceinline__ void operator()(f32x4 (&acc)[2][2][4][2], const Unit& u, int wr, int wc, int fr, int fq, const int AI0 = 0, const int AI1 = 2) const {
        const int row0 = u.pm * BM + wr * 64 + fr, col0 = u.pn * BM + wc * 32 + 8 * fq;
#pragma unroll
        for (int ai = AI0; ai < AI1; ++ai)
#pragma unroll
            for (int m = 0; m < 4; ++m) { const size_t ro = (size_t)(row0 + ai * HALF + m * 16) * 1024 + col0;
#pragma unroll
                for (int bj = 0; bj < 2; ++bj) { const size_t o = ro + bj * HALF;
                    float g[8]; unpack8(*(const u32x4*)(gate + o), g);
                    f32x4 v0 = acc[ai][bj][m][0], v1 = acc[ai][bj][m][1];
#pragma unroll
                    for (int j = 0; j < 4; ++j) { v0[j] *= g[j]; v1[j] *= g[4 + j]; }
                    if (MODE == 0) { *(f32x4*)(YA + o) = v0; *(f32x4*)(YA + o + 4) = v1; }
                    else { const f32x4 a0 = *(const f32x4*)(YA + o), a1 = *(const f32x4*)(YA + o + 4); v0 += a0; v1 += a1;
                        u32x4 w; w.x = cvt_pk_bf16(v0[0], v0[1]); w.y = cvt_pk_bf16(v0[2], v0[3]); w.z = cvt_pk_bf16(v1[0], v1[1]); w.w = cvt_pk_bf16(v1[2], v1[3]);
                        *(u32x4*)(YM + o) = w; } } }
    }
};

struct SchedPair {
    const char* A; const char* B; unsigned a0, a1, b0, b1; int nM, nN, G, c;
    __device__ __forceinline__ bool next(int i, Unit& u) const {
        const int L = (i >> 1) * G + c; u.e = i & 1; if (L >= nM * nN) return false;
        tile_order(L, nM, nN, u.pm, u.pn); return true;
    }
    __device__ __forceinline__ unsigned aoff(const Unit& u) const { return (u.e ? a1 : a0) + (unsigned)u.pm * (256u * 1024 * 2); }
    __device__ __forceinline__ unsigned boff(const Unit& u) const { return (u.e ? b1 : b0) + (unsigned)u.pn * (256u * 1024 * 2); }
    __device__ __forceinline__ void a_ready(const Unit&) const {}
    __device__ __forceinline__ void done(const Unit&) const {}
};
struct EpiMix {
    static constexpr bool PERM = true, AFTER_DRAIN = false; static constexpr int ID = 4; static constexpr int NSTH = 8; __device__ __forceinline__ bool relax_ok(const Unit& u) const { return u.e == 1; }
    const bf16_t* MA; const bf16_t* MB; bf16_t* YM;
    __device__ __forceinline__ bool keep(const Unit& u) const { return u.e == 0; }
    __device__ __forceinline__ void operator()(f32x4 (&acc)[2][2][4][2], const Unit& u, int wr, int wc, int fr, int fq, const int AI0 = 0, const int AI1 = 2) const {
        const int row0 = u.pm * BM + wr * 64 + fr, col0 = u.pn * BM + wc * 32 + 8 * fq;
#pragma unroll
        for (int ai = AI0; ai < AI1; ++ai)
#pragma unroll
            for (int m = 0; m < 4; ++m) { const size_t ro = (size_t)(row0 + ai * HALF + m * 16) * 1024 + col0;
#pragma unroll
                for (int bj = 0; bj < 2; ++bj) { const size_t o = ro + bj * HALF;
                    float gb[8]; unpack8(*(const u32x4*)(MB + o), gb);
#pragma unroll
                    for (int j = 0; j < 8; ++j) gb[j] = act_apply(gb[j], 2);
                    if (u.e == 0) { float ga[8]; unpack8(*(const u32x4*)(MA + o), ga);
#pragma unroll
                        for (int j = 0; j < 8; ++j) ga[j] = act_apply(ga[j], 2);
#pragma unroll
                        for (int j = 0; j < 4; ++j) { acc[ai][bj][m][0][j] *= ga[j] * __builtin_amdgcn_rcpf(fmaxf(gb[j], 1e-30f)); acc[ai][bj][m][1][j] *= ga[4 + j] * __builtin_amdgcn_rcpf(fmaxf(gb[4 + j], 1e-30f)); }
                    } else {
                        f32x4 v0 = acc[ai][bj][m][0], v1 = acc[ai][bj][m][1];
#pragma unroll
                        for (int j = 0; j < 4; ++j) { v0[j] *= gb[j]; v1[j] *= gb[4 + j]; }
                        u32x4 w; w.x = cvt_pk_bf16(v0[0], v0[1]); w.y = cvt_pk_bf16(v0[2], v0[3]); w.z = cvt_pk_bf16(v1[0], v1[1]); w.w = cvt_pk_bf16(v1[2], v1[3]);
                        *(u32x4*)(YM + o) = w; } } }
    }
};
struct EpiRes {
    static constexpr bool PERM = true, AFTER_DRAIN = false; static constexpr int ID = 5; static constexpr int NSTH = 8; __device__ __forceinline__ bool relax_ok(const Unit& u) const { return true; }
    const float* x; const float* mod; bf16_t* out;
    __device__ __forceinline__ bool keep(const Unit&) const { return false; }
    __device__ __forceinline__ void operator()(f32x4 (&acc)[2][2][4][2], const Unit& u, int wr, int wc, int fr, int fq, const int AI0 = 0, const int AI1 = 2) const {
        const int row0 = u.pm * BM + wr * 64 + fr, col0 = u.pn * BM + wc * 32 + 8 * fq;
        const float* g1 = mod + (size_t)(u.pm >> 3) * 6144 + 2048 + col0;
        f32x4 gv[2][2];
#pragma unroll
        for (int bj = 0; bj < 2; ++bj) { gv[bj][0] = *(const f32x4*)(g1 + bj * HALF); gv[bj][1] = *(const f32x4*)(g1 + bj * HALF + 4); }
#pragma unroll
        for (int ai = AI0; ai < AI1; ++ai)
#pragma unroll
            for (int m = 0; m < 4; ++m) { const size_t ro = (size_t)(row0 + ai * HALF + m * 16) * 1024 + col0;
#pragma unroll
                for (int bj = 0; bj < 2; ++bj) { const size_t o = ro + bj * HALF;
                    const f32x4 x0 = *(const f32x4*)(x + o), x1 = *(const f32x4*)(x + o + 4);
                    const f32x4 v0 = x0 + gv[bj][0] * acc[ai][bj][m][0], v1 = x1 + gv[bj][1] * acc[ai][bj][m][1];
                    u32x4 w; w.x = cvt_pk_bf16(v0[0], v0[1]); w.y = cvt_pk_bf16(v0[2], v0[3]); w.z = cvt_pk_bf16(v1[0], v1[1]); w.w = cvt_pk_bf16(v1[2], v1[3]);
                    *(u32x4*)(out + o) = w; } }
    }
};
struct EpiUp {
    static constexpr bool PERM = true, AFTER_DRAIN = false; static constexpr int ID = 6; static constexpr int NSTH = 4; __device__ __forceinline__ bool relax_ok(const Unit& u) const { return true; }
    const float* b_up; unsigned char* ACT;
    __device__ __forceinline__ bool keep(const Unit&) const { return false; }
    __device__ __forceinline__ void operator()(f32x4 (&acc)[2][2][4][2], const Unit& u, int wr, int wc, int fr, int fq, const int AI0 = 0, const int AI1 = 2) const {
        const int row0 = u.pm * BM + wr * 64 + fr, f0 = u.pn * 128 + wc * 32 + 8 * fq;
        const float* bp = b_up + (size_t)u.e * 2048 + 2 * f0;
        f32x4 bb[4];
#pragma unroll
        for (int q = 0; q < 4; ++q) bb[q] = *(const f32x4*)(bp + 4 * q);
        float bg[8], bl[8];
#pragma unroll
        for (int q = 0; q < 4; ++q) { bg[2 * q] = bb[q][0]; bl[2 * q] = bb[q][1]; bg[2 * q + 1] = bb[q][2]; bl[2 * q + 1] = bb[q][3]; }
#pragma unroll
        for (int ai = AI0; ai < AI1; ++ai)
#pragma unroll
            for (int m = 0; m < 4; ++m) { unsigned char* rowp = ACT + (size_t)(row0 + ai * HALF + m * 16) * 1024 + f0;
                float r[8];
#pragma unroll
                for (int n = 0; n < 2; ++n)
#pragma unroll
                    for (int j = 0; j < 4; ++j) { float gl = acc[ai][0][m][n][j] * WSCALE_INV + bg[4 * n + j], li = acc[ai][1][m][n][j] * WSCALE_INV + bl[4 * n + j];
                        gl = fminf(gl, 7.f); li = fminf(fmaxf(li, -7.f), 7.f);
                        r[4 * n + j] = gl * __builtin_amdgcn_rcpf(1.f + __expf(-1.702f * gl)) * (li + 1.f); }
                int w0 = 0, w1 = 0;
                w0 = __builtin_amdgcn_cvt_pk_fp8_f32(r[0], r[1], w0, false); w0 = __builtin_amdgcn_cvt_pk_fp8_f32(r[2], r[3], w0, true);
                w1 = __builtin_amdgcn_cvt_pk_fp8_f32(r[4], r[5], w1, false); w1 = __builtin_amdgcn_cvt_pk_fp8_f32(r[6], r[7], w1, true);
                typedef int i32x2_ __attribute__((ext_vector_type(2)));
                *(i32x2_*)rowp = (i32x2_){w0, w1}; }
    }
};
constexpr float YSCALE = 16.f, YSCALE_INV = 1.f / 16.f;
struct EpiDown {
    static constexpr bool PERM = true, AFTER_DRAIN = false; static constexpr int ID = 7; static constexpr int NSTH = 8; __device__ __forceinline__ bool relax_ok(const Unit& u) const { return true; }
    const float* b_dn; const float* roww; unsigned char* Y;
    __device__ __forceinline__ bool keep(const Unit&) const { return false; }
    __device__ __forceinline__ void operator()(f32x4 (&acc)[2][2][4][2], const Unit& u, int wr, int wc, int fr, int fq, const int AI0 = 0, const int AI1 = 2) const {
        const int row0 = u.pm * BM + wr * 64 + fr, col0 = u.pn * BM + wc * 32 + 8 * fq;
        const float* bp = b_dn + (size_t)u.e * 1024 + col0;
        f32x4 bv[2][2];
#pragma unroll
        for (int bj = 0; bj < 2; ++bj) { bv[bj][0] = *(const f32x4*)(bp + bj * HALF); bv[bj][1] = *(const f32x4*)(bp + bj * HALF + 4); }
#pragma unroll
        for (int ai = AI0; ai < AI1; ++ai)
#pragma unroll
            for (int m = 0; m < 4; ++m) { const int row = row0 + ai * HALF + m * 16; const float rw = roww[row] * YSCALE; unsigned char* rowp = Y + (size_t)row * 1024 + col0;
#pragma unroll
                for (int bj = 0; bj < 2; ++bj) { const f32x4 v0 = (acc[ai][bj][m][0] * WSCALE_INV + bv[bj][0]) * rw, v1 = (acc[ai][bj][m][1] * WSCALE_INV + bv[bj][1]) * rw;
                    int w0 = 0, w1 = 0;
                    w0 = __builtin_amdgcn_cvt_pk_fp8_f32(v0[0], v0[1], w0, false); w0 = __builtin_amdgcn_cvt_pk_fp8_f32(v0[2], v0[3], w0, true);
                    w1 = __builtin_amdgcn_cvt_pk_fp8_f32(v1[0], v1[1], w1, false); w1 = __builtin_amdgcn_cvt_pk_fp8_f32(v1[2], v1[3], w1, true);
                    typedef int i32x2_ __attribute__((ext_vector_type(2)));
                    *(i32x2_*)(rowp + bj * HALF) = (i32x2_){w0, w1}; } }
    }
};
}

template <class RowMap>
__device__ __forceinline__ void p0_transpose_item(const float* W, int K, int N, bf16* WT, LAS unsigned char* scr, int item, int lane, const RowMap& rm) {
    const int nblk = N / 32, kb = item / nblk, nb = item % nblk, k0 = 64 * kb, n0 = 32 * nb;
    const int kr = lane >> 3, c4 = lane & 7;
    f32x4 v[8];
#pragma unroll
    for (int it = 0; it < 8; ++it) v[it] = *(const f32x4*)(W + (size_t)(k0 + 8 * it + kr) * N + n0 + 4 * c4);
    float sc[4];
#pragma unroll
    for (int q = 0; q < 4; ++q) (void)rm(n0 + 4 * c4 + q, sc[q]);
#pragma unroll
    for (int it = 0; it < 8; ++it)
#pragma unroll
        for (int q = 0; q < 4; ++q) *(LAS bf16*)(scr + (4 * c4 + q) * 144 + 2 * (8 * it + kr)) = (bf16)f2bf(v[it][q] * sc[q]);
    LDS_WAIT(); asm volatile("" ::: "memory");
#pragma unroll
    for (int j = 0; j < 4; ++j) { const int n = (lane >> 3) + 8 * j, c = lane & 7; float dummy; const int drow = rm(n0 + n, dummy);
        *(v4u*)(WT + (size_t)drow * K + k0 + 8 * c) = *(const LAS v4u*)(scr + n * 144 + 16 * c); }
    LDS_WAIT(); asm volatile("" ::: "memory");
}
struct RmId { __device__ __forceinline__ int operator()(int n, float& sc) const { sc = 1.f; return n; } };
struct RmWin {
    __device__ __forceinline__ int operator()(int n, float& sc) const {
        sc = 1.f;
        if (n < 512) { sc = 0.08838834764831845f; return 7 * 256 + n; }
        if (n < 1024) return n - 512;
        if (n < 2048) return 2 * 256 + (n - 1024);
        if (n < 3072) return 9 * 256 + (n - 2048);
        if (n < 3104) return 6 * 256 + (n - 3072);
        if (n < 6176) return 13 * 256 + (n - 3104);
        if (n < 7200) return 25 * 256 + (n - 6176);
        return 29 * 256 + (n - 7200);
    }
};
struct RmUp {
    __device__ __forceinline__ int operator()(int n, float& sc) const { sc = 1.f; const int f = n >> 1; return 256 * (f >> 7) + 128 * (n & 1) + (f & 127); }
};

template <class RowMap>
__device__ __forceinline__ void fp8_transpose_kn(const float* W, int K, int N, unsigned char* WT, LAS unsigned char* scr, int kb, int nb, int lane, const RowMap& rm) {
    const int k0 = 128 * kb, n0 = 32 * nb;
    const int kg = lane >> 3, c4 = lane & 7;
    f32x4 v[16];
#pragma unroll
    for (int i = 0; i < 16; ++i) v[i] = *(const f32x4*)(W + (size_t)(k0 + 16 * kg + i) * N + n0 + 4 * c4);
#pragma unroll
    for (int q = 0; q < 4; ++q) { int wd[4];
#pragma unroll
        for (int d2 = 0; d2 < 4; ++d2) { int w0 = 0;
            w0 = __builtin_amdgcn_cvt_pk_fp8_f32(v[4 * d2][q] * pg8::WSCALE, v[4 * d2 + 1][q] * pg8::WSCALE, w0, false);
            w0 = __builtin_amdgcn_cvt_pk_fp8_f32(v[4 * d2 + 2][q] * pg8::WSCALE, v[4 * d2 + 3][q] * pg8::WSCALE, w0, true); wd[d2] = w0; }
        *(LAS v4u*)(scr + (4 * c4 + q) * 144 + 16 * kg) = (v4u){(unsigned)wd[0], (unsigned)wd[1], (unsigned)wd[2], (unsigned)wd[3]}; }
    LDS_WAIT(); asm volatile("" ::: "memory");
#pragma unroll
    for (int j = 0; j < 4; ++j) { const int n = (lane >> 3) + 8 * j, c = lane & 7; float dummy; const int drow = rm(n0 + n, dummy);
        *(v4u*)(WT + (size_t)drow * K + k0 + 16 * c) = *(const LAS v4u*)(scr + n * 144 + 16 * c); }
    LDS_WAIT(); asm volatile("" ::: "memory");
}
template <class RowMap>
__device__ __forceinline__ void fp8_transpose_item(const float* W, int K, int N, unsigned char* WT, LAS unsigned char* scr, int item, int lane, const RowMap& rm) {
    const int nblk = N / 32; fp8_transpose_kn(W, K, N, WT, scr, item / nblk, item % nblk, lane, rm);
}
struct RmG8 {
    __device__ __forceinline__ int operator()(int n, float& sc) const { sc = 1.f;
        if (n < 512) return 7680 + n;
        if (n < 1024) return 7168 + (n - 512);
        if (n < 2048) return 6144 + (n - 1024);
        if (n < 3072) return n - 2048;
        if (n < 6176) return 3072 + (n - 3104);
        return n < 7200 ? 1024 + (n - 6176) : 2048 + (n - 7200); }
};

__device__ __forceinline__ float hy_mlp(const Frame& F, int t) {
    const int lane = F.lane;
    const float tn = (float)t * (1.f / 2047.f);
    float zv = 0.f;
    if (lane == 0) zv = tn;
    else if (lane <= 32) { const int i = (lane - 1) & 15; const float f = 1e-4f + (float)i * ((15.f - 1e-4f) / 15.f); const float rev = (float)t * f * (1.f / 2048.f);
        zv = (lane <= 16) ? __builtin_amdgcn_cosf(rev) : -__builtin_amdgcn_sinf(rev); }
    const float fr = F.in[I_HFREQ][lane];
    const float inv2pi = 0.15915494309189535f;
    float a = F.in[I_HB1][lane];
#pragma unroll 11
    for (int i = 0; i < 33; ++i) a += __shfl(zv, i) * F.in[I_HW1][i * 64 + lane];
    float h = __builtin_amdgcn_sinf(fr * a * inv2pi);
    a = F.in[I_HB2][lane];
#pragma unroll 16
    for (int i = 0; i < 64; ++i) a += __shfl(h, i) * F.in[I_HW2][i * 64 + lane];
    h = __builtin_amdgcn_sinf(fr * a * inv2pi);
    a = F.in[I_HB3][lane];
#pragma unroll 16
    for (int i = 0; i < 64; ++i) a += __shfl(h, i) * F.in[I_HW3][i * 64 + lane];
    return __builtin_amdgcn_sinf(fr * a * inv2pi);
}

__device__ __forceinline__ void p0_prologue(Frame& F) {
    const int blk = blockIdx.x;
    for (int item = blk; item < 192; item += F.G) {
        LAS float* scr = (LAS float*)(F.lds + F.wave * 16384);
        const int k0 = 128 * F.wave;
        for (int idx = F.lane; idx < 17 * 128; idx += 64) { const int b = idx >> 7, kk = idx & 127;
            const float cv = (b < 16) ? F.in[I_C][b * 1024 + k0 + kk] : F.in[I_CCTX][k0 + kk];
            scr[kk * 20 + b] = cv * sigmoidf_(cv); }
        LDS_WAIT(); asm volatile("" ::: "memory");
        float acc[17];
#pragma unroll
        for (int b = 0; b < 17; ++b) acc[b] = 0.f;
        const int hl = F.lane >> 5, cl = F.lane & 31;
        const float* wp = F.in[I_WADA] + (size_t)(k0 + hl) * 6144 + 32 * item + cl;
#pragma nounroll
        for (int kb = 0; kb < 64; kb += 32) {
            float wv[32];
#pragma unroll
            for (int i = 0; i < 32; ++i) wv[i] = wp[(size_t)(2 * (kb + i)) * 6144];
#pragma unroll
            for (int i = 0; i < 32; ++i) { const LAS float* sp = scr + (2 * (kb + i) + hl) * 20;
                const f32x4 s0 = *(const LAS f32x4*)sp, s1 = *(const LAS f32x4*)(sp + 4), s2 = *(const LAS f32x4*)(sp + 8), s3 = *(const LAS f32x4*)(sp + 12); const float s4 = sp[16];
#pragma unroll
                for (int q = 0; q < 4; ++q) { acc[q] += s0[q] * wv[i]; acc[4 + q] += s1[q] * wv[i]; acc[8 + q] += s2[q] * wv[i]; acc[12 + q] += s3[q] * wv[i]; }
                acc[16] += s4 * wv[i]; }
        }
#pragma unroll
        for (int b = 0; b < 17; ++b) acc[b] += __shfl_xor(acc[b], 32);
        if (hl == 0) {
#pragma unroll
            for (int b = 0; b < 17; ++b) scr[2560 + b * 32 + cl] = acc[b]; }
        __syncthreads();
        for (int o = F.tid; o < 17 * 32; o += 512) { float s = F.in[I_BADA][32 * item + (o & 31)];
#pragma unroll
            for (int w = 0; w < 8; ++w) s += ((LAS float*)(F.lds + w * 16384))[2560 + o];
            ((float*)(F.ws + WS_MOD))[(size_t)(o >> 5) * 6144 + 32 * item + (o & 31)] = s; }
        __syncthreads();
    }
    for (int m = blk; m < 256; m += F.G) {
        LAS float* HS = (LAS float*)F.lds;
        LAS bf16* T = (LAS bf16*)(F.lds + 4096);
        { const float h3 = hy_mlp(F, 8 * m + F.wave); HS[F.wave * 64 + F.lane] = h3; }
        __syncthreads();
        const int cidx = 256 * F.wave + 4 * F.lane;
        f32x4 acc[8];
#pragma unroll
        for (int p = 0; p < 8; ++p) acc[p] = (f32x4){0.f, 0.f, 0.f, 0.f};
        const float* w4 = F.in[I_HW4] + cidx;
#pragma unroll 8
        for (int i = 0; i < 64; ++i) { const f32x4 wv = *(const f32x4*)(w4 + (size_t)i * 2048);
#pragma unroll
            for (int p = 0; p < 8; ++p) acc[p] += HS[p * 64 + i] * wv; }
        const bool fwd = F.wave < 4;
        const float a0 = -3.0701134573253944f, a1 = -15.350567286626972f;
#pragma unroll
        for (int cc = 0; cc < 4; ++cc) { const int c = (cidx & 1023) + cc; const float delta = fabsf(a0 + (float)c * ((a1 - a0) / 1023.f));
#pragma unroll
            for (int p = 0; p < 8; ++p) { const int t = 8 * m + p; float val = acc[p][cc] * __expf(-(float)t * (1.f / 2047.f) * delta);
                if (fwd && t == 0) val += F.in[I_HBIAS][c];
                T[(fwd ? c : 1024 + c) * 8 + (fwd ? 7 - p : p)] = (bf16)f2bf(val); } }
        __syncthreads();
        bf16* HR = (bf16*)(F.ws + WS_HR);
#pragma nounroll
        for (int ri = F.tid; ri < 2048; ri += 512) { const int dir = ri >> 10, c = ri & 1023; const LAS bf16* tp = T + ri * 8;
            if (dir) {
                bf16* hr = HR + (size_t)c * HRL + 2048 + 8 * m;
                const v4u v = *(const LAS v4u*)tp;
                if (m == 0) { hr[1] = (bf16)(v.x >> 16); *(unsigned*)(hr + 2) = v.y; *(v2u*)(hr + 4) = (v2u){v.z, v.w}; }
                else *(v4u*)hr = v;
            } else {
                bf16* hr = HR + (size_t)c * HRL + 2041 - 8 * m;
                const v4u v = *(const LAS v4u*)tp;
                hr[0] = (bf16)(v.x & 0xffffu); *(unsigned*)(hr + 1) = (v.x >> 16) | (v.y << 16); *(v2u*)(hr + 3) = (v2u){(v.y >> 16) | (v.z << 16), (v.z >> 16) | (v.w << 16)}; hr[7] = (bf16)(v.w >> 16);
            } }
        if (m == 255) for (int c = F.tid; c < 1024; c += 512) { bf16* hr = HR + (size_t)c * HRL; hr[0] = 0; *(v4u*)(hr + 4096) = (v4u){0u, 0u, 0u, 0u}; }
        __syncthreads();
    }
    {
        LAS unsigned char* scr = F.lds + F.wave * 8192;
        const int gw = F.vcu * NWAVES + F.wave, NGW = F.G * NWAVES;
        constexpr int I_IN = 16 * 257, I_SQ = 16 * 32;
        constexpr int NB8 = pg8::NF81 * 8;
        constexpr int NITEMS = I_IN + 3 * I_SQ + 8 * NB8;
        for (int it = gw; it < NITEMS; it += NGW) {
            int r = it;
            if (r < I_IN) { p0_transpose_item(F.in[I_WIN], 1024, 8224, (bf16*)(F.ws + WS_WB1), scr, r, F.lane, RmWin()); continue; } r -= I_IN;
            if (r < I_SQ) { p0_transpose_item(F.in[I_WGLAO], 1024, 1024, (bf16*)(F.ws + WS_WG), scr, r, F.lane, RmId()); continue; } r -= I_SQ;
            if (r < I_SQ) { p0_transpose_item(F.in[I_WHYO], 1024, 1024, (bf16*)(F.ws + WS_WH), scr, r, F.lane, RmId()); continue; } r -= I_SQ;
            if (r < I_SQ) { p0_transpose_item(F.in[I_WOUT], 1024, 1024, (bf16*)(F.ws + WS_WO), scr, r, F.lane, RmId()); continue; } r -= I_SQ;
            { const int kb = r / NB8, s2_ = r % NB8, s2 = (G1CFG >= 4 && s2_ >= 96) ? s2_ + 96 : s2_, nb = s2 < 32 ? 64 + s2 : s2 < 96 ? 193 + (s2 - 32) : s2 < 192 ? 97 + (s2 - 96) : s2 < 224 ? 32 + (s2 - 192) : s2 - 224;
              fp8_transpose_kn(F.in[I_WIN], 1024, 8224, F.ws + WS_WB8, scr, kb, nb, F.lane, RmG8()); }
        }
    }
    __syncthreads();
}

__device__ __forceinline__ void p1_norm(Frame& F) {
    const int gw = F.vcu * NWAVES + F.wave, NGW = F.G * NWAVES;
    const float* mod = (const float*)(F.ws + WS_MOD);
    bf16* HX = (bf16*)(F.ws + WS_HX);
    for (int r0 = gw; r0 < NROW; r0 += 2 * NGW) {
        f32x4 v[2][4];
#pragma unroll
        for (int rr = 0; rr < 2; ++rr) { const int row = r0 + rr * NGW; if (row < NROW) {
            const float* xr = row < NTOK ? F.in[I_X] + (size_t)row * 1024 : F.in[I_CTX] + (size_t)(row - NTOK) * 1024;
#pragma unroll
            for (int j = 0; j < 4; ++j) v[rr][j] = *(const f32x4*)(xr + 4 * F.lane + 256 * j); } }
#pragma unroll
        for (int rr = 0; rr < 2; ++rr) { const int row = r0 + rr * NGW; if (row < NROW) {
            const int b = row < NTOK ? (row >> 11) : 16; const float* mb = mod + (size_t)b * 6144; float ss = 0.f;
#pragma unroll
            for (int j = 0; j < 4; ++j) ss += (v[rr][j].x * v[rr][j].x + v[rr][j].y * v[rr][j].y) + (v[rr][j].z * v[rr][j].z + v[rr][j].w * v[rr][j].w);
            const float rs = __builtin_amdgcn_rsqf(wave_sum(ss) * (1.f / 1024.f) + EPS);
#pragma unroll
            for (int j = 0; j < 4; ++j) { const int col = 4 * F.lane + 256 * j;
                const f32x4 w = *(const f32x4*)(F.in[I_NMIX] + col), sh = *(const f32x4*)(mb + col), sc = *(const f32x4*)(mb + 1024 + col);
                const f32x4 y = (v[rr][j] * rs) * w * (sc + 1.f) + sh;
                v2u o; o.x = pk2(y.x, y.y); o.y = pk2(y.z, y.w);
                *(v2u*)(HX + (size_t)row * 1024 + col) = o;
                if (row < NTOK) { int w8 = 0; w8 = __builtin_amdgcn_cvt_pk_fp8_f32(y.x, y.y, w8, false); w8 = __builtin_amdgcn_cvt_pk_fp8_f32(y.z, y.w, w8, true); *(int*)(F.ws + WS_HX8 + (size_t)row * 1024 + col) = w8; } } } }
    }
}

constexpr int GL_QD = 0, GL_KI = 17408, GL_WGK = 34816, GL_BIAS = 43008;
constexpr float QSCALE = 16.f, QSCALE_INV = 1.f / 16.f;
__device__ __forceinline__ f32x4 mfma16(bf16x8 a, bf16x8 b, f32x4 c) { return __builtin_amdgcn_mfma_f32_16x16x32_bf16(a, b, c, 0, 0, 0); }
#define DPP_ADDM(v, ctrl, rmask) ((v) + __builtin_bit_cast(float, __builtin_amdgcn_update_dpp(0, __builtin_bit_cast(int, (v)), (ctrl), (rmask), 0xf, true)))
__device__ __forceinline__ float wave_incl_scan(float v) {
    v = DPP_ADDM(v, 0x111, 0xf); v = DPP_ADDM(v, 0x112, 0xf); v = DPP_ADDM(v, 0x114, 0xf); v = DPP_ADDM(v, 0x118, 0xf);
    v = DPP_ADDM(v, 0x142, 0xa);
    v = DPP_ADDM(v, 0x143, 0xc);
    return v;
}
constexpr int XW_UP = 8 * 8, XW_DN = 8 * 4, XW_NIT = NE * (XW_UP + XW_DN), XW_LDS = 49152;
#define XW_DECODE(it_) const bool isup_ = (it_) < NE * XW_UP; const int r_ = isup_ ? (it_) : (it_) - NE * XW_UP; const int sh_ = isup_ ? 6 : 5; const int e_ = r_ >> sh_, q_ = r_ & ((1 << sh_) - 1); \
        const int N_ = isup_ ? 2048 : 1024, kb_ = q_ >> (sh_ - 3), nb_ = q_ & ((1 << (sh_ - 3)) - 1); const float* W_ = (isup_ ? F.in[I_WUP] : F.in[I_WDN]) + (size_t)e_ * 1024 * N_;
#define XW_LOAD(it_) do { XW_DECODE(it_) _Pragma("unroll") for (int i = 0; i < 16; ++i) vn[i] = *(const f32x4*)(W_ + (size_t)(128 * kb_ + 16 * F.wave + i) * N_ + 256 * nb_ + 4 * F.lane); } while (0)
#define XW_CONVERT(T_) do { _Pragma("unroll") for (int q = 0; q < 4; ++q) { int wd[4]; \
            _Pragma("unroll") for (int d2 = 0; d2 < 4; ++d2) { int w0 = 0; \
                w0 = __builtin_amdgcn_cvt_pk_fp8_f32(vn[4 * d2][q] * pg8::WSCALE, vn[4 * d2 + 1][q] * pg8::WSCALE, w0, false); \
                w0 = __builtin_amdgcn_cvt_pk_fp8_f32(vn[4 * d2 + 2][q] * pg8::WSCALE, vn[4 * d2 + 3][q] * pg8::WSCALE, w0, true); wd[d2] = w0; } \
            *(LAS v4u*)((T_) + (4 * F.lane + q) * 144 + 16 * F.wave) = (v4u){(unsigned)wd[0], (unsigned)wd[1], (unsigned)wd[2], (unsigned)wd[3]}; } } while (0)
#define XW_STORE(it_, T_) do { XW_DECODE(it_) (void)W_; unsigned char* WT = F.ws + (isup_ ? WS_WUP : WS_WDN) + (size_t)e_ * N_ * 1024; \
          _Pragma("unroll") for (int j = 0; j < 4; ++j) { const int p = F.tid + 512 * j, row = p >> 3, c = p & 7; const int n = 256 * nb_ + row; \
              const int drow = isup_ ? (256 * ((n >> 1) >> 7) + 128 * (n & 1) + ((n >> 1) & 127)) : n; \
              *(v4u*)(WT + (size_t)drow * 1024 + 128 * kb_ + 16 * c) = *(const LAS v4u*)((T_) + row * 144 + 16 * c); } } while (0)
__device__ __forceinline__ void gla_prep(Frame& F) {
    const int tid = F.tid, lane = F.lane, w = F.wave, fr = lane & 15, fq = lane >> 4;
    LAS unsigned char* L = F.lds;
    const bf16* Qb = (const bf16*)(F.ws + WS_QB); const bf16* Kb = (const bf16*)(F.ws + WS_KB); const float* Rf = (const float*)(F.ws + WS_RF);
    int cur_hd = -1;
    f32x4 r4n[4]; v4u kvn[2], qvn[2];
#define GP_LOAD(uu) do { const int dir_ = (uu) & 1, h_ = ((uu) >> 1) & 3, cg_ = (uu) >> 3; const bool ic_ = cg_ >= 512; \
        const size_t row_ = (size_t)((ic_ ? (NTOK + ((cg_ - 512) >> 2) * 256 + 64 * ((cg_ - 512) & 3)) : ((cg_ >> 5) * 2048 + 64 * (cg_ & 31))) + lane); \
        _Pragma("unroll") for (int q = 0; q < 4; ++q) r4n[q] = *(const f32x4*)(Rf + row_ * 32 + 16 * dir_ + 4 * q); \
        _Pragma("unroll") for (int q = 0; q < 2; ++q) { kvn[q] = *(const v4u*)(Kb + row_ * 512 + 128 * h_ + 16 * w + 8 * q); qvn[q] = ic_ ? (v4u){0u, 0u, 0u, 0u} : *(const v4u*)(Qb + row_ * 512 + 128 * h_ + 16 * w + 8 * q); } } while (0)
    if ((int)blockIdx.x < 576 * 8) GP_LOAD((int)blockIdx.x);
    f32x4 vn[16]; int xit = blockIdx.x, xn = 0, xprev = 0; bool xpend = false; LAS unsigned char* XTp = L + XW_LDS;
    for (int u = blockIdx.x; u < 576 * 8; u += F.G) {
        const int dir = u & 1, h = (u >> 1) & 3, cg = u >> 3;
        const bool isctx = cg >= 512;
        const int rowbase = isctx ? (NTOK + ((cg - 512) >> 2) * 256 + 64 * ((cg - 512) & 3)) : ((cg >> 5) * 2048 + 64 * (cg & 31));
        const size_t row = (size_t)(rowbase + lane);
        f32x4 r4[4]; v4u kv[2], qv[2];
#pragma unroll
        for (int q = 0; q < 4; ++q) r4[q] = r4n[q];
#pragma unroll
        for (int q = 0; q < 2; ++q) { kv[q] = kvn[q]; qv[q] = qvn[q]; }
        if (u + F.G < 576 * 8) GP_LOAD(u + F.G);
        const bool xload = xit < XW_NIT;
        if (xload) XW_LOAD(xit);
        if ((u & 7) != cur_hd) {
            __syncthreads();
            { const int idx = 4 * tid, m = idx >> 7, dd = idx & 127; *(LAS f32x4*)(L + GL_WGK + idx * 4) = *(const f32x4*)(F.in[dir ? I_WGKB : I_WGKF] + m * 512 + 128 * h + dd); }
            if (tid < 32) *(LAS f32x4*)(L + GL_BIAS + 16 * tid) = *(const f32x4*)(F.in[dir ? I_BGKB : I_BGKF] + 128 * h + 4 * tid);
            __syncthreads();
            cur_hd = u & 7;
        }
        float a[16];
#pragma unroll
        for (int q = 0; q < 4; ++q) { const f32x4 bv = *(const LAS f32x4*)(L + GL_BIAS + (16 * w + 4 * q) * 4); a[4 * q] = bv.x; a[4 * q + 1] = bv.y; a[4 * q + 2] = bv.z; a[4 * q + 3] = bv.w; }
#pragma unroll
        for (int m = 0; m < 16; ++m) { const float rm = r4[m >> 2][m & 3];
#pragma unroll
            for (int q = 0; q < 4; ++q) { const f32x4 wv = *(const LAS f32x4*)(L + GL_WGK + (m * 128 + 16 * w + 4 * q) * 4);
                a[4 * q] += rm * wv.x; a[4 * q + 1] += rm * wv.y; a[4 * q + 2] += rm * wv.z; a[4 * q + 3] += rm * wv.w; } }
        const size_t ck = (size_t)(dir * 576 + cg) * 4 + h;
        unsigned qdw[8], kiw[8]; float decv[16]; int ku8[4] = {0, 0, 0, 0}, qd8[4] = {0, 0, 0, 0};
#pragma unroll
        for (int dd = 0; dd < 16; dd += 2) {
            float ei[2], kk2[2], qq2[2], kuv[2];
#pragma unroll
            for (int x = 0; x < 2; ++x) { const float av = a[dd + x];
                const float g = (fminf(av, 0.f) - __logf(1.f + __expf(-fabsf(av)))) * (1.f / 16.f);
                const float incl = wave_incl_scan(g);
                const float tot = __builtin_bit_cast(float, __builtin_amdgcn_readlane(__builtin_bit_cast(int, incl), 63));
                const float bc = dir ? (tot - incl + g) : incl;
                ei[x] = __expf(-bc); const float dec = __expf(tot); decv[dd + x] = dec;
                const unsigned kw = kv[(dd + x) >> 3][((dd + x) >> 1) & 3], qw = qv[(dd + x) >> 3][((dd + x) >> 1) & 3];
                kk2[x] = x ? bfhi(kw) : bflo(kw); qq2[x] = x ? bfhi(qw) : bflo(qw);
                kuv[x] = kk2[x] * (dec * ei[x]); }
            kiw[dd >> 1] = pk2(kk2[0] * ei[0], kk2[1] * ei[1]);
            const float qd0 = qq2[0] * __builtin_amdgcn_rcpf(ei[0]), qd1 = qq2[1] * __builtin_amdgcn_rcpf(ei[1]);
            qdw[dd >> 1] = pk2(qd0, qd1);
            if ((dd >> 1) & 1) { ku8[dd >> 2] = __builtin_amdgcn_cvt_pk_fp8_f32(kuv[0], kuv[1], ku8[dd >> 2], true); qd8[dd >> 2] = __builtin_amdgcn_cvt_pk_fp8_f32(qd0 * QSCALE, qd1 * QSCALE, qd8[dd >> 2], true); }
            else { ku8[dd >> 2] = __builtin_amdgcn_cvt_pk_fp8_f32(kuv[0], kuv[1], ku8[dd >> 2], false); qd8[dd >> 2] = __builtin_amdgcn_cvt_pk_fp8_f32(qd0 * QSCALE, qd1 * QSCALE, qd8[dd >> 2], false); } }
        *(v4u*)(F.ws + WS_KUT + (ck * 64 + lane) * 128 + 16 * w) = (v4u){(unsigned)ku8[0], (unsigned)ku8[1], (unsigned)ku8[2], (unsigned)ku8[3]};
        if (lane == 0) { float* dp = (float*)(F.ws + WS_DEC) + ck * 128 + 16 * w;
#pragma unroll
            for (int q = 0; q < 4; ++q) *(f32x4*)(dp + 4 * q) = (f32x4){decv[4 * q], decv[4 * q + 1], decv[4 * q + 2], decv[4 * q + 3]}; }
        if (!isctx) {
            *(v4u*)(F.ws + WS_QD + (size_t)dir * NTOK * 512 + row * 512 + 128 * h + 16 * w) = (v4u){(unsigned)qd8[0], (unsigned)qd8[1], (unsigned)qd8[2], (unsigned)qd8[3]};
            *(LAS v4u*)(L + GL_QD + lane * 272 + 32 * w) = (v4u){qdw[0], qdw[1], qdw[2], qdw[3]}; *(LAS v4u*)(L + GL_QD + lane * 272 + 32 * w + 16) = (v4u){qdw[4], qdw[5], qdw[6], qdw[7]};
            *(LAS v4u*)(L + GL_KI + lane * 272 + 32 * w) = (v4u){kiw[0], kiw[1], kiw[2], kiw[3]}; *(LAS v4u*)(L + GL_KI + lane * 272 + 32 * w + 16) = (v4u){kiw[4], kiw[5], kiw[6], kiw[7]};
            __syncthreads();
            if (xpend) XW_STORE(xprev, XTp);
            unsigned char* ag = F.ws + WS_ATT + ((size_t)(dir * 512 + cg) * 4 + h) * 4096;
            bf16x8 fa[2][4], fb[2][4];
#pragma unroll
            for (int tt = 0; tt < 2; ++tt) { const int t = 2 * w + tt, jt = t >> 2, it = t & 3;
#pragma unroll
                for (int ks = 0; ks < 4; ++ks) { fa[tt][ks] = *(const LAS bf16x8*)(L + GL_KI + (16 * jt + fr) * 272 + (32 * ks + 8 * fq) * 2); fb[tt][ks] = *(const LAS bf16x8*)(L + GL_QD + (16 * it + fr) * 272 + (32 * ks + 8 * fq) * 2); } }
#pragma unroll
            for (int tt = 0; tt < 2; ++tt) { const int t = 2 * w + tt, jt = t >> 2, it = t & 3;
                f32x4 a4 = (f32x4){0.f, 0.f, 0.f, 0.f};
#pragma unroll
                for (int ks = 0; ks < 4; ++ks) a4 = mfma16(fa[tt][ks], fb[tt][ks], a4);
                const int i = 16 * it + fr;
#pragma unroll
                for (int rgi = 0; rgi < 4; ++rgi) { const int j = 16 * jt + 4 * fq + rgi; const bool keep = dir ? (j >= i) : (j <= i); a4[rgi] = keep ? a4[rgi] : 0.f; }
                int o8 = 0; o8 = __builtin_amdgcn_cvt_pk_fp8_f32(a4[0], a4[1], o8, false); o8 = __builtin_amdgcn_cvt_pk_fp8_f32(a4[2], a4[3], o8, true);
                *(int*)(ag + (16 * it + fr) * 64 + 16 * jt + 4 * fq) = o8; }
            __syncthreads();
        } else if (xpend) { __syncthreads(); XW_STORE(xprev, XTp); }
        xpend = false;
        if (xload) { XTp = L + XW_LDS + (xn & 1) * 36864; XW_CONVERT(XTp); xprev = xit; xpend = true; xit += F.G; ++xn; }
    }
#undef GP_LOAD
    __syncthreads();
    if (xpend) XW_STORE(xprev, XTp);
    __syncthreads();
}

__device__ __forceinline__ void p_expert_weights(Frame& F) {
    const int nun = (int)blockIdx.x < 576 * 8 ? (576 * 8 - 1 - (int)blockIdx.x) / F.G + 1 : 0;
    int it = blockIdx.x + nun * F.G, nit = 0;
    f32x4 vn[16];
    if (it < XW_NIT) XW_LOAD(it);
    for (; it < XW_NIT; it += F.G, ++nit) {
        LAS unsigned char* T = F.lds + (nit & 1) * 36864;
        XW_CONVERT(T);
        if (it + F.G < XW_NIT) XW_LOAD(it + F.G);
        __syncthreads();
        XW_STORE(it, T);
    }
    __syncthreads();
}

constexpr int SC_STAGE = 57856, SC_QD = 0, SC_ATT = 16384, SC_KUT = 24576, SC_VT = 40960, SC_DEC = 57344, SC_ST = 2 * SC_STAGE;
__device__ __forceinline__ int sw16(int row, int c16) { return row * 256 + ((c16 ^ (row & 15)) << 4); }
__device__ __forceinline__ int sw8(int row, int c8) { return row * 128 + ((c8 ^ ((row >> 1) & 7)) << 4); }
constexpr float OSCALE = 1.f / 16.f;
struct ScanRegs { v4u q, a, k, v; f32x4 dec; };
__device__ __forceinline__ void scan_chunk_ids(int b, int dir, int s, bool& isctx, int& cgk, int& cga, int& rowq, int& rowk) {
    isctx = s < 4;
    const int ci = isctx ? (dir ? 3 - s : s) : (dir ? 31 - (s - 4) : (s - 4));
    cgk = isctx ? (512 + b * 4 + ci) : (b * 32 + ci); cga = b * 32 + ci;
    rowq = b * 2048 + 64 * ci; rowk = isctx ? (NTOK + b * 256 + 64 * ci) : rowq;
}
__device__ __forceinline__ void scan_issue(const unsigned char* ws, int tid, int b, int h, int dir, int dvh, int s, ScanRegs& R) {
    bool isctx; int cgk, cga, rowq, rowk; scan_chunk_ids(b, dir, s, isctx, cgk, cga, rowq, rowk);
    const int lane = tid & 63, w = tid >> 6;
    R.k = *(const v4u*)(ws + WS_KUT + (((size_t)(dir * 576 + cgk) * 4 + h) * 64 + lane) * 128 + 16 * w);
    R.v = *(const v4u*)(ws + WS_VB + (size_t)(rowk + lane) * 1024 + 256 * h + 128 * dvh + 16 * w);
    if (tid < 32) R.dec = *(const f32x4*)((const float*)(ws + WS_DEC) + ((size_t)(dir * 576 + cgk) * 4 + h) * 128 + 4 * tid);
    if (!isctx) {
        R.q = *(const v4u*)(ws + WS_QD + (size_t)dir * NTOK * 512 + (size_t)(rowq + (tid >> 3)) * 512 + 128 * h + 16 * (tid & 7));
        if (tid < 256) R.a = *(const v4u*)(ws + WS_ATT + ((size_t)(dir * 512 + cga) * 4 + h) * 4096 + 16 * tid);
    }
}
__device__ __forceinline__ unsigned fp8x2_bf16(int wd, bool hi, float sc) {
    typedef float f32x2_ __attribute__((ext_vector_type(2)));
    const f32x2_ f = hi ? __builtin_amdgcn_cvt_pk_f32_fp8(wd, true) : __builtin_amdgcn_cvt_pk_f32_fp8(wd, false);
    return (__builtin_bit_cast(unsigned, f[0] * sc) >> 16) | (__builtin_bit_cast(unsigned, f[1] * sc) & 0xffff0000u);
}
__device__ __forceinline__ void scan_fill(Frame& F, LAS unsigned char* G, bool isctx, const ScanRegs& R) {
    const int tid = F.tid, lane = F.lane, w = F.wave;
#pragma unroll
    for (int d2 = 0; d2 < 4; ++d2) {
        const unsigned k01 = fp8x2_bf16((int)R.k[d2], false, 1.f), k23 = fp8x2_bf16((int)R.k[d2], true, 1.f);
        const unsigned v01 = fp8x2_bf16((int)R.v[d2], false, 1.f), v23 = fp8x2_bf16((int)R.v[d2], true, 1.f);
        const int r0 = 16 * w + 4 * d2, co = 2 * (lane & 7), cj = lane >> 3;
        *(LAS bf16*)(G + SC_KUT + sw8(r0, cj) + co) = (bf16)(k01 & 0xffffu); *(LAS bf16*)(G + SC_KUT + sw8(r0 + 1, cj) + co) = (bf16)(k01 >> 16);
        *(LAS bf16*)(G + SC_KUT + sw8(r0 + 2, cj) + co) = (bf16)(k23 & 0xffffu); *(LAS bf16*)(G + SC_KUT + sw8(r0 + 3, cj) + co) = (bf16)(k23 >> 16);
        *(LAS bf16*)(G + SC_VT + sw8(r0, cj) + co) = (bf16)(v01 & 0xffffu); *(LAS bf16*)(G + SC_VT + sw8(r0 + 1, cj) + co) = (bf16)(v01 >> 16);
        *(LAS bf16*)(G + SC_VT + sw8(r0 + 2, cj) + co) = (bf16)(v23 & 0xffffu); *(LAS bf16*)(G + SC_VT + sw8(r0 + 3, cj) + co) = (bf16)(v23 >> 16); }
    if (tid < 32) *(LAS f32x4*)(G + SC_DEC + 16 * tid) = R.dec;
    if (!isctx) {
        { const int row = tid >> 3, c = tid & 7; unsigned o[8];
#pragma unroll
          for (int d2 = 0; d2 < 4; ++d2) { o[2 * d2] = fp8x2_bf16((int)R.q[d2], false, QSCALE_INV); o[2 * d2 + 1] = fp8x2_bf16((int)R.q[d2], true, QSCALE_INV); }
          *(LAS v4u*)(G + SC_QD + sw16(row, 2 * c)) = (v4u){o[0], o[1], o[2], o[3]}; *(LAS v4u*)(G + SC_QD + sw16(row, 2 * c + 1)) = (v4u){o[4], o[5], o[6], o[7]}; }
        if (tid < 256) { const int row = tid >> 2, c = tid & 3; unsigned o[8];
#pragma unroll
          for (int d2 = 0; d2 < 4; ++d2) { o[2 * d2] = fp8x2_bf16((int)R.a[d2], false, 1.f); o[2 * d2 + 1] = fp8x2_bf16((int)R.a[d2], true, 1.f); }
          *(LAS v4u*)(G + SC_ATT + sw8(row, 2 * c)) = (v4u){o[0], o[1], o[2], o[3]}; *(LAS v4u*)(G + SC_ATT + sw8(row, 2 * c + 1)) = (v4u){o[4], o[5], o[6], o[7]}; }
    }
}
__device__ __forceinline__ void scan_mma(Frame& F, LAS unsigned char* G, bool isctx, int rowq, int h, int dvh, f32x4 (&S)[8], unsigned char* O) {
    const int lane = F.lane, w = F.wave, fr = lane & 15, fq = lane >> 4;
    LAS unsigned char* L = F.lds;
    bf16x8 av[2];
#pragma unroll
    for (int ks = 0; ks < 2; ++ks) av[ks] = *(const LAS bf16x8*)(G + SC_VT + sw8(16 * w + fr, 4 * ks + fq));
    if (!isctx) {
        bf16x8 as_[4];
#pragma unroll
        for (int ks = 0; ks < 4; ++ks) as_[ks] = *(const LAS bf16x8*)(L + SC_ST + (16 * w + fr) * 272 + (32 * ks + 8 * fq) * 2);
#pragma unroll
        for (int hf = 0; hf < 2; ++hf) {
            bf16x8 ba[2][2], bq[2][4];
#pragma unroll
            for (int t2 = 0; t2 < 2; ++t2) { const int it = 2 * hf + t2;
#pragma unroll
                for (int ks = 0; ks < 2; ++ks) ba[t2][ks] = *(const LAS bf16x8*)(G + SC_ATT + sw8(16 * it + fr, 4 * ks + fq));
#pragma unroll
                for (int ks = 0; ks < 4; ++ks) bq[t2][ks] = *(const LAS bf16x8*)(G + SC_QD + sw16(16 * it + fr, 4 * ks + fq)); }
#pragma unroll
            for (int t2 = 0; t2 < 2; ++t2) { const int it = 2 * hf + t2; f32x4 a4 = (f32x4){0.f, 0.f, 0.f, 0.f};
#pragma unroll
                for (int ks = 0; ks < 2; ++ks) a4 = mfma16(av[ks], ba[t2][ks], a4);
#pragma unroll
                for (int ks = 0; ks < 4; ++ks) a4 = mfma16(as_[ks], bq[t2][ks], a4);
                int o8 = 0; o8 = __builtin_amdgcn_cvt_pk_fp8_f32(a4[0] * OSCALE, a4[1] * OSCALE, o8, false); o8 = __builtin_amdgcn_cvt_pk_fp8_f32(a4[2] * OSCALE, a4[3] * OSCALE, o8, true);
                *(int*)(O + (size_t)(rowq + 16 * it + fr) * 1024 + 256 * h + 128 * dvh + 16 * w + 4 * fq) = o8; }
        }
    }
    {
        bf16x8 ak[8][2]; f32x4 dc[8];
#pragma unroll
        for (int mt = 0; mt < 8; ++mt) { dc[mt] = *(const LAS f32x4*)(G + SC_DEC + (16 * mt + 4 * fq) * 4);
#pragma unroll
            for (int ks = 0; ks < 2; ++ks) ak[mt][ks] = *(const LAS bf16x8*)(G + SC_KUT + sw8(16 * mt + fr, 4 * ks + fq)); }
#pragma unroll
        for (int mt = 0; mt < 8; ++mt) { f32x4 a4 = S[mt] * dc[mt];
#pragma unroll
            for (int ks = 0; ks < 2; ++ks) a4 = mfma16(ak[mt][ks], av[ks], a4);
            S[mt] = a4; }
#pragma unroll
        for (int mt = 0; mt < 8; ++mt) { v2u o; o.x = pk2(S[mt][0], S[mt][1]); o.y = pk2(S[mt][2], S[mt][3]);
            *(LAS v2u*)(L + SC_ST + (16 * w + fr) * 272 + (16 * mt + 4 * fq) * 2) = o; }
    }
}
__device__ __forceinline__ void scan_step(Frame& F, int b, int h, int dir, int dvh, int s, ScanRegs& Rn, f32x4 (&S)[8], unsigned char* O) {
    bool isctx; int cgk, cga, rowq, rowk; scan_chunk_ids(b, dir, s, isctx, cgk, cga, rowq, rowk);
    if (s + 1 < 36) { scan_fill(F, F.lds + ((s + 1) & 1) * SC_STAGE, s + 1 < 4, Rn); if (s + 3 < 36) scan_issue(F.ws, F.tid, b, h, dir, dvh, s + 3, Rn); }
    scan_mma(F, F.lds + (s & 1) * SC_STAGE, isctx, rowq, h, dvh, S, O);
    __syncthreads();
}
__device__ __forceinline__ void gla_scan(Frame& F, int u) {
    const int dvh = u & 1, dir = (u >> 1) & 1, h = (u >> 2) & 3, b = u >> 4;
    const int tid = F.tid;
    LAS unsigned char* L = F.lds;
    unsigned char* O = F.ws + (dir ? WS_OB : WS_OF);
    f32x4 S[8];
#pragma unroll
    for (int mt = 0; mt < 8; ++mt) S[mt] = (f32x4){0.f, 0.f, 0.f, 0.f};
    for (int i = tid; i < 34816 / 16; i += 512) *(LAS v4u*)(L + SC_ST + 16 * i) = (v4u){0u, 0u, 0u, 0u};
    ScanRegs R0, R1;
    scan_issue(F.ws, tid, b, h, dir, dvh, 0, R0);
    scan_issue(F.ws, tid, b, h, dir, dvh, 1, R1);
    scan_fill(F, L, true, R0);
    scan_issue(F.ws, tid, b, h, dir, dvh, 2, R0);
    __syncthreads();
    for (int s = 0; s < 36; s += 2) {
        scan_step(F, b, h, dir, dvh, s, R1, S, O);
        scan_step(F, b, h, dir, dvh, s + 1, R0, S, O);
    }
}

__device__ __forceinline__ void hy_prep(Frame& F) {
    const bf16* HY = (const bf16*)(F.ws + WS_HY); bf16* X0C = (bf16*)(F.ws + WS_X0C); bf16* UT = (bf16*)(F.ws + WS_UT);
    const float* cw = F.in[I_HCW]; const float* cb_ = F.in[I_HCB];
    LAS unsigned char* L = F.lds;
    const int tl = F.tid >> 3, cg = F.tid & 7; int nit = 0;
    pg8::u32x4 ra[2][3][3], rb[2][3][3];
#define HP_LOAD(R, it0_) do { _Pragma("unroll") for (int k = 0; k < 2; ++k) { const int it = (it0_) + k * F.G; if (it < 8192) { \
            const int b = it >> 9, gr = (it >> 4) & 31, cb = it & 15, row0 = b * 2048 + 64 * gr, c0 = 64 * cb; \
            _Pragma("unroll") for (int gi = 0; gi < 3; ++gi) { const bf16* p = HY + (size_t)(row0 + tl) * 3072 + 1024 * gi + c0 + 8 * cg; \
                R[k][gi][0] = *(const pg8::u32x4*)p; R[k][gi][1] = (pg8::u32x4){0u, 0u, 0u, 0u}; R[k][gi][2] = (pg8::u32x4){0u, 0u, 0u, 0u}; \
                if (tl > 0) R[k][gi][1] = *(const pg8::u32x4*)(p - 3072); \
                if (tl < 63) R[k][gi][2] = *(const pg8::u32x4*)(p + 3072); } } } } while (0)
#define HP_TRIP(R, it0_) do { \
        LAS unsigned char* Lt = L + (nit & 1) * 18432; ++nit; \
        _Pragma("unroll") for (int k = 0; k < 2; ++k) { const int it = (it0_) + k * F.G; if (it < 8192) { \
            const int b = it >> 9, gr = (it >> 4) & 31, cb = it & 15, row0 = b * 2048 + 64 * gr, c0 = 64 * cb; (void)b; \
            float res[3][8]; \
            _Pragma("unroll") for (int gi = 0; gi < 3; ++gi) { const int col = 1024 * gi + c0 + 8 * cg; \
                float fc[8], fp[8], fn[8]; pg8::unpack8(R[k][gi][0], fc); pg8::unpack8(R[k][gi][1], fp); pg8::unpack8(R[k][gi][2], fn); \
                const LAS float* wl = WL + col; \
                const pg8::f32x4 w0a = *(const LAS pg8::f32x4*)(wl), w0b = *(const LAS pg8::f32x4*)(wl + 4), w1a = *(const LAS pg8::f32x4*)(wl + 3072), w1b = *(const LAS pg8::f32x4*)(wl + 3072 + 4); \
                const pg8::f32x4 w2a = *(const LAS pg8::f32x4*)(wl + 6144), w2b = *(const LAS pg8::f32x4*)(wl + 6144 + 4), wba = *(const LAS pg8::f32x4*)(wl + 9216), wbb = *(const LAS pg8::f32x4*)(wl + 9216 + 4); \
                _Pragma("unroll") for (int ch = 0; ch < 4; ++ch) { res[gi][ch] = w0a[ch] * fp[ch] + w1a[ch] * fc[ch] + w2a[ch] * fn[ch] + wba[ch]; \
                    res[gi][4 + ch] = w0b[ch] * fp[4 + ch] + w1b[ch] * fc[4 + ch] + w2b[ch] * fn[4 + ch] + wbb[ch]; } } \
            { v4u o; o.x = pk2(res[0][0], res[0][1]); o.y = pk2(res[0][2], res[0][3]); o.z = pk2(res[0][4], res[0][5]); o.w = pk2(res[0][6], res[0][7]); \
              *(v4u*)(X0C + (size_t)(row0 + tl) * 1024 + c0 + 8 * cg) = o; } \
            _Pragma("unroll") for (int ch = 0; ch < 8; ++ch) *(LAS bf16*)(Lt + k * 9216 + (8 * cg + ch) * 144 + 2 * tl) = (bf16)f2bf(res[2][ch] * res[1][ch]); } } \
        __syncthreads(); \
        _Pragma("unroll") for (int k = 0; k < 2; ++k) { const int it = (it0_) + k * F.G; if (it < 8192) { \
            const int b = it >> 9, gr = (it >> 4) & 31, cb = it & 15, c0 = 64 * cb; const int cl = F.tid >> 3, piece = F.tid & 7; \
            *(v4u*)(UT + ((size_t)(c0 + cl) * 16 + b) * 2048 + 64 * gr + 8 * piece) = *(const LAS v4u*)(Lt + k * 9216 + cl * 144 + 16 * piece); } } \
    } while (0)
    const LAS float* WL = (const LAS float*)(L + 40960);
    for (int i = F.tid; i < 3 * 3072 / 4; i += 512) *(LAS pg8::f32x4*)(L + 40960 + 16 * i) = *(const pg8::f32x4*)(cw + 4 * i);
    for (int i = F.tid; i < 3072 / 4; i += 512) *(LAS pg8::f32x4*)(L + 40960 + 3 * 3072 * 4 + 16 * i) = *(const pg8::f32x4*)(cb_ + 4 * i);
    __syncthreads();
    const int step = 2 * F.G;
    HP_LOAD(ra, (int)blockIdx.x);
    for (int it0 = blockIdx.x; it0 < 8192; it0 += 2 * step) {
        HP_LOAD(rb, it0 + step);
        HP_TRIP(ra, it0);
        if (it0 + step < 8192) {
            HP_LOAD(ra, it0 + 2 * step);
            HP_TRIP(rb, it0 + step);
        }
    }
#undef HP_LOAD
#undef HP_TRIP
    __syncthreads();
}

constexpr int CV_UL = 0, CV_UB = 4240, CV_HC = 16 * CV_UB, CV_HS = 8208;
__device__ __forceinline__ void hy_conv(Frame& F) {
    const bf16* UT = (const bf16*)(F.ws + WS_UT); const bf16* HR = (const bf16*)(F.ws + WS_HR); bf16* ZT = (bf16*)(F.ws + WS_ZT);
    LAS unsigned char* L = F.lds;
    const int tid = F.tid, lane = F.lane, w = F.wave;
    const int r = lane & 31, hk = lane >> 5, msh = (8 - (r & 7)) & 7;
    const int abase = CV_HC + msh * CV_HS + (2048 - r + 8 * hk - msh) * 2;
    const int bbase = CV_UL + (lane & 15) * CV_UB + 64 + ((lane & 31) >> 4) * 64 + 16 * hk;
    v4u ur[8], hv0, hv1;
#define CV_LOAD(cc) do { _Pragma("unroll") for (int kk = 0; kk < 8; ++kk) { const int p = tid + 512 * kk; ur[kk] = *(const v4u*)(UT + ((size_t)(cc) * 16 + (p >> 8)) * 2048 + 8 * (p & 255)); } \
        { const bf16* g = HR + (size_t)(cc) * HRL + 8 * tid; hv0 = *(const v4u*)g; hv1 = *(const v4u*)(g + 8); } } while (0)
    if ((int)blockIdx.x < 1024) CV_LOAD((int)blockIdx.x);
    for (int c = blockIdx.x; c < 1024; c += F.G) {
#pragma unroll
        for (int kk = 0; kk < 8; ++kk) { const int p = tid + 512 * kk, b = p >> 8, o16 = p & 255; *(LAS v4u*)(L + CV_UL + b * CV_UB + 64 + 16 * o16) = ur[kk]; }
        if (tid < 128) { const int b = tid >> 3, wh = (tid >> 2) & 1, q4 = tid & 3; *(LAS v4u*)(L + CV_UL + b * CV_UB + (wh ? 4160 : 0) + 16 * q4) = (v4u){0u, 0u, 0u, 0u}; }
        { unsigned W[8];
#pragma unroll
          for (int q = 0; q < 4; ++q) { W[q] = hv0[q]; W[4 + q] = hv1[q]; }
#pragma unroll
          for (int m = 0; m < 8; ++m) { v4u o;
#pragma unroll
              for (int q = 0; q < 4; ++q) o[q] = (m & 1) ? ((W[(m >> 1) + q] >> 16) | (W[(m >> 1) + q + 1] << 16)) : W[(m >> 1) + q];
              *(LAS v4u*)(L + CV_HC + m * CV_HS + 16 * tid) = o; } }
        if (c + F.G < 1024) CV_LOAD(c + F.G);
        __syncthreads();
        f32x16 acc[4];
#pragma unroll
        for (int i = 0; i < 4; ++i)
#pragma unroll
            for (int q = 0; q < 16; ++q) acc[i][q] = 0.f;
        bf16x8 Bs[4][2];
#define CV_STEP(S) do { const int j = 4 * g + (S); const int qn = 2 * (32 - j) - par; const int dl = 2 * (4 * w - 32 + j) + par; \
            if (qn >= -1 && qn <= 63) { Bs[(4 - (S)) & 3][0] = *(const LAS bf16x8*)(L + bbase + qn * 64); Bs[(4 - (S)) & 3][1] = *(const LAS bf16x8*)(L + bbase + qn * 64 + 32); } \
            if (qn + 6 >= -1 && qn <= 63) { \
                const bf16x8 A0 = *(const LAS bf16x8*)(L + abase - 64 * dl), A1 = *(const LAS bf16x8*)(L + abase - 64 * dl + 32); \
                _Pragma("unroll") for (int i = 0; i < 4; ++i) { const int q = qn + 2 * i; if (q >= -1 && q <= 63) { \
                    acc[i] = __builtin_amdgcn_mfma_f32_32x32x16_bf16(A0, Bs[(i - (S) + 4) & 3][0], acc[i], 0, 0, 0); \
                    acc[i] = __builtin_amdgcn_mfma_f32_32x32x16_bf16(A1, Bs[(i - (S) + 4) & 3][1], acc[i], 0, 0, 0); } } } } while (0)
        for (int par = 0; par < 2; ++par)
            for (int g = 0; g < 9; ++g) { CV_STEP(0); CV_STEP(1); CV_STEP(2); CV_STEP(3); }
#undef CV_STEP
        { const int qs = (lane & 31) >> 4, bb = lane & 15;
#pragma unroll
          for (int i = 0; i < 4; ++i) { const int p = 8 * w + 2 * i + qs; bf16* zp = ZT + ((size_t)c * 16 + bb) * 2048 + 32 * p + 4 * hk;
#pragma unroll
              for (int g4 = 0; g4 < 4; ++g4) { v2u o; o.x = pk2(acc[i][4 * g4], acc[i][4 * g4 + 1]); o.y = pk2(acc[i][4 * g4 + 2], acc[i][4 * g4 + 3]); *(v2u*)(zp + 8 * g4) = o; } } }
        __syncthreads();
    }
#undef CV_LOAD
}

__device__ __forceinline__ void p5_post(Frame& F) {
    const int gw = F.vcu * NWAVES + F.wave, NGW = F.G * NWAVES, lane = F.lane;
    { const unsigned char* Of = F.ws + WS_OF; const unsigned char* Ob = F.ws + WS_OB; const unsigned char* OG = F.ws + WS_OG; bf16* GA = (bf16*)(F.ws + WS_GA);
      typedef float f32x2_ __attribute__((ext_vector_type(2)));
      f32x4 gn[4];
#pragma unroll
      for (int q = 0; q < 4; ++q) gn[q] = *(const f32x4*)(F.in[I_GLAN] + 16 * (lane & 15) + 4 * q);
      v4u ra[2][3], rb[2][3];
#define PP_LOAD(R, r0_) do { _Pragma("unroll") for (int rr = 0; rr < 2; ++rr) { const int row = (r0_) + rr * NGW; if (row < NTOK) { const size_t o = (size_t)row * 1024 + 16 * lane; \
            R[rr][0] = *(const v4u*)(Of + o); R[rr][1] = *(const v4u*)(Ob + o); R[rr][2] = *(const v4u*)(OG + o); } } } while (0)
#define PP_TRIP(R, r0_) do { _Pragma("unroll") for (int rr = 0; rr < 2; ++rr) { const int row = (r0_) + rr * NGW; if (row < NTOK) { \
            f32x4 v[4], og[4]; float ss = 0.f; \
            _Pragma("unroll") for (int q = 0; q < 4; ++q) { \
                const f32x2_ al = __builtin_amdgcn_cvt_pk_f32_fp8((int)R[rr][0][q], false), ah = __builtin_amdgcn_cvt_pk_f32_fp8((int)R[rr][0][q], true); \
                const f32x2_ bl = __builtin_amdgcn_cvt_pk_f32_fp8((int)R[rr][1][q], false), bh = __builtin_amdgcn_cvt_pk_f32_fp8((int)R[rr][1][q], true); \
                const f32x2_ gl = __builtin_amdgcn_cvt_pk_f32_fp8((int)R[rr][2][q], false), gh = __builtin_amdgcn_cvt_pk_f32_fp8((int)R[rr][2][q], true); \
                v[q] = (f32x4){al[0] + bl[0], al[1] + bl[1], ah[0] + bh[0], ah[1] + bh[1]}; og[q] = (f32x4){gl[0], gl[1], gh[0], gh[1]}; \
                ss += (v[q].x * v[q].x + v[q].y * v[q].y) + (v[q].z * v[q].z + v[q].w * v[q].w); } \
            ss = DPP_ADD(ss, 0xB1); ss = DPP_ADD(ss, 0x4E); ss = DPP_ADD(ss, 0x141); ss = DPP_ADD(ss, 0x140);        \
            const float rs = __builtin_amdgcn_rsqf(ss * (1.f / 256.f) + EPS * (OSCALE * OSCALE));        \
            unsigned ow[8]; \
            _Pragma("unroll") for (int q = 0; q < 4; ++q) { f32x4 g = og[q]; \
                _Pragma("unroll") for (int e = 0; e < 4; ++e) g[e] = g[e] * sigmoidf_(g[e]);          \
                const f32x4 y = (v[q] * rs) * gn[q] * g; ow[2 * q] = pk2(y.x, y.y); ow[2 * q + 1] = pk2(y.z, y.w); } \
            bf16* gp = GA + (size_t)row * 1024 + 16 * lane; \
            *(v4u*)gp = (v4u){ow[0], ow[1], ow[2], ow[3]}; *(v4u*)(gp + 8) = (v4u){ow[4], ow[5], ow[6], ow[7]}; } } } while (0)
      const int rstep = 2 * NGW;
      PP_LOAD(ra, gw);
      for (int row0 = gw; row0 < NTOK; row0 += 2 * rstep) {
          PP_LOAD(rb, row0 + rstep);
          PP_TRIP(ra, row0);
          if (row0 + rstep < NTOK) { PP_LOAD(ra, row0 + 2 * rstep); PP_TRIP(rb, row0 + rstep); }
      }
#undef PP_LOAD
#undef PP_TRIP
    }
    { const bf16* ZT = (const bf16*)(F.ws + WS_ZT); const bf16* X0C = (const bf16*)(F.ws + WS_X0C); bf16* YH = (bf16*)(F.ws + WS_YH);
      LAS unsigned char* L = F.lds; int nit = 0;
      const int cl = F.tid >> 3, piece = F.tid & 7, tl = F.tid >> 3, cg = F.tid & 7;
      v4u za[2], zb[2]; pg8::u32x4 xa[2], xb[2];
#define PH_LOAD(Z, X, it0_) do { _Pragma("unroll") for (int k = 0; k < 2; ++k) { const int it = (it0_) + k * F.G; if (it < 8192) { const int b = it >> 9, tb = (it >> 4) & 31, cb = it & 15, row0 = b * 2048 + 64 * tb, c0 = 64 * cb; \
              Z[k] = *(const v4u*)(ZT + ((size_t)(c0 + cl) * 16 + b) * 2048 + 64 * tb + 8 * piece); \
              X[k] = *(const pg8::u32x4*)(X0C + (size_t)(row0 + tl) * 1024 + c0 + 8 * cg); } } } while (0)
#define PH_TRIP(Z, X, it0_) do { \
          LAS unsigned char* Lt = L + (nit & 1) * 18432; ++nit; \
          _Pragma("unroll") for (int k = 0; k < 2; ++k) { const int it = (it0_) + k * F.G; if (it < 8192) *(LAS v4u*)(Lt + k * 9216 + cl * 144 + 16 * piece) = Z[k]; } \
          __syncthreads(); \
          _Pragma("unroll") for (int k = 0; k < 2; ++k) { const int it = (it0_) + k * F.G; if (it < 8192) { const int b = it >> 9, tb = (it >> 4) & 31, cb = it & 15, row0 = b * 2048 + 64 * tb, c0 = 64 * cb; \
              float xf[8]; pg8::unpack8(X[k], xf); float y[8]; \
              _Pragma("unroll") for (int ch = 0; ch < 8; ++ch) y[ch] = xf[ch] * bf2f(*(const LAS bf16*)(Lt + k * 9216 + (8 * cg + ch) * 144 + 2 * tl)); \
              v4u o; o.x = pk2(y[0], y[1]); o.y = pk2(y[2], y[3]); o.z = pk2(y[4], y[5]); o.w = pk2(y[6], y[7]); \
              *(v4u*)(YH + (size_t)(row0 + tl) * 1024 + c0 + 8 * cg) = o; } } } while (0)
      const int step = 2 * F.G;
      PH_LOAD(za, xa, (int)blockIdx.x);
      for (int it0 = blockIdx.x; it0 < 8192; it0 += 2 * step) {
          PH_LOAD(zb, xb, it0 + step);
          PH_TRIP(za, xa, it0);
          if (it0 + step < 8192) { PH_LOAD(za, xa, it0 + 2 * step); PH_TRIP(zb, xb, it0 + step); }
      }
#undef PH_LOAD
#undef PH_TRIP
      __syncthreads(); }
}

constexpr int RT_RS = 2064;
constexpr int RT_WH = 0, RT_WL = 32 * RT_RS, RT_LG = 64 * RT_RS;
__device__ __forceinline__ void p9_router(Frame& F, bool count = true) {
    LAS unsigned char* L = F.lds;
    for (int it = 0; it < 64; ++it) { const int idx = F.tid + 512 * it, k = idx >> 5, e = idx & 31; const float wv = F.in[I_WRT][idx];
        const unsigned hi = f2bf(wv); const unsigned lo = f2bf(wv - bf2f(hi));
        *(LAS bf16*)(L + RT_WH + e * RT_RS + 2 * k) = (bf16)hi; *(LAS bf16*)(L + RT_WL + e * RT_RS + 2 * k) = (bf16)lo; }
    if (F.tid < 32) F.LC[LC_HIST + F.tid] = 0u;
    __syncthreads();
    const int gw = F.vcu * NWAVES + F.wave, NGW = F.G * NWAVES, lane = F.lane, fr = lane & 15, fq = lane >> 4;
    const float* mod = (const float*)(F.ws + WS_MOD);
    unsigned char* H8 = F.ws + WS_H8; int* toke = (int*)(F.ws + WS_TOKE); float* tokw = (float*)(F.ws + WS_TOKW);
    LAS float* LG = (LAS float*)(L + RT_LG + F.wave * 2048);
    for (int g = gw; g < NTOK / 16; g += NGW) {
        const int row = 16 * g + fr; const bf16* xr = (const bf16*)(F.ws + WS_XM) + (size_t)row * 1024 + 8 * fq; const float* mb = mod + (size_t)(row >> 11) * 6144 + 8 * fq;
        float ss = 0.f;
#pragma unroll 8
        for (int s = 0; s < 32; ++s) { float a[8]; pg8::unpack8(*(const pg8::u32x4*)(xr + 32 * s), a);
            ss += (a[0] * a[0] + a[1] * a[1]) + (a[2] * a[2] + a[3] * a[3]) + (a[4] * a[4] + a[5] * a[5]) + (a[6] * a[6] + a[7] * a[7]); }
        ss += __shfl_xor(ss, 16); ss += __shfl_xor(ss, 32);
        const float rs = __builtin_amdgcn_rsqf(ss * (1.f / 1024.f) + EPS);
        f32x4 acc0 = (f32x4){0.f, 0.f, 0.f, 0.f}, acc1 = (f32x4){0.f, 0.f, 0.f, 0.f};
        const float* nfp = F.in[I_NFFN] + 8 * fq;
#pragma unroll 2
        for (int s = 0; s < 32; ++s) {
            float x[8], w[8], sh[8], sc[8];
            pg8::unpack8(*(const pg8::u32x4*)(xr + 32 * s), x);
            *(f32x4*)&w[0] = *(const f32x4*)(nfp + 32 * s); *(f32x4*)&w[4] = *(const f32x4*)(nfp + 32 * s + 4);
            *(f32x4*)&sh[0] = *(const f32x4*)(mb + 3072 + 32 * s); *(f32x4*)&sh[4] = *(const f32x4*)(mb + 3072 + 32 * s + 4);
            *(f32x4*)&sc[0] = *(const f32x4*)(mb + 4096 + 32 * s); *(f32x4*)&sc[4] = *(const f32x4*)(mb + 4096 + 32 * s + 4);
            unsigned hi[8], lo[8]; float hv[8];
#pragma unroll
            for (int q = 0; q < 8; ++q) { const float h = (x[q] * rs) * w[q] * (sc[q] + 1.f) + sh[q]; hv[q] = h; hi[q] = f2bf(h); lo[q] = f2bf(h - bf2f(hi[q])); }
            v4u ah, al;
#pragma unroll
            for (int q = 0; q < 4; ++q) { ah[q] = hi[2 * q] | (hi[2 * q + 1] << 16); al[q] = lo[2 * q] | (lo[2 * q + 1] << 16); }
            { int w0 = 0, w1 = 0;
              w0 = __builtin_amdgcn_cvt_pk_fp8_f32(hv[0], hv[1], w0, false); w0 = __builtin_amdgcn_cvt_pk_fp8_f32(hv[2], hv[3], w0, true);
              w1 = __builtin_amdgcn_cvt_pk_fp8_f32(hv[4], hv[5], w1, false); w1 = __builtin_amdgcn_cvt_pk_fp8_f32(hv[6], hv[7], w1, true);
              *(v2u*)(H8 + (size_t)row * 1024 + 32 * s + 8 * fq) = (v2u){(unsigned)w0, (unsigned)w1}; }
            const bf16x8 AH = __builtin_bit_cast(bf16x8, ah), AL = __builtin_bit_cast(bf16x8, al);
            const int bo = fr * RT_RS + (32 * s + 8 * fq) * 2;
            const bf16x8 BH0 = *(const LAS bf16x8*)(L + RT_WH + bo), BH1 = *(const LAS bf16x8*)(L + RT_WH + 16 * RT_RS + bo);
            const bf16x8 BL0 = *(const LAS bf16x8*)(L + RT_WL + bo), BL1 = *(const LAS bf16x8*)(L + RT_WL + 16 * RT_RS + bo);
            acc0 = mfma16(AH, BH0, acc0); acc1 = mfma16(AH, BH1, acc1);
            acc0 = mfma16(AH, BL0, acc0); acc1 = mfma16(AH, BL1, acc1);
            acc0 = mfma16(AL, BH0, acc0); acc1 = mfma16(AL, BH1, acc1);
        }
#pragma unroll
        for (int r = 0; r < 4; ++r) { LG[(4 * fq + r) * 32 + fr] = acc0[r]; LG[(4 * fq + r) * 32 + 16 + fr] = acc1[r]; }
        LDS_WAIT(); asm volatile("" ::: "memory");
        if (lane < 16) {
            float lg[32];
#pragma unroll
            for (int q = 0; q < 8; ++q) { const f32x4 v = *(const LAS f32x4*)(LG + lane * 32 + 4 * q); const f32x4 bb = *(const f32x4*)(F.in[I_BRT] + 4 * q);
                lg[4 * q] = v.x + bb.x; lg[4 * q + 1] = v.y + bb.y; lg[4 * q + 2] = v.z + bb.z; lg[4 * q + 3] = v.w + bb.w; }
            int bi[4]; float bv[4];
#pragma unroll
            for (int k = 0; k < 4; ++k) { float best = -3.0e38f; int bidx = 0;
#pragma unroll
                for (int e = 0; e < 32; ++e) { if (lg[e] > best) { best = lg[e]; bidx = e; } }
#pragma unroll
                for (int e = 0; e < 32; ++e) lg[e] = (e == bidx) ? -3.4e38f : lg[e];
                bi[k] = bidx; bv[k] = best; }
            const float e1 = __expf(bv[1] - bv[0]), e2 = __expf(bv[2] - bv[0]), e3 = __expf(bv[3] - bv[0]); const float inv = 1.f / (1.f + e1 + e2 + e3);
            const int orow = 16 * g + lane;
            *(int4*)(toke + (size_t)orow * 4) = make_int4(bi[0], bi[1], bi[2], bi[3]); *(f32x4*)(tokw + (size_t)orow * 4) = (f32x4){inv, e1 * inv, e2 * inv, e3 * inv};
#pragma unroll
            for (int k = 0; k < 4; ++k) __hip_atomic_fetch_add((LAS unsigned*)&F.LC[LC_HIST + bi[k]], 1u, __ATOMIC_RELAXED, __HIP_MEMORY_SCOPE_WORKGROUP);
        }
        LDS_WAIT(); asm volatile("" ::: "memory");
    }
    __syncthreads();
    if (F.tid < 32 && count) atomicAdd(F.ctl + CW_CNT + F.tid, (unsigned)F.LC[LC_HIST + F.tid]);
    __syncthreads();
}

__device__ __forceinline__ int moe_offsets(Frame& F) {
    __syncthreads();
    if (F.tid < 64) {
        const unsigned c = (F.tid < 32) ? __hip_atomic_load(F.ctl + CW_CNT + F.tid, __ATOMIC_RELAXED, __HIP_MEMORY_SCOPE_AGENT) : 0u; const unsigned nt = (c + 255u) >> 8;
        unsigned incl = nt;
#pragma unroll
        for (int o = 1; o < 32; o <<= 1) { const unsigned tv = __shfl_up(incl, o); if (F.lane >= o) incl += tv; }
        if (F.tid < 32) F.LC[LC_OFF + F.tid] = (incl - nt) << 8;
        if (F.tid == 31) F.LC[LC_OFF + 32] = incl << 8;
    }
    __syncthreads();
    const int total = (int)(F.LC[LC_OFF + 32] >> 8);
    for (int t = F.tid; t < total; t += 512) { unsigned e = 0;
#pragma unroll
        for (int j = 1; j < 32; ++j) e += (F.LC[LC_OFF + j] <= (unsigned)(t * 256)) ? 1u : 0u;
        F.LC[LC_T2E + t] = e; }
    __syncthreads();
    return total;
}

__device__ __forceinline__ void p10_scatter(Frame& F, int cw_cur = CW_CUR) {
    (void)moe_offsets(F);
    const int* toke = (const int*)(F.ws + WS_TOKE); const float* tokw = (const float*)(F.ws + WS_TOKW);
    int* pairpos = (int*)(F.ws + WS_PAIRPOS); int* rowtok = (int*)(F.ws + WS_ROWTOK); float* roww = (float*)(F.ws + WS_ROWW);
    const unsigned char* H8 = F.ws + WS_H8; unsigned char* AX = F.ws + WS_AX;
    LAS int* PP = (LAS int*)F.lds; LAS int* PT = (LAS int*)(F.lds + 2048);
    for (int chunk = blockIdx.x; chunk < 256; chunk += F.G) {
        if (F.tid < 32) F.LC[LC_LCNT + F.tid] = 0u;
        __syncthreads();
        const int tok = chunk * 128 + (F.tid >> 2), k = F.tid & 3;
        const int e = toke[(size_t)tok * 4 + k];
        const unsigned lrank = __hip_atomic_fetch_add((LAS unsigned*)&F.LC[LC_LCNT + e], 1u, __ATOMIC_RELAXED, __HIP_MEMORY_SCOPE_WORKGROUP);
        __syncthreads();
        if (F.tid < 32) F.LC[LC_BASE + F.tid] = atomicAdd(F.ctl + cw_cur + F.tid, (unsigned)F.LC[LC_LCNT + F.tid]);
        __syncthreads();
        const int pos = (int)(F.LC[LC_OFF + e] + F.LC[LC_BASE + e] + lrank);
        rowtok[pos] = tok; roww[pos] = tokw[(size_t)tok * 4 + k]; pairpos[(size_t)tok * 4 + k] = pos;
        PP[F.tid] = pos; PT[F.tid] = tok;
        __syncthreads();
        for (int i0 = 0; i0 < 64; i0 += 8) { v4u a[8]; int ps[8];
#pragma unroll
            for (int i = 0; i < 8; ++i) { const int pi = F.wave * 64 + i0 + i; ps[i] = PP[pi]; const int tk = PT[pi]; a[i] = *(const v4u*)(H8 + (size_t)tk * 1024 + 16 * F.lane); }
#pragma unroll
            for (int i = 0; i < 8; ++i) *(v4u*)(AX + (size_t)ps[i] * 1024 + 16 * F.lane) = a[i]; }
        __syncthreads();
    }
}

__device__ __forceinline__ void p13_final(Frame& F, float* dst) {
    const int gw = F.vcu * NWAVES + F.wave, NGW = F.G * NWAVES, lane = F.lane;
    const float* mod = (const float*)(F.ws + WS_MOD); const int* pairpos = (const int*)(F.ws + WS_PAIRPOS); const unsigned char* Y = F.ws + WS_Y;
    typedef float f32x2_ __attribute__((ext_vector_type(2)));
    f32x4 nf[2][2];
#pragma unroll
    for (int j = 0; j < 2; ++j) { nf[j][0] = *(const f32x4*)(F.in[I_NFIN] + 8 * lane + 512 * j); nf[j][1] = *(const f32x4*)(F.in[I_NFIN] + 8 * lane + 512 * j + 4); }
    for (int row0 = 2 * gw; row0 < NTOK; row0 += 2 * NGW) {
        f32x4 v[2][2][2]; v2u yv[2][2][4]; f32x4 g2v[2][2][2];
#pragma unroll
        for (int rr = 0; rr < 2; ++rr) { const int row = row0 + rr; const bf16* xr = (const bf16*)(F.ws + WS_XM) + (size_t)row * 1024; const float* g2 = mod + (size_t)(row >> 11) * 6144 + 5120;
            const int4 pp = *(const int4*)(pairpos + (size_t)row * 4);
#pragma unroll
            for (int j = 0; j < 2; ++j) { const int col = 8 * lane + 512 * j;
                { float xf[8]; pg8::unpack8(*(const pg8::u32x4*)(xr + col), xf); v[rr][j][0] = (f32x4){xf[0], xf[1], xf[2], xf[3]}; v[rr][j][1] = (f32x4){xf[4], xf[5], xf[6], xf[7]}; }
                g2v[rr][j][0] = *(const f32x4*)(g2 + col); g2v[rr][j][1] = *(const f32x4*)(g2 + col + 4);
                yv[rr][j][0] = *(const v2u*)(Y + (size_t)pp.x * 1024 + col); yv[rr][j][1] = *(const v2u*)(Y + (size_t)pp.y * 1024 + col);
                yv[rr][j][2] = *(const v2u*)(Y + (size_t)pp.z * 1024 + col); yv[rr][j][3] = *(const v2u*)(Y + (size_t)pp.w * 1024 + col); } }
#pragma unroll
        for (int rr = 0; rr < 2; ++rr) { float* xr = dst + (size_t)(row0 + rr) * 1024; float ss = 0.f;
#pragma unroll
            for (int j = 0; j < 2; ++j) { float m8[8];
#pragma unroll
                for (int q = 0; q < 8; ++q) m8[q] = 0.f;
#pragma unroll
                for (int k = 0; k < 4; ++k)
#pragma unroll
                    for (int d2 = 0; d2 < 2; ++d2) { const int wd = (int)yv[rr][j][k][d2];
                        const f32x2_ lo = __builtin_amdgcn_cvt_pk_f32_fp8(wd, false), hi = __builtin_amdgcn_cvt_pk_f32_fp8(wd, true);
                        m8[4 * d2] += lo[0]; m8[4 * d2 + 1] += lo[1]; m8[4 * d2 + 2] += hi[0]; m8[4 * d2 + 3] += hi[1]; }
#pragma unroll
                for (int q = 0; q < 8; ++q) { const float x = v[rr][j][q >> 2][q & 3] + g2v[rr][j][q >> 2][q & 3] * (m8[q] * pg8::YSCALE_INV); v[rr][j][q >> 2][q & 3] = x; ss += x * x; } }
            const float rs = __builtin_amdgcn_rsqf(wave_sum(ss) * (1.f / 1024.f) + EPS);
#pragma unroll
            for (int j = 0; j < 2; ++j) { const int col = 8 * lane + 512 * j; *(f32x4*)(xr + col) = (v[rr][j][0] * rs) * nf[j][0]; *(f32x4*)(xr + col + 4) = (v[rr][j][1] * rs) * nf[j][1]; } }
    }
}

constexpr int N_PHASES = 14;
struct Args { const float* in[35]; float* out; unsigned char* ws; int ph_lo, ph_hi, flags, pad; };
__global__ void __launch_bounds__(NWAVES * 64, 2) fwd(Args args) {
    extern __shared__ __attribute__((aligned(16))) unsigned char lds[];
    Frame F;
    F.lds = (LAS unsigned char*)lds;
    F.LC = (volatile LAS unsigned*)(F.lds + LDSCTL_OFF);
    F.tid = threadIdx.x; F.lane = F.tid & 63; F.wave = __builtin_amdgcn_readfirstlane(F.tid >> 6);
    F.G = gridDim.x; { const int bx = blockIdx.x; F.vcu = (F.G % 8 == 0) ? (bx % 8) * (F.G / 8) + bx / 8 : bx; }
    F.ws = args.ws; F.out = args.out; F.ctl = (unsigned*)(args.ws + WS_CTL);
#pragma unroll
    for (int i = 0; i < 35; ++i) F.in[i] = args.in[i];
    for (int u = F.tid; u < (LDS_BYTES - LDSCTL_OFF) / 4; u += NWAVES * 64) ((LAS unsigned*)(F.lds + LDSCTL_OFF))[u] = 0u;
    __syncthreads();
    const int lo = args.ph_lo, hi = args.ph_hi;
    XcdBarrier bar; bar.bar = F.ctl + CW_BAR; bar.x = 0; bar.st = nullptr;
    if (hi - lo > 1) bar = xcd_barrier_post(F.ctl + CW_BAR, F.LC + LC_BAR);
#define IN(k) (lo <= (k) && (k) < hi)
#define REP(k) _Pragma("unroll") for (int rep_ = 0; rep_ < (((k) == PROBE_PHASE) ? 2 : 1); ++rep_)
#define SEAM(k) do { if (IN(k) && IN((k) + 1)) xcd_barrier(bar); } while (0)
    unsigned char* ws = args.ws;
    LAS unsigned char* ring = F.lds;

    if (IN(0)) REP(0) { p0_prologue(F); } SEAM(0);
    if (IN(1)) REP(1) { p1_norm(F); } SEAM(1);
    if (PROBE_PHASE == 99) { _Pragma("nounroll") for (int r_ = 0; r_ < 10; ++r_) xcd_barrier(bar); }
    if (IN(2)) REP(2) {
        pg8::Sched1 S{(const char*)(ws + WS_HX), (const char*)(ws + WS_WB1), F.G, (int)blockIdx.x};
        pg8::Epi1 E{(bf16*)(ws + WS_KB), (bf16*)(ws + WS_VB), (bf16*)(ws + WS_QB), (bf16*)(ws + WS_OG), (bf16*)(ws + WS_HY), (bf16*)(ws + WS_MA), (bf16*)(ws + WS_MB), (float*)(ws + WS_RF)};
        pg8::gemm_phase<pg8::Epi1, pg8::Sched1, false, true>(ring, 1024, S, E);
        pg8::SchedG8 S8{(const char*)(ws + WS_HX8), (const char*)(ws + WS_WB8), F.G, (int)blockIdx.x};
        pg8::EpiG8 E8{ws + WS_OG, (bf16*)(ws + WS_MA), (bf16*)(ws + WS_MB), (bf16*)(ws + WS_HY), ws + WS_VB, (bf16*)(ws + WS_KB), (bf16*)(ws + WS_QB)};
        pg8::gemm_phase<pg8::EpiG8, pg8::SchedG8, true, true, true>(ring, 512, S8, E8);
    } SEAM(2);
    if (IN(3)) { REP(30) { gla_prep(F); } REP(31) { hy_prep(F); } } SEAM(3);
    if (IN(4)) { REP(40) { for (int ub = blockIdx.x; ub < 256; ub += F.G) {
            const int u = ((((ub >> 4) << 3) | (ub & 7)) << 1) | ((ub >> 3) & 1); gla_scan(F, u); } } REP(4) { hy_conv(F); } } SEAM(4);
    if (IN(5)) REP(5) { p5_post(F); } SEAM(5);
    if (IN(6)) REP(6) {
        pg8::SchedPair S{(const char*)ws, (const char*)ws, (unsigned)WS_GA, (unsigned)WS_YH, (unsigned)WS_WG, (unsigned)WS_WH, 128, 4, F.G, (int)blockIdx.x};
        pg8::EpiMix E{(const bf16*)(ws + WS_MA), (const bf16*)(ws + WS_MB), (bf16*)(ws + WS_YM)};
        pg8::gemm_phase<pg8::EpiMix, pg8::SchedPair, true, true>(ring, 1024, S, E);
    }
    SEAM(7);
    if (IN(8)) REP(8) {
        pg8::SchedStd S{(const char*)(ws + WS_YM), (const char*)(ws + WS_WO), 128, 4, F.G, (int)blockIdx.x};
        pg8::EpiRes E{F.in[I_X], (const float*)(ws + WS_MOD), (bf16*)(ws + WS_XM)};
        pg8::gemm_phase<pg8::EpiRes, pg8::SchedStd, true, true>(ring, 1024, S, E);
    } SEAM(8);
    if (IN(9)) {
REP(90) { p_expert_weights(F); } p9_router(F, args.flags == 0); } SEAM(9);
    if (IN(10)) {
_Pragma("nounroll") for (int rep_ = (PROBE_PHASE == 10 ? 0 : 1); rep_ < 2; ++rep_) { p10_scatter(F, rep_ == 1 ? CW_CUR : CW_CUR + 64); if (rep_ == 0) xcd_barrier(bar); } } SEAM(10);
    if (IN(11)) REP(11) {
        const int nt = moe_offsets(F);
        pg8::SchedMoE S{(const char*)(ws + WS_AX), (const char*)(ws + WS_WUP), nt, 8, F.G, (int)blockIdx.x, 2048u * 1024u, (const volatile LAS unsigned*)(F.LC + LC_T2E)};
        pg8::EpiUp E{F.in[I_BUP], ws + WS_ACT};
        pg8::gemm_phase<pg8::EpiUp, pg8::SchedMoE, true, true, true>(ring, 512, S, E);
    } SEAM(11);
    if (IN(12)) REP(12) {
        const int nt = moe_offsets(F);
        pg8::SchedMoE S{(const char*)(ws + WS_ACT), (const char*)(ws + WS_WDN), nt, 4, F.G, (int)blockIdx.x, 1024u * 1024u, (const volatile LAS unsigned*)(F.LC + LC_T2E)};
        pg8::EpiDown E{F.in[I_BDN], (const float*)(ws + WS_ROWW), ws + WS_Y};
        pg8::gemm_phase<pg8::EpiDown, pg8::SchedMoE, true, true, true>(ring, 512, S, E);
    } SEAM(12);
    if (IN(13)) {
_Pragma("nounroll") for (int rep_ = (PROBE_PHASE == 13 ? 0 : 1); rep_ < 2; ++rep_) p13_final(F, rep_ == 1 ? F.out : (float*)(ws + WS_ACT)); }
#undef IN
#undef REP
#undef SEAM
}

extern "C" void kernel_launch(void* const* d_in, const int* in_sizes, int n_in, void* d_out, int out_size, void* d_ws, size_t ws_size, hipStream_t stream) {
    static int grid = 0;
    if (grid == 0) {
        if (n_in != 35 || in_sizes[0] != NTOK * D || out_size != NTOK * D || ws_size < WS_END) {
            fprintf(stderr, "kernel_launch: unexpected shapes (n_in %d, in0 %d, out %d, ws %zu < %zu); nothing launched\n", n_in, n_in > 0 ? in_sizes[0] : -1, out_size, ws_size, (size_t)WS_END); grid = -1; return; }
        int dev = 0, cus = 0, per_cu = 0;
        if (hipGetDevice(&dev) != hipSuccess || hipDeviceGetAttribute(&cus, hipDeviceAttributeMultiprocessorCount, dev) != hipSuccess) { grid = -1; return; }
        if (hipFuncSetAttribute((const void*)fwd, hipFuncAttributeMaxDynamicSharedMemorySize, LDS_BYTES) != hipSuccess) { fprintf(stderr, "kernel_launch: hipFuncSetAttribute failed\n"); grid = -1; return; }
        if (hipOccupancyMaxActiveBlocksPerMultiprocessor(&per_cu, (const void*)fwd, NWAVES * 64, LDS_BYTES) != hipSuccess || per_cu < 1)
            fprintf(stderr, "kernel_launch: note: occupancy query reports %d workgroups per CU\n", per_cu);
        (void)hipGetLastError();
        grid = cus;
    }
    if (grid < 0) return;
    if (hipMemsetAsync((char*)d_ws + WS_CTL, 0, CTL_ZERO_BYTES, stream) != hipSuccess) return;
    Args a{};
    for (int i = 0; i < 35; ++i) a.in[i] = (const float*)d_in[i];
    a.out = (float*)d_out; a.ws = (unsigned char*)d_ws;
#if MK_N_LAUNCHES == 1
    a.ph_lo = 0; a.ph_hi = N_PHASES;
    hipLaunchKernelGGL(fwd, dim3(grid), dim3(NWAVES * 64), LDS_BYTES, stream, a);
#else
    for (int k = 0; k < N_PHASES; ++k) { a.ph_lo = k; a.ph_hi = k + 1;
        if (k == PROBE_PHASE && k == 9) { a.flags = 1; hipLaunchKernelGGL(fwd, dim3(grid), dim3(NWAVES * 64), LDS_BYTES, stream, a); a.flags = 0; }
        hipLaunchKernelGGL(fwd, dim3(grid), dim3(NWAVES * 64), LDS_BYTES, stream, a); }
#endif
}
```

```cpp
#include <hip/hip_runtime.h>
#include <cstdio>
#include <cstdint>

#ifndef MK_N_LAUNCHES
#define MK_N_LAUNCHES 1
#endif
#ifndef SCAN_DUP
#define SCAN_DUP 0
#endif
#ifndef PROBE_PHASE
#define PROBE_PHASE -1
#endif

namespace pg8 {
#define PG8_LAS __attribute__((address_space(3)))
typedef unsigned short bf16_t;
typedef short bf16x8 __attribute__((ext_vector_type(8)));
typedef float f32x4 __attribute__((ext_vector_type(4)));
typedef unsigned u32x4 __attribute__((ext_vector_type(4)));
constexpr int BM = 256, BK = 64, HALF = 128, HTB = HALF * BK * 2  , STAGE_BYTES = 8 * HTB, NXCD = 8, WGM = 8;

__host__ __device__ __forceinline__ int lds_byte(int r, int c) { const int st = (r >> 4) * 2 + (c >> 5), rr = r & 15, cc = c & 31, ob = rr * 64 + cc * 2; return st * 1024 + (ob ^ (((ob >> 9) & 1) << 5)); }
__host__ __device__ __forceinline__ void stage_rc(int b, int& R, int& C) { const int st = b / 1024, sb = b % 1024, swz = sb ^ (((sb >> 9) & 1) << 5); R = (st >> 1) * 16 + swz / 64; C = (st & 1) * 32 + (swz % 64) / 2; }
__host__ __device__ __forceinline__ int perm32(int rho) { const int n = rho >> 4, i = rho & 15; return 8 * (i >> 2) + 4 * n + (i & 3); }

struct Unit { int pm, pn, e; };

__device__ __forceinline__ void tile_order(int L, int nM, int nN, int& pm, int& pn) {
    const int nwg = nM * nN; int wgid = L;
    { const int q = nwg / NXCD, r = nwg % NXCD, xcd = wgid % NXCD, off = wgid / NXCD; wgid = (xcd < r ? xcd * (q + 1) : r * (q + 1) + (xcd - r) * q) + off; }
    const int nig = WGM * nN, gid = wgid / nig, fm = gid * WGM, gsz = (nM - fm) < WGM ? (nM - fm) : WGM;
    pm = fm + ((wgid % nig) % gsz); pn = (wgid % nig) / gsz;
}

typedef int i32x8 __attribute__((ext_vector_type(8)));
typedef int i32x4_ __attribute__((ext_vector_type(4)));
__device__ __forceinline__ i32x8 cat8(bf16x8 a, bf16x8 b) { return __builtin_shufflevector(__builtin_bit_cast(i32x4_, a), __builtin_bit_cast(i32x4_, b), 0, 1, 2, 3, 4, 5, 6, 7); }
__device__ __forceinline__ void mfma_fp8_inplace(f32x4& acc, const i32x8 a, const i32x8 b) { asm volatile("v_mfma_f32_16x16x128_f8f6f4 %0, %1, %2, %0" : "+v"(acc) : "v"(a), "v"(b)); }
template <int N> __device__ __forceinline__ void wait_vm() { asm volatile("s_waitcnt vmcnt(%0)" :: "n"(N) : "memory"); }
__device__ __forceinline__ unsigned cvt_pk_bf16(float lo, float hi) { unsigned r; asm volatile("v_cvt_pk_bf16_f32 %0, %1, %2" : "=v"(r) : "v"(lo), "v"(hi)); return r; }

template <class Epi, class Sched, bool ALIGN_EPI = false, bool SP2 = false, bool FP8 = false>
__device__ __forceinline__ void gemm_phase(PG8_LAS unsigned char* lds, const int K, const Sched& S, const Epi& E) {
    const int tid = threadIdx.x, wid = __builtin_amdgcn_readfirstlane(tid >> 6), lane = tid & 63, wr = wid >> 2, wc = wid & 3, fr = lane & 15, fq = lane >> 4;
    const int nt = K / BK;
    unsigned voffA[2], voffB[2];
#pragma unroll
    for (int i = 0; i < 2; ++i) { int R, C; stage_rc(tid * 16 + i * 8192, R, C); const int Rb = Epi::PERM ? ((R & ~31) + perm32(R & 31)) : R;
        voffA[i] = (unsigned)(R * K + C) * 2u; voffB[i] = (unsigned)(Rb * K + C) * 2u; }
    const unsigned kstep = (unsigned)(BK * 2);
    const unsigned hstep = (unsigned)HALF * K * 2;
    const unsigned tstep = 2 * hstep; (void)tstep;
    const __amdgpu_buffer_rsrc_t rsA = __builtin_amdgcn_make_buffer_rsrc((void*)S.A, 0, -1, 0x00020000), rsB = __builtin_amdgcn_make_buffer_rsrc((void*)S.B, 0, -1, 0x00020000);
    const unsigned ldsw = (unsigned)wid * 1024u;
    const int aoff = lds_byte(wr * 64 + fr, fq * 8), boff = lds_byte(wc * 32 + fr, fq * 8);
#define PG8_SA(b, h) (((b) * 2 + (h)) * HTB)
#define PG8_SB(b, h) ((4 + (b) * 2 + (h)) * HTB)
#define PG8_STAGE_R(rs, bufoff, soff, voff) do { _Pragma("unroll") for (int _i = 0; _i < 2; ++_i) \
        __builtin_amdgcn_raw_ptr_buffer_load_lds((rs), (PG8_LAS void*)(lds + (bufoff) + ldsw + _i * 8192), 16, (int)(voff)[_i], (int)(soff), 0, 0); } while (0)
#define PG8_STAGE(bufoff, gbase, voff) PG8_STAGE_R(PG8_RS_##voff, bufoff, gbase, voff)
#define PG8_RS_voffA rsA
#define PG8_RS_voffB rsB
#define PG8_LDA(dst, b, h) do { _Pragma("unroll") for (int m = 0; m < 4; ++m) _Pragma("unroll") for (int k = 0; k < 2; ++k) dst[m][k] = *(const PG8_LAS bf16x8*)(lds + PG8_SA(b, h) + aoff + m * 2048 + k * 1024); } while (0)
#define PG8_LDB(dst, b, h) do { _Pragma("unroll") for (int n = 0; n < 2; ++n) _Pragma("unroll") for (int k = 0; k < 2; ++k) dst[n][k] = *(const PG8_LAS bf16x8*)(lds + PG8_SB(b, h) + boff + n * 2048 + k * 1024); } while (0)
#define PG8_MMA(ai, bj, At, Bt) do { __builtin_amdgcn_s_setprio(1); _Pragma("unroll") for (int m = 0; m < 4; ++m) _Pragma("unroll") for (int n = 0; n < 2; ++n) { \
        if constexpr (FP8) { mfma_fp8_inplace(acc[ai][bj][m][n], cat8(Bt[n][0], Bt[n][1]), cat8(At[m][0], At[m][1])); } \
        else { _Pragma("unroll") for (int k = 0; k < 2; ++k) acc[ai][bj][m][n] = __builtin_amdgcn_mfma_f32_16x16x32_bf16(Bt[n][k], At[m][k], acc[ai][bj][m][n], 0, 0, 0); } } \
        __builtin_amdgcn_s_setprio(0); } while (0)
#define PG8_WAIT_V(n) asm volatile("s_waitcnt vmcnt(" #n ")" ::: "memory")
#define PG8_WAIT_L(n) asm volatile("s_waitcnt lgkmcnt(" #n ")" ::: "memory")
#define PG8_BAR __builtin_amdgcn_s_barrier()
#define PG8_SCHED __builtin_amdgcn_sched_barrier(0)
    Unit cur, nxt; int ui = 0;
    if (!S.next(0, cur)) return;
    f32x4 acc[2][2][4][2];
#pragma unroll
    for (int a = 0; a < 2; ++a)
#pragma unroll
        for (int b = 0; b < 2; ++b)
#pragma unroll
            for (int m = 0; m < 4; ++m)
#pragma unroll
                for (int n = 0; n < 2; ++n) acc[a][b][m][n] = (f32x4){0.f, 0.f, 0.f, 0.f};
    bf16x8 At[4][2], B0[2][2], B1[2][2];
    unsigned cA = S.aoff(cur), cB = S.boff(cur);
    S.a_ready(cur);
    if constexpr (SP2) {
        PG8_STAGE(PG8_SB(0, 0), cB, voffB); PG8_STAGE(PG8_SB(0, 1), cB + hstep, voffB); PG8_STAGE(PG8_SA(0, 0), cA, voffA); PG8_STAGE(PG8_SA(0, 1), cA + hstep, voffA);
        if (wr == 1) PG8_BAR;
        PG8_WAIT_V(2); PG8_BAR;
        PG8_STAGE(PG8_SB(1, 0), cB + kstep, voffB); PG8_STAGE(PG8_SA(1, 0), cA + kstep, voffA); PG8_STAGE(PG8_SB(1, 1), cB + hstep + kstep, voffB);
        PG8_WAIT_V(6); PG8_BAR;
    } else {
        PG8_STAGE(PG8_SB(0, 0), cB, voffB); PG8_STAGE(PG8_SA(0, 0), cA, voffA); PG8_STAGE(PG8_SB(0, 1), cB + hstep, voffB); PG8_STAGE(PG8_SA(0, 1), cA + hstep, voffA);
        if (wr == 1) PG8_BAR;
        PG8_WAIT_V(4); PG8_BAR;
        PG8_STAGE(PG8_SB(1, 0), cB + kstep, voffB); PG8_STAGE(PG8_SA(1, 0), cA + kstep, voffA); PG8_STAGE(PG8_SB(1, 1), cB + hstep + kstep, voffB);
        PG8_WAIT_V(6); PG8_BAR;
    }
    for (;;) {
        const bool has_next = S.next(ui + 1, nxt);
        const unsigned nA = has_next ? S.aoff(nxt) : cA, nB = has_next ? S.boff(nxt) : cB;
        constexpr int KREP = (PROBE_PHASE == 300 + Epi::ID) ? 2 : 1;
#pragma nounroll
        for (int krep = 0; krep < KREP; ++krep) {
        if (KREP == 2 && krep == 1) {
#pragma unroll
        for (int a = 0; a < 2; ++a)
#pragma unroll
            for (int b = 0; b < 2; ++b)
#pragma unroll
                for (int m = 0; m < 4; ++m)
#pragma unroll
                    for (int n = 0; n < 2; ++n) acc[a][b][m][n] = (f32x4){0.f, 0.f, 0.f, 0.f};
        }
        for (int t = 0; t < nt; t += 2) {
            const bool last = (t == nt - 2);
            const unsigned a1 = cA + (unsigned)(t + 1) * kstep;
            const unsigned nA_ = (KREP == 2 && krep == 0) ? cA : nA, nB_ = (KREP == 2 && krep == 0) ? cB : nB;
            const unsigned a2 = last ? nA_ : cA + (unsigned)(t + 2) * kstep, b2 = last ? nB_ : cB + (unsigned)(t + 2) * kstep;
            const unsigned a3 = a2 + kstep, b3 = b2 + kstep;
            if (last && has_next) S.a_ready(nxt);
            if constexpr (SP2) {
            PG8_LDB(B0, 0, 0); PG8_LDB(B1, 0, 1); PG8_SCHED; PG8_LDA(At, 0, 0); PG8_STAGE(PG8_SA(1, 1), a1 + hstep, voffA);
            PG8_WAIT_V(8); PG8_WAIT_L(0); PG8_BAR; PG8_MMA(0, 0, At, B0); PG8_MMA(0, 1, At, B1); PG8_BAR; PG8_SCHED;
            PG8_LDA(At, 0, 1); PG8_STAGE(PG8_SB(0, 0), b2, voffB); PG8_STAGE(PG8_SB(0, 1), b2 + hstep, voffB); PG8_STAGE(PG8_SA(0, 0), a2, voffA);
            PG8_WAIT_V(8); PG8_WAIT_L(0); PG8_BAR; PG8_MMA(1, 0, At, B0); PG8_MMA(1, 1, At, B1); PG8_BAR; PG8_SCHED;
            PG8_LDB(B0, 1, 0); PG8_LDB(B1, 1, 1); PG8_SCHED; PG8_LDA(At, 1, 0); PG8_STAGE(PG8_SA(0, 1), a2 + hstep, voffA);
            PG8_WAIT_V(8); PG8_WAIT_L(0); PG8_BAR; PG8_MMA(0, 0, At, B0); PG8_MMA(0, 1, At, B1); PG8_BAR; PG8_SCHED;
            PG8_LDA(At, 1, 1); PG8_STAGE(PG8_SB(1, 0), b3, voffB); PG8_STAGE(PG8_SB(1, 1), b3 + hstep, voffB); PG8_STAGE(PG8_SA(1, 0), a3, voffA);
            PG8_WAIT_V(8); PG8_WAIT_L(0); PG8_BAR; PG8_MMA(1, 0, At, B0); PG8_MMA(1, 1, At, B1); PG8_BAR; PG8_SCHED;
            } else {
            PG8_LDB(B0, 0, 0); PG8_SCHED; PG8_LDA(At, 0, 0); PG8_STAGE(PG8_SA(1, 1), a1 + hstep, voffA);
            PG8_WAIT_L(8); PG8_BAR; PG8_WAIT_L(0); PG8_MMA(0, 0, At, B0); PG8_BAR; PG8_SCHED;
            PG8_LDB(B1, 0, 1); PG8_STAGE(PG8_SB(0, 0), b2, voffB);
            PG8_BAR; PG8_WAIT_L(0); PG8_MMA(0, 1, At, B1); PG8_BAR;
            PG8_LDA(At, 0, 1); PG8_STAGE(PG8_SA(0, 0), a2, voffA);
            PG8_BAR; PG8_WAIT_L(0); PG8_MMA(1, 0, At, B0); PG8_BAR; PG8_SCHED;
            PG8_STAGE(PG8_SB(0, 1), b2 + hstep, voffB);
            PG8_WAIT_V(6); PG8_BAR; PG8_MMA(1, 1, At, B1); PG8_BAR;
            PG8_LDB(B0, 1, 0); PG8_SCHED; PG8_LDA(At, 1, 0); PG8_STAGE(PG8_SA(0, 1), a2 + hstep, voffA);
            PG8_WAIT_L(8); PG8_BAR; PG8_WAIT_L(0); PG8_MMA(0, 0, At, B0); PG8_BAR; PG8_SCHED;
            PG8_LDB(B1, 1, 1); PG8_STAGE(PG8_SB(1, 0), b3, voffB);
            PG8_BAR; PG8_WAIT_L(0); PG8_MMA(0, 1, At, B1); PG8_BAR;
            PG8_LDA(At, 1, 1); PG8_STAGE(PG8_SA(1, 0), a3, voffA);
            PG8_BAR; PG8_WAIT_L(0); PG8_MMA(1, 0, At, B0); PG8_BAR; PG8_SCHED;
            PG8_STAGE(PG8_SB(1, 1), b3 + hstep, voffB);
            PG8_WAIT_V(6); PG8_BAR; PG8_MMA(1, 1, At, B1); PG8_BAR;
            }
        }
        }
        if constexpr (FP8) {
            asm volatile("s_nop 15\n\ts_nop 15" : "+v"(acc[0][0][0][0]), "+v"(acc[0][0][0][1]));
#pragma unroll
            for (int a = 0; a < 2; ++a)
#pragma unroll
                for (int b = 0; b < 2; ++b)
#pragma unroll
                    for (int m = 0; m < 4; ++m) asm volatile("" : "+v"(acc[a][b][m][0]), "+v"(acc[a][b][m][1]));
        }
        if constexpr (ALIGN_EPI) { if (wr == 0) PG8_BAR; }
        if constexpr (!Epi::AFTER_DRAIN) { E(acc, cur, wr, wc, fr, fq); if constexpr (PROBE_PHASE == 200 + Epi::ID) { asm volatile("" ::: "memory"); E(acc, cur, wr, wc, fr, fq); } S.done(cur); }
        if (!has_next) break;
        if (!E.keep(cur)) {
#pragma unroll
        for (int a = 0; a < 2; ++a)
#pragma unroll
            for (int b = 0; b < 2; ++b)
#pragma unroll
                for (int m = 0; m < 4; ++m)
#pragma unroll
                    for (int n = 0; n < 2; ++n) acc[a][b][m][n] = (f32x4){0.f, 0.f, 0.f, 0.f};
        }
        cur = nxt; cA = nA; cB = nB; ++ui;
        if constexpr (ALIGN_EPI) { if (wr == 1) PG8_BAR; }
    }
    PG8_WAIT_V(0);
    if constexpr (!ALIGN_EPI) { if (wr == 0) PG8_BAR; }
    PG8_BAR;
    if constexpr (Epi::AFTER_DRAIN) { E.fused(acc, cur, wr, wc, fr, fq, lds, wid, lane); S.done(cur); }
#undef PG8_SA
#undef PG8_SB
#undef PG8_STAGE
#undef PG8_LDA
#undef PG8_LDB
#undef PG8_MMA
#undef PG8_WAIT_V
#undef PG8_WAIT_L
#undef PG8_BAR
#undef PG8_SCHED
}

template <class Epi, class Sched, bool FP8 = false>
__device__ __forceinline__ void gemm_phase_sp(PG8_LAS unsigned char* lds, const int K, const Sched& S, const Epi& E) {
    const int tid = threadIdx.x, wid = __builtin_amdgcn_readfirstlane(tid >> 6), lane = tid & 63, wr = wid >> 2, wc = wid & 3, fr = lane & 15, fq = lane >> 4;
    const int nt = K / BK;
    unsigned voffA[2], voffB[2];
#pragma unroll
    for (int i = 0; i < 2; ++i) { int R, C; stage_rc(tid * 16 + i * 8192, R, C); const int Rb = Epi::PERM ? ((R & ~31) + perm32(R & 31)) : R;
        voffA[i] = (unsigned)(R * K + C) * 2u; voffB[i] = (unsigned)(Rb * K + C) * 2u; }
    const unsigned kstep = (unsigned)(BK * 2);
    const unsigned hstep = (unsigned)HALF * K * 2;
    const unsigned tstep = 2 * hstep; (void)tstep;
    const __amdgpu_buffer_rsrc_t rsA = __builtin_amdgcn_make_buffer_rsrc((void*)S.A, 0, -1, 0x00020000), rsB = __builtin_amdgcn_make_buffer_rsrc((void*)S.B, 0, -1, 0x00020000);
    const unsigned ldsw = (unsigned)wid * 1024u;
    const int aoff = lds_byte(wr * 64 + fr, fq * 8), boff = lds_byte(wc * 32 + fr, fq * 8);
#define PG8_SA(b, h) (((b) * 2 + (h)) * HTB)
#define PG8_SB(b, h) ((4 + (b) * 2 + (h)) * HTB)
#define PG8_STAGE_R(rs, bufoff, soff, voff) do { _Pragma("unroll") for (int _i = 0; _i < 2; ++_i) \
        __builtin_amdgcn_raw_ptr_buffer_load_lds((rs), (PG8_LAS void*)(lds + (bufoff) + ldsw + _i * 8192), 16, (int)(voff)[_i], (int)(soff), 0, 0); } while (0)
#define PG8_STAGE(bufoff, gbase, voff) PG8_STAGE_R(PG8_RS_##voff, bufoff, gbase, voff)
#define PG8_RS_voffA rsA
#define PG8_RS_voffB rsB
#define PG8_LDA(dst, b, h) do { _Pragma("unroll") for (int m = 0; m < 4; ++m) _Pragma("unroll") for (int k = 0; k < 2; ++k) dst[m][k] = *(const PG8_LAS bf16x8*)(lds + PG8_SA(b, h) + aoff + m * 2048 + k * 1024); } while (0)
#define PG8_LDB(dst, b, h) do { _Pragma("unroll") for (int n = 0; n < 2; ++n) _Pragma("unroll") for (int k = 0; k < 2; ++k) dst[n][k] = *(const PG8_LAS bf16x8*)(lds + PG8_SB(b, h) + boff + n * 2048 + k * 1024); } while (0)
#define PG8_MMA(ai, bj, At, Bt) do { __builtin_amdgcn_s_setprio(1); _Pragma("unroll") for (int m = 0; m < 4; ++m) _Pragma("unroll") for (int n = 0; n < 2; ++n) { \
        if constexpr (FP8) { mfma_fp8_inplace(acc[ai][bj][m][n], cat8(Bt[n][0], Bt[n][1]), cat8(At[m][0], At[m][1])); } \
        else { _Pragma("unroll") for (int k = 0; k < 2; ++k) acc[ai][bj][m][n] = __builtin_amdgcn_mfma_f32_16x16x32_bf16(Bt[n][k], At[m][k], acc[ai][bj][m][n], 0, 0, 0); } } \
        __builtin_amdgcn_s_setprio(0); } while (0)
#define PG8_WAIT_V(n) asm volatile("s_waitcnt vmcnt(" #n ")" ::: "memory")
#define PG8_WAIT_L(n) asm volatile("s_waitcnt lgkmcnt(" #n ")" ::: "memory")
#define PG8_BAR __builtin_amdgcn_s_barrier()
#define PG8_SCHED __builtin_amdgcn_sched_barrier(0)
    static_assert(!Epi::AFTER_DRAIN, "split epilogue");
    Unit cur, nxt, prv; int ui = 0; bool pend = false;
    if (!S.next(0, cur)) return;
    prv = cur;
    f32x4 acc[2][2][4][2];
#pragma unroll
    for (int a = 0; a < 2; ++a)
#pragma unroll
        for (int b = 0; b < 2; ++b)
#pragma unroll
            for (int m = 0; m < 4; ++m)
#pragma unroll
                for (int n = 0; n < 2; ++n) acc[a][b][m][n] = (f32x4){0.f, 0.f, 0.f, 0.f};
    bf16x8 At[4][2], B0[2][2], B1[2][2];
    unsigned cA = S.aoff(cur), cB = S.boff(cur);
    S.a_ready(cur);
#define PG8_EPI_HALF(un, h) do { \
        if constexpr (FP8) { asm volatile("s_nop 15\n\ts_nop 15" : "+v"(acc[h][0][0][0]), "+v"(acc[h][0][0][1])); \
            _Pragma("unroll") for (int b_ = 0; b_ < 2; ++b_) _Pragma("unroll") for (int m_ = 0; m_ < 4; ++m_) asm volatile("" : "+v"(acc[h][b_][m_][0]), "+v"(acc[h][b_][m_][1])); } \
        E(acc, un, wr, wc, fr, fq, h, h + 1); \
        if (!E.keep(un)) { _Pragma("unroll") for (int b_ = 0; b_ < 2; ++b_) _Pragma("unroll") for (int m_ = 0; m_ < 4; ++m_) _Pragma("unroll") for (int n_ = 0; n_ < 2; ++n_) acc[h][b_][m_][n_] = (f32x4){0.f, 0.f, 0.f, 0.f}; } \
        if constexpr (FP8) { _Pragma("unroll") for (int b_ = 0; b_ < 2; ++b_) _Pragma("unroll") for (int m_ = 0; m_ < 4; ++m_) asm volatile("s_nop 1" : "+v"(acc[h][b_][m_][0]), "+v"(acc[h][b_][m_][1])); } \
    } while (0)
    PG8_STAGE(PG8_SB(0, 0), cB, voffB); PG8_STAGE(PG8_SB(0, 1), cB + hstep, voffB); PG8_STAGE(PG8_SA(0, 0), cA, voffA); PG8_STAGE(PG8_SA(0, 1), cA + hstep, voffA);
    if (wr == 1) PG8_BAR;
    PG8_WAIT_V(2); PG8_BAR;
    PG8_STAGE(PG8_SB(1, 0), cB + kstep, voffB); PG8_STAGE(PG8_SA(1, 0), cA + kstep, voffA); PG8_STAGE(PG8_SB(1, 1), cB + hstep + kstep, voffB);
    PG8_WAIT_V(6); PG8_BAR;
    for (;;) {
        const bool has_next = S.next(ui + 1, nxt);
        const unsigned nA = has_next ? S.aoff(nxt) : cA, nB = has_next ? S.boff(nxt) : cB;
        for (int t = 0; t < nt; t += 2) {
            const bool last = (t == nt - 2);
            const unsigned a1 = cA + (unsigned)(t + 1) * kstep;
            const unsigned a2 = last ? nA : cA + (unsigned)(t + 2) * kstep, b2 = last ? nB : cB + (unsigned)(t + 2) * kstep;
            const unsigned a3 = a2 + kstep, b3 = b2 + kstep;
            if (last && has_next) S.a_ready(nxt);
            const bool rlxB = (t == 0) && pend && E.relax_ok(prv), rlxA = last && E.relax_ok(cur);
            if (t == 0 && pend) { PG8_SCHED; PG8_EPI_HALF(prv, 1); S.done(prv); pend = false; PG8_SCHED; }
            PG8_LDB(B0, 0, 0); PG8_LDB(B1, 0, 1); PG8_SCHED; PG8_LDA(At, 0, 0); PG8_STAGE(PG8_SA(1, 1), a1 + hstep, voffA);
            if (rlxB) wait_vm<8 + 2 * Epi::NSTH>(); else wait_vm<8>();
            PG8_WAIT_L(0); PG8_BAR; PG8_MMA(0, 0, At, B0); PG8_MMA(0, 1, At, B1); PG8_BAR; PG8_SCHED;
            PG8_LDA(At, 0, 1); PG8_STAGE(PG8_SB(0, 0), b2, voffB); PG8_STAGE(PG8_SB(0, 1), b2 + hstep, voffB); PG8_STAGE(PG8_SA(0, 0), a2, voffA);
            if (rlxB) wait_vm<8 + Epi::NSTH>(); else wait_vm<8>();
            PG8_WAIT_L(0); PG8_BAR; PG8_MMA(1, 0, At, B0); PG8_MMA(1, 1, At, B1); PG8_BAR; PG8_SCHED;
            PG8_LDB(B0, 1, 0); PG8_LDB(B1, 1, 1); PG8_SCHED; PG8_LDA(At, 1, 0); PG8_STAGE(PG8_SA(0, 1), a2 + hstep, voffA);
            PG8_WAIT_V(8); PG8_WAIT_L(0); PG8_BAR; PG8_MMA(0, 0, At, B0); PG8_MMA(0, 1, At, B1); PG8_BAR; PG8_SCHED;
            if (last) { PG8_SCHED; PG8_EPI_HALF(cur, 0); PG8_SCHED; }
            PG8_LDA(At, 1, 1); PG8_STAGE(PG8_SB(1, 0), b3, voffB); PG8_STAGE(PG8_SB(1, 1), b3 + hstep, voffB); PG8_STAGE(PG8_SA(1, 0), a3, voffA);
            if (rlxA) wait_vm<8 + Epi::NSTH>(); else wait_vm<8>();
            PG8_WAIT_L(0); PG8_BAR; PG8_MMA(1, 0, At, B0); PG8_MMA(1, 1, At, B1); PG8_BAR; PG8_SCHED;
        }
        prv = cur; pend = true;
        if (!has_next) break;
        cur = nxt; cA = nA; cB = nB; ++ui;
    }
    PG8_EPI_HALF(prv, 1); S.done(prv);
    PG8_WAIT_V(0);
    if (wr == 0) PG8_BAR;
    PG8_BAR;
#undef PG8_EPI_HALF
#undef PG8_SA
#undef PG8_SB
#undef PG8_STAGE
#undef PG8_LDA
#undef PG8_LDB
#undef PG8_MMA
#undef PG8_WAIT_V
#undef PG8_WAIT_L
#undef PG8_BAR
#undef PG8_SCHED
}

}

constexpr int NB = 16, SEQ = 2048, D = 1024, CTXL = 256;
constexpr int NTOK = NB * SEQ, NCTX = NB * CTXL, NROW = NTOK + NCTX;
constexpr int NT1 = 33, N1 = NT1 * 256;
constexpr int NE = 32, TOPK = 4, DFF = 1024;
constexpr int MAXTILES = 544, MAXROWS = MAXTILES * 256;
constexpr float EPS = 1e-6f;
constexpr int NWAVES = 8;
constexpr int HRL = 4104;

constexpr size_t KiB = 1024, MiB = 1u << 20;
constexpr size_t WS_CTL = 0, CTL_ZERO_BYTES = 1 * MiB;
constexpr size_t WS_MOD = 1 * MiB;
constexpr size_t WS_TOKE = 1536 * KiB, WS_TOKW = 2048 * KiB, WS_PAIRPOS = 2560 * KiB, WS_ROWTOK = 3072 * KiB, WS_ROWW = 3840 * KiB;
constexpr size_t WS_HR = 5 * MiB;
constexpr size_t WS_WB1 = 13824 * KiB;
constexpr size_t WS_WG = 30 * MiB, WS_WH = 32 * MiB, WS_WO = 34 * MiB;
constexpr size_t WS_WUP = 68 * MiB, WS_WDN = 168 * MiB;
constexpr size_t WS_HX = 228 * MiB, WS_KB = 300 * MiB, WS_VB = 336 * MiB, WS_RF = 408 * MiB, WS_QB = 408 * MiB + 4608 * KiB;
constexpr size_t WS_OG = WS_QB + 32 * MiB, WS_HY = WS_OG + 64 * MiB, WS_MA = WS_HY + 192 * MiB, WS_MB = WS_MA + 64 * MiB;
constexpr size_t WS_OF = WS_MB + 64 * MiB, WS_OB = WS_OF + 64 * MiB, WS_UT = WS_OB + 64 * MiB, WS_END = WS_UT + 64 * MiB;
constexpr size_t WS_X0C = WS_HX, WS_ZT = WS_HY, WS_GA = WS_KB, WS_YH = WS_KB + 64 * MiB, WS_YA = WS_HY, WS_YM = WS_HY + 128 * MiB;
constexpr size_t WS_HX8 = 36 * MiB, WS_WB8 = 68 * MiB;
constexpr size_t WS_QD = 36 * MiB, WS_ATT = 207 * MiB, WS_KUT = 132 * MiB, WS_DEC = 204 * MiB;
static_assert(WS_DEC + 2 * (size_t)576 * 4 * 128 * 4 <= WS_ATT && WS_ATT + 2 * (size_t)512 * 4 * 4096 <= WS_HX && WS_QD + 2 * (size_t)NTOK * 512 <= WS_WUP && WS_WUP + (size_t)NE * 2048 * 1024 <= WS_KUT, "ws map gla");
static_assert(WS_KUT + 2 * (size_t)576 * 4 * 64 * 128 <= WS_WDN && WS_WDN + (size_t)NE * 1024 * 1024 <= WS_DEC && WS_WB8 + (size_t)32 * 256 * 1024 <= WS_KUT, "ws map gla 2");
constexpr size_t WS_XM = 428 * MiB;
constexpr size_t WS_H8 = WS_HX, WS_AX = 292 * MiB, WS_Y = WS_AX, WS_ACT = 564 * MiB;
static_assert(WS_WB1 + (size_t)N1 * 1024 * 2 <= WS_WG && WS_HR + (size_t)1024 * HRL * 2 <= WS_WB1, "ws map 1");
static_assert(WS_RF + (size_t)NROW * 32 * 4 <= WS_QB && WS_END <= 1024 * MiB && WS_YH + 64 * MiB <= WS_OG, "ws map 2");
static_assert(WS_ACT + (size_t)MAXROWS * 1024 <= WS_END && WS_Y + (size_t)MAXROWS * 1024 <= WS_ACT && WS_H8 + 32 * MiB <= WS_AX, "ws map 3");
static_assert(WS_ROWTOK + (size_t)MAXROWS * 4 <= WS_ROWW && WS_ROWW + (size_t)MAXROWS * 4 <= WS_HR, "ws map 4");
constexpr int CW_CNT = 64, CW_CUR = 128, CW_BAR = 4096;

constexpr int LDS_BYTES = 163840;
constexpr int LDSCTL_OFF = 159744;
constexpr int LC_BAR = 0  , LC_OFF = 8  , LC_HIST = 48  , LC_LCNT = 80  , LC_BASE = 112  , LC_T2E = 160  ;
static_assert((LC_T2E + MAXTILES) * 4 <= 4096, "LDS control area");

#define GAS __attribute__((address_space(1)))
#define LAS __attribute__((address_space(3)))
typedef unsigned short bf16;
typedef unsigned v4u __attribute__((ext_vector_type(4)));
typedef unsigned v2u __attribute__((ext_vector_type(2)));
typedef float f32x4 __attribute__((ext_vector_type(4)));
typedef float f32x16 __attribute__((ext_vector_type(16)));
typedef short bf16x8 __attribute__((ext_vector_type(8)));
#define LDS_WAIT() asm volatile("s_waitcnt lgkmcnt(0)" ::: "memory")
typedef __bf16 hwbf16x2 __attribute__((ext_vector_type(2)));
typedef float hwf32x2 __attribute__((ext_vector_type(2)));
__device__ __forceinline__ unsigned f2bf(float f) { return (unsigned)__builtin_bit_cast(unsigned short, (__bf16)f); }
__device__ __forceinline__ unsigned pk2(float lo, float hi) { return __builtin_bit_cast(unsigned, __builtin_convertvector((hwf32x2){lo, hi}, hwbf16x2)); }
__device__ __forceinline__ float bf2f(unsigned h) { return __builtin_bit_cast(float, h << 16); }
__device__ __forceinline__ float bflo(unsigned w) { return __builtin_bit_cast(float, w << 16); }
__device__ __forceinline__ float bfhi(unsigned w) { return __builtin_bit_cast(float, w & 0xffff0000u); }
#define DPP_ADD(v, ctrl) ((v) + __builtin_bit_cast(float, __builtin_amdgcn_update_dpp(0, __builtin_bit_cast(int, (v)), (ctrl), 0xf, 0xf, true)))
__device__ __forceinline__ float wave_sum(float v) {
    v = DPP_ADD(v, 0xB1);
    v = DPP_ADD(v, 0x4E);
    v = DPP_ADD(v, 0x141);
    v = DPP_ADD(v, 0x140);
    const float r0 = __builtin_bit_cast(float, __builtin_amdgcn_readlane(__builtin_bit_cast(int, v), 0)), r1 = __builtin_bit_cast(float, __builtin_amdgcn_readlane(__builtin_bit_cast(int, v), 16));
    const float r2 = __builtin_bit_cast(float, __builtin_amdgcn_readlane(__builtin_bit_cast(int, v), 32)), r3 = __builtin_bit_cast(float, __builtin_amdgcn_readlane(__builtin_bit_cast(int, v), 48));
    return (r0 + r1) + (r2 + r3);
}
__device__ __forceinline__ float sigmoidf_(float x) { return __builtin_amdgcn_rcpf(1.f + __expf(-x)); }

#define XB_TMO      128
#define XB_XCNT(j)  (256  + 64 * (j))
#define XB_XSUB(j)  (1280 + 64 * (j))
#define XB_XGEN(j)  (2304 + 64 * (j))
#define XB_TOP      3328
#define XB_TOPGEN   3392
#define XCD_BAR_WORDS 3456
#define XB_SPIN_CAP (1u << 18)
__device__ __forceinline__ unsigned xb_ld(unsigned* p)              { return __hip_atomic_load(p, __ATOMIC_RELAXED, __HIP_MEMORY_SCOPE_AGENT); }
__device__ __forceinline__ unsigned xb_add(unsigned* p, unsigned v) { return __hip_atomic_fetch_add(p, v, __ATOMIC_RELAXED, __HIP_MEMORY_SCOPE_AGENT); }
__device__ __forceinline__ unsigned xb_xcc_id() { return (unsigned)__builtin_amdgcn_s_getreg((3 << 11) | 20) & 0xFu; }
#define XB_SPIN(cond, bar) do { unsigned _sp = 0; while (cond) { __builtin_amdgcn_s_sleep(1); \
    if ((++_sp & 255u) == 0u) { if (xb_ld(&(bar)[XB_TMO])) break; if (_sp > XB_SPIN_CAP) { atomicAdd(&(bar)[XB_TMO], 1u); break; } } } } while (0)
struct XcdBarrier { unsigned* bar; unsigned x; volatile LAS unsigned* st; };
__device__ __forceinline__ XcdBarrier xcd_barrier_post(unsigned* bar, volatile LAS unsigned* st) {
    XcdBarrier b; b.bar = bar; b.x = xb_xcc_id(); b.st = st;
    if (threadIdx.x == 0) (void)xb_add(&bar[XB_XCNT(b.x)], 1u);
    return b;
}
__device__ __forceinline__ void xcd_barrier_complete(unsigned* bar, unsigned x, unsigned& nloc, unsigned& nx) {
    const unsigned G = gridDim.x * gridDim.y * gridDim.z;
    unsigned sum, cnt, mine, sp = 0u;
    for (;;) {
        sum = 0u; cnt = 0u; mine = 0u;
#pragma unroll
        for (unsigned j = 0; j < 16; ++j) { const unsigned c = xb_ld(&bar[XB_XCNT(j)]); sum += c; cnt += (c > 0u) ? 1u : 0u; mine = (j == x) ? c : mine; }
        if (sum == G) break;
        __builtin_amdgcn_s_sleep(1);
        if ((++sp & 255u) == 0u) { if (xb_ld(&bar[XB_TMO])) break; if (sp > XB_SPIN_CAP) { atomicAdd(&bar[XB_TMO], 1u); break; } }
    }
    nloc = mine > 0u ? mine : 1u; nx = cnt > 0u ? cnt : 1u;
}
__device__ __forceinline__ void xcd_barrier(const XcdBarrier& b) {
    asm volatile("s_waitcnt vmcnt(0)" ::: "memory");
    __syncthreads();
    if (threadIdx.x == 0) {
        unsigned* bar = b.bar;
        __builtin_amdgcn_s_waitcnt(0);
        unsigned nloc = b.st[0], nx = b.st[1];
        if (nloc == 0u) { xcd_barrier_complete(bar, b.x, nloc, nx); b.st[0] = nloc; b.st[1] = nx; }
        const unsigned old = xb_add(&bar[XB_XSUB(b.x)], 1u);
        const unsigned gen = old / nloc;
        if (old + 1u == (gen + 1u) * nloc) {
            __builtin_amdgcn_fence(__ATOMIC_RELEASE, "agent");
            asm volatile("s_waitcnt vmcnt(0)" ::: "memory");
            const unsigned og = xb_add(&bar[XB_TOP], 1u);
            const unsigned tg = og / nx;
            if (og + 1u == (tg + 1u) * nx) xb_add(&bar[XB_TOPGEN], 1u);
            else XB_SPIN(xb_ld(&bar[XB_TOPGEN]) == tg, bar);
            __builtin_amdgcn_fence(__ATOMIC_ACQUIRE, "agent");
            xb_add(&bar[XB_XGEN(b.x)], 1u);
            asm volatile("s_waitcnt vmcnt(0)" ::: "memory");
        } else {
            XB_SPIN(xb_ld(&bar[XB_XGEN(b.x)]) == gen, bar);
            __builtin_amdgcn_fence(__ATOMIC_ACQUIRE, "agent");
            asm volatile("s_waitcnt vmcnt(0)" ::: "memory");
        }
    }
    __syncthreads();
}

struct Frame {
    LAS unsigned char* lds;
    volatile LAS unsigned* LC;
    unsigned* ctl;
    int tid, lane, wave, vcu, G;
    const float* in[35]; float* out; unsigned char* ws;
};
enum { I_X = 0, I_C, I_CTX, I_CCTX, I_WADA, I_BADA, I_NMIX, I_NFFN, I_WIN, I_WGKF, I_BGKF, I_WGKB, I_BGKB, I_GLAN, I_WGLAO, I_HCW, I_HCB, I_HW1, I_HB1, I_HW2, I_HB2, I_HW3, I_HB3,
       I_HW4, I_HFREQ, I_HBIAS, I_WHYO, I_WOUT, I_WRT, I_BRT, I_WUP, I_BUP, I_WDN, I_BDN, I_NFIN };

namespace pg8 {
#ifndef G1CFG
#define G1CFG 5
#endif
constexpr int NBF1 = G1CFG == 0 ? 21 : G1CFG == 1 ? 9 : G1CFG == 2 ? 5 : G1CFG == 3 ? 1 : G1CFG == 4 ? 17 : 13, NF81 = G1CFG == 0 ? 12 : G1CFG == 1 ? 24 : G1CFG == 2 ? 28 : G1CFG == 3 ? 32 : G1CFG == 4 ? 16 : 20;
struct Sched1 {
    const char* A; const char* B; int G, c;
    __device__ __forceinline__ bool next(int i, Unit& u) const {
        const int L = i * G + c; u.e = 0;
        if (L < 128 * NBF1) { int pn; tile_order(L, 128, NBF1, u.pm, pn);
            u.pn = G1CFG == 0 ? (pn < 9 ? pn : pn + 4) : G1CFG == 1 ? pn : G1CFG == 2 ? (pn < 2 ? pn : pn + 4) : G1CFG == 3 ? 6 : G1CFG == 4 ? (pn < 2 ? pn : pn < 5 ? pn + 4 : pn + 8) : (pn == 0 ? 6 : pn + 12); return true; }
        const int L2 = L - 128 * NBF1; if (L2 >= 16 * 7) return false;
        u.pm = 128 + (L2 & 15); u.pn = L2 >> 4; return true;
    }
    __device__ __forceinline__ unsigned aoff(const Unit& u) const { return (unsigned)u.pm * (256u * 1024 * 2); }
    __device__ __forceinline__ unsigned boff(const Unit& u) const { return (unsigned)u.pn * (256u * 1024 * 2); }
    __device__ __forceinline__ void a_ready(const Unit&) const {}
    __device__ __forceinline__ void done(const Unit&) const {}
};
struct SchedG8 {
    const char* A; const char* B; int G, c;
    __device__ __forceinline__ bool next(int i, Unit& u) const {
        const int L = i * G + c; u.e = 0; if (L >= 128 * NF81) return false;
        tile_order(L, 128, NF81, u.pm, u.pn); if (G1CFG >= 4 && u.pn >= 12) u.pn += 12; return true;
    }
    __device__ __forceinline__ unsigned aoff(const Unit& u) const { return (unsigned)u.pm * (256u * 1024); }
    __device__ __forceinline__ unsigned boff(const Unit& u) const { return (unsigned)u.pn * (256u * 1024); }
    __device__ __forceinline__ void a_ready(const Unit&) const {}
    __device__ __forceinline__ void done(const Unit&) const {}
};
struct SchedStd {
    const char* A; const char* B; int nM, nN, G, c;
    __device__ __forceinline__ bool next(int i, Unit& u) const {
        const int L = i * G + c; u.e = 0; if (L >= nM * nN) return false;
        tile_order(L, nM, nN, u.pm, u.pn); return true;
    }
    __device__ __forceinline__ unsigned aoff(const Unit& u) const { return (unsigned)u.pm * (256u * 1024 * 2); }
    __device__ __forceinline__ unsigned boff(const Unit& u) const { return (unsigned)u.pn * (256u * 1024 * 2); }
    __device__ __forceinline__ void a_ready(const Unit&) const {}
    __device__ __forceinline__ void done(const Unit&) const {}
};
struct SchedMoE {
    const char* A; const char* B; int nM, nN, G, c; unsigned estride; const volatile PG8_LAS unsigned* t2e;
    __device__ __forceinline__ bool next(int i, Unit& u) const {
        const int L = i * G + c; if (L >= nM * nN) { u.e = 0; return false; }
        tile_order(L, nM, nN, u.pm, u.pn); u.e = (int)t2e[u.pm]; return true;
    }
    __device__ __forceinline__ unsigned aoff(const Unit& u) const { return (unsigned)u.pm * (256u * 1024); }
    __device__ __forceinline__ unsigned boff(const Unit& u) const { return (unsigned)u.e * estride + (unsigned)u.pn * (256u * 1024); }
    __device__ __forceinline__ void a_ready(const Unit&) const {}
    __device__ __forceinline__ void done(const Unit&) const {}
};

constexpr float WSCALE = 32.f, WSCALE_INV = 1.f / 32.f;
__device__ __forceinline__ float act_apply(float x, int act) { const float s = __builtin_amdgcn_rcpf(1.f + __expf(-x)); return act == 1 ? x * s : s; }

struct Epi1 {
    static constexpr bool PERM = true, AFTER_DRAIN = false; static constexpr int ID = 1; static constexpr int NSTH = 8; __device__ __forceinline__ bool relax_ok(const Unit& u) const { return u.pn != 6; }
    bf16_t *Kb, *Vb, *Qb, *OGb, *HYb, *MAb, *MBb; float* Rf;
    __device__ __forceinline__ bool keep(const Unit&) const { return false; }
    __device__ __forceinline__ void operator()(f32x4 (&acc)[2][2][4][2], const Unit& u, int wr, int wc, int fr, int fq, const int AI0 = 0, const int AI1 = 2) const {
        const int pn = u.pn; const int row0 = u.pm * BM + wr * 64 + fr;
        if (pn == 6) {
            if (wc == 0) {
#pragma unroll
                for (int ai = AI0; ai < AI1; ++ai)
#pragma unroll
                    for (int m = 0; m < 4; ++m) { float* rp = Rf + (size_t)(row0 + ai * HALF + m * 16) * 32 + 8 * fq;
                        *(f32x4*)rp = acc[ai][0][m][0]; *(f32x4*)(rp + 4) = acc[ai][0][m][1]; }
            }
            return;
        }
        if (pn >= 2 && pn < 6) {
            unsigned char* og8 = (unsigned char*)Vb; const int col0 = 256 * (pn - 2) + wc * 32 + 8 * fq;
#pragma unroll
            for (int ai = AI0; ai < AI1; ++ai)
#pragma unroll
                for (int m = 0; m < 4; ++m) { unsigned char* rowp = og8 + (size_t)(row0 + ai * HALF + m * 16) * 1024 + col0;
#pragma unroll
                    for (int bj = 0; bj < 2; ++bj) { const f32x4 v0 = acc[ai][bj][m][0], v1 = acc[ai][bj][m][1]; int w0 = 0, w1 = 0;
                        w0 = __builtin_amdgcn_cvt_pk_fp8_f32(v0[0], v0[1], w0, false); w0 = __builtin_amdgcn_cvt_pk_fp8_f32(v0[2], v0[3], w0, true);
                        w1 = __builtin_amdgcn_cvt_pk_fp8_f32(v1[0], v1[1], w1, false); w1 = __builtin_amdgcn_cvt_pk_fp8_f32(v1[2], v1[3], w1, true);
                        typedef int i32x2_ __attribute__((ext_vector_type(2))); *(i32x2_*)(rowp + bj * HALF) = (i32x2_){w0, w1}; } }
            return;
        }
        bf16_t* dst; int ld, c0, act = 0;
        if (pn < 2) { dst = Kb; ld = 512; c0 = 256 * pn; }
        else if (pn < 6) { dst = Vb; ld = 1024; c0 = 256 * (pn - 2); }
        else if (pn < 9) { dst = Qb; ld = 512; c0 = 256 * (pn - 7); }
        else if (pn < 13) { dst = OGb; ld = 1024; c0 = 256 * (pn - 9); }
        else if (pn < 25) { dst = HYb; ld = 3072; c0 = 256 * (pn - 13); }
        else if (pn < 29) { dst = MAb; ld = 1024; c0 = 256 * (pn - 25); act = 2; }
        else { dst = MBb; ld = 1024; c0 = 256 * (pn - 29); act = 2; }
        const int col0 = c0 + wc * 32 + 8 * fq;
#pragma unroll
        for (int ai = AI0; ai < AI1; ++ai)
#pragma unroll
            for (int m = 0; m < 4; ++m) { bf16_t* rowp = dst + (size_t)(row0 + ai * HALF + m * 16) * ld + col0;
#pragma unroll
                for (int bj = 0; bj < 2; ++bj) { f32x4 v0 = acc[ai][bj][m][0], v1 = acc[ai][bj][m][1];
                    if (act) {
#pragma unroll
                        for (int j = 0; j < 4; ++j) { v0[j] = act_apply(v0[j], act); v1[j] = act_apply(v1[j], act); } }
                    u32x4 w; w.x = cvt_pk_bf16(v0[0], v0[1]); w.y = cvt_pk_bf16(v0[2], v0[3]); w.z = cvt_pk_bf16(v1[0], v1[1]); w.w = cvt_pk_bf16(v1[2], v1[3]);
                    *(u32x4*)(rowp + bj * HALF) = w; } }
    }
};

struct EpiG8 {
    static constexpr bool PERM = true, AFTER_DRAIN = false; static constexpr int ID = 2; static constexpr int NSTH = 8; __device__ __forceinline__ bool relax_ok(const Unit& u) const { return true; }
    unsigned char* OG8; bf16_t* MAb; bf16_t* MBb; bf16_t* HYb; unsigned char* V8; bf16_t* Kb; bf16_t* Qb;
    __device__ __forceinline__ bool keep(const Unit&) const { return false; }
    __device__ __forceinline__ void operator()(f32x4 (&acc)[2][2][4][2], const Unit& u, int wr, int wc, int fr, int fq, const int AI0 = 0, const int AI1 = 2) const {
        const int pn = u.pn, row0 = u.pm * BM + wr * 64 + fr, col0 = 256 * (pn & 3) + wc * 32 + 8 * fq;
        if (pn < 4 || (pn >= 24 && pn < 28)) {
            unsigned char* o8 = pn < 4 ? OG8 : V8;
#pragma unroll
            for (int ai = AI0; ai < AI1; ++ai)
#pragma unroll
                for (int m = 0; m < 4; ++m) { unsigned char* rowp = o8 + (size_t)(row0 + ai * HALF + m * 16) * 1024 + col0;
#pragma unroll
                    for (int bj = 0; bj < 2; ++bj) { const f32x4 v0 = acc[ai][bj][m][0] * WSCALE_INV, v1 = acc[ai][bj][m][1] * WSCALE_INV; int w0 = 0, w1 = 0;
                        w0 = __builtin_amdgcn_cvt_pk_fp8_f32(v0[0], v0[1], w0, false); w0 = __builtin_amdgcn_cvt_pk_fp8_f32(v0[2], v0[3], w0, true);
                        w1 = __builtin_amdgcn_cvt_pk_fp8_f32(v1[0], v1[1], w1, false); w1 = __builtin_amdgcn_cvt_pk_fp8_f32(v1[2], v1[3], w1, true);
                        typedef int i32x2_ __attribute__((ext_vector_type(2))); *(i32x2_*)(rowp + bj * HALF) = (i32x2_){w0, w1}; } }
            return;
        }
        bf16_t* dst = pn < 8 ? MAb : MBb; int ld = 1024; float sc = WSCALE_INV;
        if (pn >= 12) {
            if (pn < 24) { dst = HYb + 256 * (pn - 12) - 256 * (pn & 3); ld = 3072; }
            else if (pn < 30) { dst = Kb + 256 * (pn - 28) - 256 * (pn & 3); ld = 512; }
            else { dst = Qb + 256 * (pn - 30) - 256 * (pn & 3); ld = 512; sc = WSCALE_INV * 0.08838834764831845f; }
        }
#pragma unroll
        for (int ai = AI0; ai < AI1; ++ai)
#pragma unroll
            for (int m = 0; m < 4; ++m) { bf16_t* rowp = dst + (size_t)(row0 + ai * HALF + m * 16) * ld + col0;
#pragma unroll
                for (int bj = 0; bj < 2; ++bj) { const f32x4 v0 = acc[ai][bj][m][0] * sc, v1 = acc[ai][bj][m][1] * sc;
                    u32x4 w; w.x = cvt_pk_bf16(v0[0], v0[1]); w.y = cvt_pk_bf16(v0[2], v0[3]); w.z = cvt_pk_bf16(v1[0], v1[1]); w.w = cvt_pk_bf16(v1[2], v1[3]);
                    *(u32x4*)(rowp + bj * HALF) = w; } }
    }
};
__device__ __forceinline__ void unpack8(const u32x4 w, float (&f)[8]) {
    f[0] = __builtin_bit_cast(float, w.x << 16); f[1] = __builtin_bit_cast(float, w.x & 0xffff0000u); f[2] = __builtin_bit_cast(float, w.y << 16); f[3] = __builtin_bit_cast(float, w.y & 0xffff0000u);
    f[4] = __builtin_bit_cast(float, w.z << 16); f[5] = __builtin_bit_cast(float, w.z & 0xffff0000u); f[6] = __builtin_bit_cast(float, w.w << 16); f[7] = __builtin_bit_cast(float, w.w & 0xffff0000u);
}
template <int MODE> struct EpiGate {
    static constexpr bool PERM = true, AFTER_DRAIN = false; static constexpr int ID = 3; static constexpr int NSTH = 8; __device__ __forceinline__ bool relax_ok(const Unit& u) const { return false; }
    const bf16_t* gate; float* YA; bf16_t* YM;
    __device__ __forceinline__ bool keep(const Unit&) const { return false; }
    __device__ __forceinline__ void operator()(f32x4 (&acc)[2][2][4][2], const Unit& u, int wr, int wc, int fr, int fq, const int AI0 = 0, const int AI1 = 2) const {
        const int row0 = u.pm * BM + wr * 64 + fr, col0 = u.pn * BM + wc * 32 + 8 * fq;
#pragma unroll
        for (int ai = AI0; ai < AI1; ++ai)
#pragma unroll
            for (int m = 0; m < 4; ++m) { const size_t ro = (size_t)(row0 + ai * HALF + m * 16) * 1024 + col0;
#pragma unroll
                for (int bj = 0; bj < 2; ++bj) { const size_t o = ro + bj * HALF;
                    float g[8]; unpack8(*(const u32x4*)(gate + o), g);
                    f32x4 v0 = acc[ai][bj][m][0], v1 = acc[ai][bj][m][1];
#pragma unroll
                    for (int j = 0; j < 4; ++j) { v0[j] *= g[j]; v1[j] *= g[4 + j]; }
                    if (MODE == 0) { *(f32x4*)(YA + o) = v0; *(f32x4*)(YA + o + 4) = v1; }
                    else { const f32x4 a0 = *(const f32x4*)(YA + o), a1 = *(const f32x4*)(YA + o + 4); v0 += a0; v1 += a1;
                        u32x4 w; w.x = cvt_pk_bf16(v0[0], v0[1]); w.y = cvt_pk_bf16(v0[2], v0[3]); w.z = cvt_pk_bf16(v1[0], v1[1]); w.w = cvt_pk_bf16(v1[2], v1[3]);
                        *(u32x4*)(YM + o) = w; } } }
    }
};

struct SchedPair {
    const char* A; const char* B; unsigned a0, a1, b0, b1; int nM, nN, G, c;
    __device__ __forceinline__ bool next(int i, Unit& u) const {
        const int L = (i >> 1) * G + c; u.e = i & 1; if (L >= nM * nN) return false;
        tile_order(L, nM, nN, u.pm, u.pn); return true;
    }
    __device__ __forceinline__ unsigned aoff(const Unit& u) const { return (u.e ? a1 : a0) + (unsigned)u.pm * (256u * 1024 * 2); }
    __device__ __forceinline__ unsigned boff(const Unit& u) const { return (u.e ? b1 : b0) + (unsigned)u.pn * (256u * 1024 * 2); }
    __device__ __forceinline__ void a_ready(const Unit&) const {}
    __device__ __forceinline__ void done(const Unit&) const {}
};
struct EpiMix {
    static constexpr bool PERM = true, AFTER_DRAIN = false; static constexpr int ID = 4; static constexpr int NSTH = 8; __device__ __forceinline__ bool relax_ok(const Unit& u) const { return u.e == 1; }
    const bf16_t* MA; const bf16_t* MB; bf16_t* YM;
    __device__ __forceinline__ bool keep(const Unit& u) const { return u.e == 0; }
    __device__ __forceinline__ void operator()(f32x4 (&acc)[2][2][4][2], const Unit& u, int wr, int wc, int fr, int fq, const int AI0 = 0, const int AI1 = 2) const {
        const int row0 = u.pm * BM + wr * 64 + fr, col0 = u.pn * BM + wc * 32 + 8 * fq;
#pragma unroll
        for (int ai = AI0; ai < AI1; ++ai)
#pragma unroll
            for (int m = 0; m < 4; ++m) { const size_t ro = (size_t)(row0 + ai * HALF + m * 16) * 1024 + col0;
#pragma unroll
                for (int bj = 0; bj < 2; ++bj) { const size_t o = ro + bj * HALF;
                    float gb[8]; unpack8(*(const u32x4*)(MB + o), gb);
#pragma unroll
                    for (int j = 0; j < 8; ++j) gb[j] = act_apply(gb[j], 2);
                    if (u.e == 0) { float ga[8]; unpack8(*(const u32x4*)(MA + o), ga);
#pragma unroll
                        for (int j = 0; j < 8; ++j) ga[j] = act_apply(ga[j], 2);
#pragma unroll
                        for (int j = 0; j < 4; ++j) { acc[ai][bj][m][0][j] *= ga[j] * __builtin_amdgcn_rcpf(fmaxf(gb[j], 1e-30f)); acc[ai][bj][m][1][j] *= ga[4 + j] * __builtin_amdgcn_rcpf(fmaxf(gb[4 + j], 1e-30f)); }
                    } else {
                        f32x4 v0 = acc[ai][bj][m][0], v1 = acc[ai][bj][m][1];
#pragma unroll
                        for (int j = 0; j < 4; ++j) { v0[j] *= gb[j]; v1[j] *= gb[4 + j]; }
                        u32x4 w; w.x = cvt_pk_bf16(v0[0], v0[1]); w.y = cvt_pk_bf16(v0[2], v0[3]); w.z = cvt_pk_bf16(v1[0], v1[1]); w.w = cvt_pk_bf16(v1[2], v1[3]);
                        *(u32x4*)(YM + o) = w; } } }
    }
};
struct EpiRes {
    static constexpr bool PERM = true, AFTER_DRAIN = false; static constexpr int ID = 5; static constexpr int NSTH = 8; __device__ __forceinline__ bool relax_ok(const Unit& u) const { return true; }
    const float* x; const float* mod; bf16_t* out;
    __device__ __forceinline__ bool keep(const Unit&) const { return false; }
    __device__ __forceinline__ void operator()(f32x4 (&acc)[2][2][4][2], const Unit& u, int wr, int wc, int fr, int fq, const int AI0 = 0, const int AI1 = 2) const {
        const int row0 = u.pm * BM + wr * 64 + fr, col0 = u.pn * BM + wc * 32 + 8 * fq;
        const float* g1 = mod + (size_t)(u.pm >> 3) * 6144 + 2048 + col0;
        f32x4 gv[2][2];
#pragma unroll
        for (int bj = 0; bj < 2; ++bj) { gv[bj][0] = *(const f32x4*)(g1 + bj * HALF); gv[bj][1] = *(const f32x4*)(g1 + bj * HALF + 4); }
#pragma unroll
        for (int ai = AI0; ai < AI1; ++ai)
#pragma unroll
            for (int m = 0; m < 4; ++m) { const size_t ro = (size_t)(row0 + ai * HALF + m * 16) * 1024 + col0;
#pragma unroll
                for (int bj = 0; bj < 2; ++bj) { const size_t o = ro + bj * HALF;
                    const f32x4 x0 = *(const f32x4*)(x + o), x1 = *(const f32x4*)(x + o + 4);
                    const f32x4 v0 = x0 + gv[bj][0] * acc[ai][bj][m][0], v1 = x1 + gv[bj][1] * acc[ai][bj][m][1];
                    u32x4 w; w.x = cvt_pk_bf16(v0[0], v0[1]); w.y = cvt_pk_bf16(v0[2], v0[3]); w.z = cvt_pk_bf16(v1[0], v1[1]); w.w = cvt_pk_bf16(v1[2], v1[3]);
                    *(u32x4*)(out + o) = w; } }
    }
};
struct EpiUp {
    static constexpr bool PERM = true, AFTER_DRAIN = false; static constexpr int ID = 6; static constexpr int NSTH = 4; __device__ __forceinline__ bool relax_ok(const Unit& u) const { return true; }
    const float* b_up; unsigned char* ACT;
    __device__ __forceinline__ bool keep(const Unit&) const { return false; }
    __device__ __forceinline__ void operator()(f32x4 (&acc)[2][2][4][2], const Unit& u, int wr, int wc, int fr, int fq, const int AI0 = 0, const int AI1 = 2) const {
        const int row0 = u.pm * BM + wr * 64 + fr, f0 = u.pn * 128 + wc * 32 + 8 * fq;
        const float* bp = b_up + (size_t)u.e * 2048 + 2 * f0;
        f32x4 bb[4];
#pragma unroll
        for (int q = 0; q < 4; ++q) bb[q] = *(const f32x4*)(bp + 4 * q);
        float bg[8], bl[8];
#pragma unroll
        for (int q = 0; q < 4; ++q) { bg[2 * q] = bb[q][0]; bl[2 * q] = bb[q][1]; bg[2 * q + 1] = bb[q][2]; bl[2 * q + 1] = bb[q][3]; }
#pragma unroll
        for (int ai = AI0; ai < AI1; ++ai)
#pragma unroll
            for (int m = 0; m < 4; ++m) { unsigned char* rowp = ACT + (size_t)(row0 + ai * HALF + m * 16) * 1024 + f0;
                float r[8];
#pragma unroll
                for (int n = 0; n < 2; ++n)
#pragma unroll
                    for (int j = 0; j < 4; ++j) { float gl = acc[ai][0][m][n][j] * WSCALE_INV + bg[4 * n + j], li = acc[ai][1][m][n][j] * WSCALE_INV + bl[4 * n + j];
                        gl = fminf(gl, 7.f); li = fminf(fmaxf(li, -7.f), 7.f);
                        r[4 * n + j] = gl * __builtin_amdgcn_rcpf(1.f + __expf(-1.702f * gl)) * (li + 1.f); }
                int w0 = 0, w1 = 0;
                w0 = __builtin_amdgcn_cvt_pk_fp8_f32(r[0], r[1], w0, false); w0 = __builtin_amdgcn_cvt_pk_fp8_f32(r[2], r[3], w0, true);
                w1 = __builtin_amdgcn_cvt_pk_fp8_f32(r[4], r[5], w1, false); w1 = __builtin_amdgcn_cvt_pk_fp8_f32(r[6], r[7], w1, true);
                typedef int i32x2_ __attribute__((ext_vector_type(2)));
                *(i32x2_*)rowp = (i32x2_){w0, w1}; }
    }
};
constexpr float YSCALE = 16.f, YSCALE_INV = 1.f / 16.f;
struct EpiDown {
    static constexpr bool PERM = true, AFTER_DRAIN = false; static constexpr int ID = 7; static constexpr int NSTH = 8; __device__ __forceinline__ bool relax_ok(const Unit& u) const { return true; }
    const float* b_dn; const float* roww; unsigned char* Y;
    __device__ __forceinline__ bool keep(const Unit&) const { return false; }
    __device__ __forceinline__ void operator()(f32x4 (&acc)[2][2][4][2], const Unit& u, int wr, int wc, int fr, int fq, const int AI0 = 0, const int AI1 = 2) const {
        const int row0 = u.pm * BM + wr * 64 + fr, col0 = u.pn * BM + wc * 32 + 8 * fq;
        const float* bp = b_dn + (size_t)u.e * 1024 + col0;
        f32x4 bv[2][2];
#pragma unroll
        for (int bj = 0; bj < 2; ++bj) { bv[bj][0] = *(const f32x4*)(bp + bj * HALF); bv[bj][1] = *(const f32x4*)(bp + bj * HALF + 4); }
#pragma unroll
        for (int ai = AI0; ai < AI1; ++ai)
#pragma unroll
            for (int m = 0; m < 4; ++m) { const int row = row0 + ai * HALF + m * 16; const float rw = roww[row] * YSCALE; unsigned char* rowp = Y + (size_t)row * 1024 + col0;
#pragma unroll
                for (int bj = 0; bj < 2; ++bj) { const f32x4 v0 = (acc[ai][bj][m][0] * WSCALE_INV + bv[bj][0]) * rw, v1 = (acc[ai][bj][m][1] * WSCALE_INV + bv[bj][1]) * rw;
                    int w0 = 0, w1 = 0;
                    w0 = __builtin_amdgcn_cvt_pk_fp8_f32(v0[0], v0[1], w0, false); w0 = __builtin_amdgcn_cvt_pk_fp8_f32(v0[2], v0[3], w0, true);
                    w1 = __builtin_amdgcn_cvt_pk_fp8_f32(v1[0], v1[1], w1, false); w1 = __builtin_amdgcn_cvt_pk_fp8_f32(v1[2], v1[3], w1, true);
                    typedef int i32x2_ __attribute__((ext_vector_type(2)));
                    *(i32x2_*)(rowp + bj * HALF) = (i32x2_){w0, w1}; } }
    }
};
}

template <class RowMap>
__device__ __forceinline__ void p0_transpose_item(const float* W, int K, int N, bf16* WT, LAS unsigned char* scr, int item, int lane, const RowMap& rm) {
    const int nblk = N / 32, kb = item / nblk, nb = item % nblk, k0 = 64 * kb, n0 = 32 * nb;
    const int kr = lane >> 3, c4 = lane & 7;
    f32x4 v[8];
#pragma unroll
    for (int it = 0; it < 8; ++it) v[it] = *(const f32x4*)(W + (size_t)(k0 + 8 * it + kr) * N + n0 + 4 * c4);
    float sc[4];
#pragma unroll
    for (int q = 0; q < 4; ++q) (void)rm(n0 + 4 * c4 + q, sc[q]);
#pragma unroll
    for (int it = 0; it < 8; ++it)
#pragma unroll
        for (int q = 0; q < 4; ++q) *(LAS bf16*)(scr + (4 * c4 + q) * 144 + 2 * (8 * it + kr)) = (bf16)f2bf(v[it][q] * sc[q]);
    LDS_WAIT(); asm volatile("" ::: "memory");
#pragma unroll
    for (int j = 0; j < 4; ++j) { const int n = (lane >> 3) + 8 * j, c = lane & 7; float dummy; const int drow = rm(n0 + n, dummy);
        *(v4u*)(WT + (size_t)drow * K + k0 + 8 * c) = *(const LAS v4u*)(scr + n * 144 + 16 * c); }
    LDS_WAIT(); asm volatile("" ::: "memory");
}
struct RmId { __device__ __forceinline__ int operator()(int n, float& sc) const { sc = 1.f; return n; } };
struct RmWin {
    __device__ __forceinline__ int operator()(int n, float& sc) const {
        sc = 1.f;
        if (n < 512) { sc = 0.08838834764831845f; return 7 * 256 + n; }
        if (n < 1024) return n - 512;
        if (n < 2048) return 2 * 256 + (n - 1024);
        if (n < 3072) return 9 * 256 + (n - 2048);
        if (n < 3104) return 6 * 256 + (n - 3072);
        if (n < 6176) return 13 * 256 + (n - 3104);
        if (n < 7200) return 25 * 256 + (n - 6176);
        return 29 * 256 + (n - 7200);
    }
};
struct RmUp {
    __device__ __forceinline__ int operator()(int n, float& sc) const { sc = 1.f; const int f = n >> 1; return 256 * (f >> 7) + 128 * (n & 1) + (f & 127); }
};

template <class RowMap>
__device__ __forceinline__ void fp8_transpose_kn(const float* W, int K, int N, unsigned char* WT, LAS unsigned char* scr, int kb, int nb, int lane, const RowMap& rm) {
    const int k0 = 128 * kb, n0 = 32 * nb;
    const int kg = lane >> 3, c4 = lane & 7;
    f32x4 v[16];
#pragma unroll
    for (int i = 0; i < 16; ++i) v[i] = *(const f32x4*)(W + (size_t)(k0 + 16 * kg + i) * N + n0 + 4 * c4);
#pragma unroll
    for (int q = 0; q < 4; ++q) { int wd[4];
#pragma unroll
        for (int d2 = 0; d2 < 4; ++d2) { int w0 = 0;
            w0 = __builtin_amdgcn_cvt_pk_fp8_f32(v[4 * d2][q] * pg8::WSCALE, v[4 * d2 + 1][q] * pg8::WSCALE, w0, false);
            w0 = __builtin_amdgcn_cvt_pk_fp8_f32(v[4 * d2 + 2][q] * pg8::WSCALE, v[4 * d2 + 3][q] * pg8::WSCALE, w0, true); wd[d2] = w0; }
        *(LAS v4u*)(scr + (4 * c4 + q) * 144 + 16 * kg) = (v4u){(unsigned)wd[0], (unsigned)wd[1], (unsigned)wd[2], (unsigned)wd[3]}; }
    LDS_WAIT(); asm volatile("" ::: "memory");
#pragma unroll
    for (int j = 0; j < 4; ++j) { const int n = (lane >> 3) + 8 * j, c = lane & 7; float dummy; const int drow = rm(n0 + n, dummy);
        *(v4u*)(WT + (size_t)drow * K + k0 + 16 * c) = *(const LAS v4u*)(scr + n * 144 + 16 * c); }
    LDS_WAIT(); asm volatile("" ::: "memory");
}
template <class RowMap>
__device__ __forceinline__ void fp8_transpose_item(const float* W, int K, int N, unsigned char* WT, LAS unsigned char* scr, int item, int lane, const RowMap& rm) {
    const int nblk = N / 32; fp8_transpose_kn(W, K, N, WT, scr, item / nblk, item % nblk, lane, rm);
}
struct RmG8 {
    __device__ __forceinline__ int operator()(int n, float& sc) const { sc = 1.f;
        if (n < 512) return 7680 + n;
        if (n < 1024) return 7168 + (n - 512);
        if (n < 2048) return 6144 + (n - 1024);
        if (n < 3072) return n - 2048;
        if (n < 6176) return 3072 + (n - 3104);
        return n < 7200 ? 1024 + (n - 6176) : 2048 + (n - 7200); }
};

__device__ __forceinline__ float hy_mlp(const Frame& F, int t) {
    const int lane = F.lane;
    const float tn = (float)t * (1.f / 2047.f);
    float zv = 0.f;
    if (lane == 0) zv = tn;
    else if (lane <= 32) { const int i = (lane - 1) & 15; const float f = 1e-4f + (float)i * ((15.f - 1e-4f) / 15.f); const float rev = (float)t * f * (1.f / 2048.f);
        zv = (lane <= 16) ? __builtin_amdgcn_cosf(rev) : -__builtin_amdgcn_sinf(rev); }
    const float fr = F.in[I_HFREQ][lane];
    const float inv2pi = 0.15915494309189535f;
    float a = F.in[I_HB1][lane];
#pragma unroll 11
    for (int i = 0; i < 33; ++i) a += __shfl(zv, i) * F.in[I_HW1][i * 64 + lane];
    float h = __builtin_amdgcn_sinf(fr * a * inv2pi);
    a = F.in[I_HB2][lane];
#pragma unroll 16
    for (int i = 0; i < 64; ++i) a += __shfl(h, i) * F.in[I_HW2][i * 64 + lane];
    h = __builtin_amdgcn_sinf(fr * a * inv2pi);
    a = F.in[I_HB3][lane];
#pragma unroll 16
    for (int i = 0; i < 64; ++i) a += __shfl(h, i) * F.in[I_HW3][i * 64 + lane];
    return __builtin_amdgcn_sinf(fr * a * inv2pi);
}

__device__ __forceinline__ void p0_prologue(Frame& F) {
    const int blk = blockIdx.x;
    for (int item = blk; item < 192; item += F.G) {
        LAS float* scr = (LAS float*)(F.lds + F.wave * 16384);
        const int k0 = 128 * F.wave;
        for (int idx = F.lane; idx < 17 * 128; idx += 64) { const int b = idx >> 7, kk = idx & 127;
            const float cv = (b < 16) ? F.in[I_C][b * 1024 + k0 + kk] : F.in[I_CCTX][k0 + kk];
            scr[kk * 20 + b] = cv * sigmoidf_(cv); }
        LDS_WAIT(); asm volatile("" ::: "memory");
        float acc[17];
#pragma unroll
        for (int b = 0; b < 17; ++b) acc[b] = 0.f;
        const int hl = F.lane >> 5, cl = F.lane & 31;
        const float* wp = F.in[I_WADA] + (size_t)(k0 + hl) * 6144 + 32 * item + cl;
#pragma nounroll
        for (int kb = 0; kb < 64; kb += 32) {
            float wv[32];
#pragma unroll
            for (int i = 0; i < 32; ++i) wv[i] = wp[(size_t)(2 * (kb + i)) * 6144];
#pragma unroll
            for (int i = 0; i < 32; ++i) { const LAS float* sp = scr + (2 * (kb + i) + hl) * 20;
                const f32x4 s0 = *(const LAS f32x4*)sp, s1 = *(const LAS f32x4*)(sp + 4), s2 = *(const LAS f32x4*)(sp + 8), s3 = *(const LAS f32x4*)(sp + 12); const float s4 = sp[16];
#pragma unroll
                for (int q = 0; q < 4; ++q) { acc[q] += s0[q] * wv[i]; acc[4 + q] += s1[q] * wv[i]; acc[8 + q] += s2[q] * wv[i]; acc[12 + q] += s3[q] * wv[i]; }
                acc[16] += s4 * wv[i]; }
        }
#pragma unroll
        for (int b = 0; b < 17; ++b) acc[b] += __shfl_xor(acc[b], 32);
        if (hl == 0) {
#pragma unroll
            for (int b = 0; b < 17; ++b) scr[2560 + b * 32 + cl] = acc[b]; }
        __syncthreads();
        for (int o = F.tid; o < 17 * 32; o += 512) { float s = F.in[I_BADA][32 * item + (o & 31)];
#pragma unroll
            for (int w = 0; w < 8; ++w) s += ((LAS float*)(F.lds + w * 16384))[2560 + o];
            ((float*)(F.ws + WS_MOD))[(size_t)(o >> 5) * 6144 + 32 * item + (o & 31)] = s; }
        __syncthreads();
    }
    for (int m = blk; m < 256; m += F.G) {
        LAS float* HS = (LAS float*)F.lds;
        LAS bf16* T = (LAS bf16*)(F.lds + 4096);
        { const float h3 = hy_mlp(F, 8 * m + F.wave); HS[F.wave * 64 + F.lane] = h3; }
        __syncthreads();
        const int cidx = 256 * F.wave + 4 * F.lane;
        f32x4 acc[8];
#pragma unroll
        for (int p = 0; p < 8; ++p) acc[p] = (f32x4){0.f, 0.f, 0.f, 0.f};
        const float* w4 = F.in[I_HW4] + cidx;
#pragma unroll 8
        for (int i = 0; i < 64; ++i) { const f32x4 wv = *(const f32x4*)(w4 + (size_t)i * 2048);
#pragma unroll
            for (int p = 0; p < 8; ++p) acc[p] += HS[p * 64 + i] * wv; }
        const bool fwd = F.wave < 4;
        const float a0 = -3.0701134573253944f, a1 = -15.350567286626972f;
#pragma unroll
        for (int cc = 0; cc < 4; ++cc) { const int c = (cidx & 1023) + cc; const float delta = fabsf(a0 + (float)c * ((a1 - a0) / 1023.f));
#pragma unroll
            for (int p = 0; p < 8; ++p) { const int t = 8 * m + p; float val = acc[p][cc] * __expf(-(float)t * (1.f / 2047.f) * delta);
                if (fwd && t == 0) val += F.in[I_HBIAS][c];
                T[(fwd ? c : 1024 + c) * 8 + (fwd ? 7 - p : p)] = (bf16)f2bf(val); } }
        __syncthreads();
        bf16* HR = (bf16*)(F.ws + WS_HR);
#pragma nounroll
        for (int ri = F.tid; ri < 2048; ri += 512) { const int dir = ri >> 10, c = ri & 1023; const LAS bf16* tp = T + ri * 8;
            if (dir) {
                bf16* hr = HR + (size_t)c * HRL + 2048 + 8 * m;
                const v4u v = *(const LAS v4u*)tp;
                if (m == 0) { hr[1] = (bf16)(v.x >> 16); *(unsigned*)(hr + 2) = v.y; *(v2u*)(hr + 4) = (v2u){v.z, v.w}; }
                else *(v4u*)hr = v;
            } else {
                bf16* hr = HR + (size_t)c * HRL + 2041 - 8 * m;
                const v4u v = *(const LAS v4u*)tp;
                hr[0] = (bf16)(v.x & 0xffffu); *(unsigned*)(hr + 1) = (v.x >> 16) | (v.y << 16); *(v2u*)(hr + 3) = (v2u){(v.y >> 16) | (v.z << 16), (v.z >> 16) | (v.w << 16)}; hr[7] = (bf16)(v.w >> 16);
            } }
        if (m == 255) for (int c = F.tid; c < 1024; c += 512) { bf16* hr = HR + (size_t)c * HRL; hr[0] = 0; *(v4u*)(hr + 4096) = (v4u){0u, 0u, 0u, 0u}; }
        __syncthreads();
    }
    {
        LAS unsigned char* scr = F.lds + F.wave * 8192;
        const int gw = F.vcu * NWAVES + F.wave, NGW = F.G * NWAVES;
        constexpr int I_IN = 16 * 257, I_SQ = 16 * 32;
        constexpr int NB8 = pg8::NF81 * 8;
        constexpr int NITEMS = I_IN + 3 * I_SQ + 8 * NB8;
        for (int it = gw; it < NITEMS; it += NGW) {
            int r = it;
            if (r < I_IN) { p0_transpose_item(F.in[I_WIN], 1024, 8224, (bf16*)(F.ws + WS_WB1), scr, r, F.lane, RmWin()); continue; } r -= I_IN;
            if (r < I_SQ) { p0_transpose_item(F.in[I_WGLAO], 1024, 1024, (bf16*)(F.ws + WS_WG), scr, r, F.lane, RmId()); continue; } r -= I_SQ;
            if (r < I_SQ) { p0_transpose_item(F.in[I_WHYO], 1024, 1024, (bf16*)(F.ws + WS_WH), scr, r, F.lane, RmId()); continue; } r -= I_SQ;
            if (r < I_SQ) { p0_transpose_item(F.in[I_WOUT], 1024, 1024, (bf16*)(F.ws + WS_WO), scr, r, F.lane, RmId()); continue; } r -= I_SQ;
            { const int kb = r / NB8, s2_ = r % NB8, s2 = (G1CFG >= 4 && s2_ >= 96) ? s2_ + 96 : s2_, nb = s2 < 32 ? 64 + s2 : s2 < 96 ? 193 + (s2 - 32) : s2 < 192 ? 97 + (s2 - 96) : s2 < 224 ? 32 + (s2 - 192) : s2 - 224;
              fp8_transpose_kn(F.in[I_WIN], 1024, 8224, F.ws + WS_WB8, scr, kb, nb, F.lane, RmG8()); }
        }
    }
    __syncthreads();
}

__device__ __forceinline__ void p1_norm(Frame& F) {
    const int gw = F.vcu * NWAVES + F.wave, NGW = F.G * NWAVES;
    const float* mod = (const float*)(F.ws + WS_MOD);
    bf16* HX = (bf16*)(F.ws + WS_HX);
    for (int r0 = gw; r0 < NROW; r0 += 2 * NGW) {
        f32x4 v[2][4];
#pragma unroll
        for (int rr = 0; rr < 2; ++rr) { const int row = r0 + rr * NGW; if (row < NROW) {
            const float* xr = row < NTOK ? F.in[I_X] + (size_t)row * 1024 : F.in[I_CTX] + (size_t)(row - NTOK) * 1024;
#pragma unroll
            for (int j = 0; j < 4; ++j) v[rr][j] = *(const f32x4*)(xr + 4 * F.lane + 256 * j); } }
#pragma unroll
        for (int rr = 0; rr < 2; ++rr) { const int row = r0 + rr * NGW; if (row < NROW) {
            const int b = row < NTOK ? (row >> 11) : 16; const float* mb = mod + (size_t)b * 6144; float ss = 0.f;
#pragma unroll
            for (int j = 0; j < 4; ++j) ss += (v[rr][j].x * v[rr][j].x + v[rr][j].y * v[rr][j].y) + (v[rr][j].z * v[rr][j].z + v[rr][j].w * v[rr][j].w);
            const float rs = __builtin_amdgcn_rsqf(wave_sum(ss) * (1.f / 1024.f) + EPS);
#pragma unroll
            for (int j = 0; j < 4; ++j) { const int col = 4 * F.lane + 256 * j;
                const f32x4 w = *(const f32x4*)(F.in[I_NMIX] + col), sh = *(const f32x4*)(mb + col), sc = *(const f32x4*)(mb + 1024 + col);
                const f32x4 y = (v[rr][j] * rs) * w * (sc + 1.f) + sh;
                v2u o; o.x = pk2(y.x, y.y); o.y = pk2(y.z, y.w);
                *(v2u*)(HX + (size_t)row * 1024 + col) = o;
                if (row < NTOK) { int w8 = 0; w8 = __builtin_amdgcn_cvt_pk_fp8_f32(y.x, y.y, w8, false); w8 = __builtin_amdgcn_cvt_pk_fp8_f32(y.z, y.w, w8, true); *(int*)(F.ws + WS_HX8 + (size_t)row * 1024 + col) = w8; } } } }
    }
}

constexpr int GL_QD = 0, GL_KI = 17408, GL_WGK = 34816, GL_BIAS = 43008;
constexpr float QSCALE = 16.f, QSCALE_INV = 1.f / 16.f;
__device__ __forceinline__ f32x4 mfma16(bf16x8 a, bf16x8 b, f32x4 c) { return __builtin_amdgcn_mfma_f32_16x16x32_bf16(a, b, c, 0, 0, 0); }
#define DPP_ADDM(v, ctrl, rmask) ((v) + __builtin_bit_cast(float, __builtin_amdgcn_update_dpp(0, __builtin_bit_cast(int, (v)), (ctrl), (rmask), 0xf, true)))
__device__ __forceinline__ float wave_incl_scan(float v) {
    v = DPP_ADDM(v, 0x111, 0xf); v = DPP_ADDM(v, 0x112, 0xf); v = DPP_ADDM(v, 0x114, 0xf); v = DPP_ADDM(v, 0x118, 0xf);
    v = DPP_ADDM(v, 0x142, 0xa);
    v = DPP_ADDM(v, 0x143, 0xc);
    return v;
}
constexpr int XW_UP = 8 * 8, XW_DN = 8 * 4, XW_NIT = NE * (XW_UP + XW_DN), XW_LDS = 49152;
#define XW_DECODE(it_) const bool isup_ = (it_) < NE * XW_UP; const int r_ = isup_ ? (it_) : (it_) - NE * XW_UP; const int sh_ = isup_ ? 6 : 5; const int e_ = r_ >> sh_, q_ = r_ & ((1 << sh_) - 1); \
        const int N_ = isup_ ? 2048 : 1024, kb_ = q_ >> (sh_ - 3), nb_ = q_ & ((1 << (sh_ - 3)) - 1); const float* W_ = (isup_ ? F.in[I_WUP] : F.in[I_WDN]) + (size_t)e_ * 1024 * N_;
#define XW_LOAD(it_) do { XW_DECODE(it_) _Pragma("unroll") for (int i = 0; i < 16; ++i) vn[i] = *(const f32x4*)(W_ + (size_t)(128 * kb_ + 16 * F.wave + i) * N_ + 256 * nb_ + 4 * F.lane); } while (0)
#define XW_CONVERT(T_) do { _Pragma("unroll") for (int q = 0; q < 4; ++q) { int wd[4]; \
            _Pragma("unroll") for (int d2 = 0; d2 < 4; ++d2) { int w0 = 0; \
                w0 = __builtin_amdgcn_cvt_pk_fp8_f32(vn[4 * d2][q] * pg8::WSCALE, vn[4 * d2 + 1][q] * pg8::WSCALE, w0, false); \
                w0 = __builtin_amdgcn_cvt_pk_fp8_f32(vn[4 * d2 + 2][q] * pg8::WSCALE, vn[4 * d2 + 3][q] * pg8::WSCALE, w0, true); wd[d2] = w0; } \
            *(LAS v4u*)((T_) + (4 * F.lane + q) * 144 + 16 * F.wave) = (v4u){(unsigned)wd[0], (unsigned)wd[1], (unsigned)wd[2], (unsigned)wd[3]}; } } while (0)
#define XW_STORE(it_, T_) do { XW_DECODE(it_) (void)W_; unsigned char* WT = F.ws + (isup_ ? WS_WUP : WS_WDN) + (size_t)e_ * N_ * 1024; \
          _Pragma("unroll") for (int j = 0; j < 4; ++j) { const int p = F.tid + 512 * j, row = p >> 3, c = p & 7; const int n = 256 * nb_ + row; \
              const int drow = isup_ ? (256 * ((n >> 1) >> 7) + 128 * (n & 1) + ((n >> 1) & 127)) : n; \
              *(v4u*)(WT + (size_t)drow * 1024 + 128 * kb_ + 16 * c) = *(const LAS v4u*)((T_) + row * 144 + 16 * c); } } while (0)
__device__ __forceinline__ void gla_prep(Frame& F) {
    const int tid = F.tid, lane = F.lane, w = F.wave, fr = lane & 15, fq = lane >> 4;
    LAS unsigned char* L = F.lds;
    const bf16* Qb = (const bf16*)(F.ws + WS_QB); const bf16* Kb = (const bf16*)(F.ws + WS_KB); const float* Rf = (const float*)(F.ws + WS_RF);
    int cur_hd = -1;
    f32x4 r4n[4]; v4u kvn[2], qvn[2];
#define GP_LOAD(uu) do { const int dir_ = (uu) & 1, h_ = ((uu) >> 1) & 3, cg_ = (uu) >> 3; const bool ic_ = cg_ >= 512; \
        const size_t row_ = (size_t)((ic_ ? (NTOK + ((cg_ - 512) >> 2) * 256 + 64 * ((cg_ - 512) & 3)) : ((cg_ >> 5) * 2048 + 64 * (cg_ & 31))) + lane); \
        _Pragma("unroll") for (int q = 0; q < 4; ++q) r4n[q] = *(const f32x4*)(Rf + row_ * 32 + 16 * dir_ + 4 * q); \
        _Pragma("unroll") for (int q = 0; q < 2; ++q) { kvn[q] = *(const v4u*)(Kb + row_ * 512 + 128 * h_ + 16 * w + 8 * q); qvn[q] = ic_ ? (v4u){0u, 0u, 0u, 0u} : *(const v4u*)(Qb + row_ * 512 + 128 * h_ + 16 * w + 8 * q); } } while (0)
    if ((int)blockIdx.x < 576 * 8) GP_LOAD((int)blockIdx.x);
    f32x4 vn[16]; int xit = blockIdx.x, xn = 0, xprev = 0; bool xpend = false; LAS unsigned char* XTp = L + XW_LDS;
    for (int u = blockIdx.x; u < 576 * 8; u += F.G) {
        const int dir = u & 1, h = (u >> 1) & 3, cg = u >> 3;
        const bool isctx = cg >= 512;
        const int rowbase = isctx ? (NTOK + ((cg - 512) >> 2) * 256 + 64 * ((cg - 512) & 3)) : ((cg >> 5) * 2048 + 64 * (cg & 31));
        const size_t row = (size_t)(rowbase + lane);
        f32x4 r4[4]; v4u kv[2], qv[2];
#pragma unroll
        for (int q = 0; q < 4; ++q) r4[q] = r4n[q];
#pragma unroll
        for (int q = 0; q < 2; ++q) { kv[q] = kvn[q]; qv[q] = qvn[q]; }
        if (u + F.G < 576 * 8) GP_LOAD(u + F.G);
        const bool xload = xit < XW_NIT;
        if (xload) XW_LOAD(xit);
        if ((u & 7) != cur_hd) {
            __syncthreads();
            { const int idx = 4 * tid, m = idx >> 7, dd = idx & 127; *(LAS f32x4*)(L + GL_WGK + idx * 4) = *(const f32x4*)(F.in[dir ? I_WGKB : I_WGKF] + m * 512 + 128 * h + dd); }
            if (tid < 32) *(LAS f32x4*)(L + GL_BIAS + 16 * tid) = *(const f32x4*)(F.in[dir ? I_BGKB : I_BGKF] + 128 * h + 4 * tid);
            __syncthreads();
            cur_hd = u & 7;
        }
        float a[16];
#pragma unroll
        for (int q = 0; q < 4; ++q) { const f32x4 bv = *(const LAS f32x4*)(L + GL_BIAS + (16 * w + 4 * q) * 4); a[4 * q] = bv.x; a[4 * q + 1] = bv.y; a[4 * q + 2] = bv.z; a[4 * q + 3] = bv.w; }
#pragma unroll
        for (int m = 0; m < 16; ++m) { const float rm = r4[m >> 2][m & 3];
#pragma unroll
            for (int q = 0; q < 4; ++q) { const f32x4 wv = *(const LAS f32x4*)(L + GL_WGK + (m * 128 + 16 * w + 4 * q) * 4);
                a[4 * q] += rm * wv.x; a[4 * q + 1] += rm * wv.y; a[4 * q + 2] += rm * wv.z; a[4 * q + 3] += rm * wv.w; } }
        const size_t ck = (size_t)(dir * 576 + cg) * 4 + h;
        unsigned qdw[8], kiw[8]; float decv[16]; int ku8[4] = {0, 0, 0, 0}, qd8[4] = {0, 0, 0, 0};
#pragma unroll
        for (int dd = 0; dd < 16; dd += 2) {
            float ei[2], kk2[2], qq2[2], kuv[2];
#pragma unroll
            for (int x = 0; x < 2; ++x) { const float av = a[dd + x];
                const float g = (fminf(av, 0.f) - __logf(1.f + __expf(-fabsf(av)))) * (1.f / 16.f);
                const float incl = wave_incl_scan(g);
                const float tot = __builtin_bit_cast(float, __builtin_amdgcn_readlane(__builtin_bit_cast(int, incl), 63));
                const float bc = dir ? (tot - incl + g) : incl;
                ei[x] = __expf(-bc); const float dec = __expf(tot); decv[dd + x] = dec;
                const unsigned kw = kv[(dd + x) >> 3][((dd + x) >> 1) & 3], qw = qv[(dd + x) >> 3][((dd + x) >> 1) & 3];
                kk2[x] = x ? bfhi(kw) : bflo(kw); qq2[x] = x ? bfhi(qw) : bflo(qw);
                kuv[x] = kk2[x] * (dec * ei[x]); }
            kiw[dd >> 1] = pk2(kk2[0] * ei[0], kk2[1] * ei[1]);
            const float qd0 = qq2[0] * __builtin_amdgcn_rcpf(ei[0]), qd1 = qq2[1] * __builtin_amdgcn_rcpf(ei[1]);
            qdw[dd >> 1] = pk2(qd0, qd1);
            if ((dd >> 1) & 1) { ku8[dd >> 2] = __builtin_amdgcn_cvt_pk_fp8_f32(kuv[0], kuv[1], ku8[dd >> 2], true); qd8[dd >> 2] = __builtin_amdgcn_cvt_pk_fp8_f32(qd0 * QSCALE, qd1 * QSCALE, qd8[dd >> 2], true); }
            else { ku8[dd >> 2] = __builtin_amdgcn_cvt_pk_fp8_f32(kuv[0], kuv[1], ku8[dd >> 2], false); qd8[dd >> 2] = __builtin_amdgcn_cvt_pk_fp8_f32(qd0 * QSCALE, qd1 * QSCALE, qd8[dd >> 2], false); } }
        *(v4u*)(F.ws + WS_KUT + (ck * 64 + lane) * 128 + 16 * w) = (v4u){(unsigned)ku8[0], (unsigned)ku8[1], (unsigned)ku8[2], (unsigned)ku8[3]};
        if (lane == 0) { float* dp = (float*)(F.ws + WS_DEC) + ck * 128 + 16 * w;
#pragma unroll
            for (int q = 0; q < 4; ++q) *(f32x4*)(dp + 4 * q) = (f32x4){decv[4 * q], decv[4 * q + 1], decv[4 * q + 2], decv[4 * q + 3]}; }
        if (!isctx) {
            *(v4u*)(F.ws + WS_QD + (size_t)dir * NTOK * 512 + row * 512 + 128 * h + 16 * w) = (v4u){(unsigned)qd8[0], (unsigned)qd8[1], (unsigned)qd8[2], (unsigned)qd8[3]};
            *(LAS v4u*)(L + GL_QD + lane * 272 + 32 * w) = (v4u){qdw[0], qdw[1], qdw[2], qdw[3]}; *(LAS v4u*)(L + GL_QD + lane * 272 + 32 * w + 16) = (v4u){qdw[4], qdw[5], qdw[6], qdw[7]};
            *(LAS v4u*)(L + GL_KI + lane * 272 + 32 * w) = (v4u){kiw[0], kiw[1], kiw[2], kiw[3]}; *(LAS v4u*)(L + GL_KI + lane * 272 + 32 * w + 16) = (v4u){kiw[4], kiw[5], kiw[6], kiw[7]};
            __syncthreads();
            if (xpend) XW_STORE(xprev, XTp);
            unsigned char* ag = F.ws + WS_ATT + ((size_t)(dir * 512 + cg) * 4 + h) * 4096;
            bf16x8 fa[2][4], fb[2][4];
#pragma unroll
            for (int tt = 0; tt < 2; ++tt) { const int t = 2 * w + tt, jt = t >> 2, it = t & 3;
#pragma unroll
                for (int ks = 0; ks < 4; ++ks) { fa[tt][ks] = *(const LAS bf16x8*)(L + GL_KI + (16 * jt + fr) * 272 + (32 * ks + 8 * fq) * 2); fb[tt][ks] = *(const LAS bf16x8*)(L + GL_QD + (16 * it + fr) * 272 + (32 * ks + 8 * fq) * 2); } }
#pragma unroll
            for (int tt = 0; tt < 2; ++tt) { const int t = 2 * w + tt, jt = t >> 2, it = t & 3;
                f32x4 a4 = (f32x4){0.f, 0.f, 0.f, 0.f};
#pragma unroll
                for (int ks = 0; ks < 4; ++ks) a4 = mfma16(fa[tt][ks], fb[tt][ks], a4);
                const int i = 16 * it + fr;
#pragma unroll
                for (int rgi = 0; rgi < 4; ++rgi) { const int j = 16 * jt + 4 * fq + rgi; const bool keep = dir ? (j >= i) : (j <= i); a4[rgi] = keep ? a4[rgi] : 0.f; }
                int o8 = 0; o8 = __builtin_amdgcn_cvt_pk_fp8_f32(a4[0], a4[1], o8, false); o8 = __builtin_amdgcn_cvt_pk_fp8_f32(a4[2], a4[3], o8, true);
                *(int*)(ag + (16 * it + fr) * 64 + 16 * jt + 4 * fq) = o8; }
            __syncthreads();
        } else if (xpend) { __syncthreads(); XW_STORE(xprev, XTp); }
        xpend = false;
        if (xload) { XTp = L + XW_LDS + (xn & 1) * 36864; XW_CONVERT(XTp); xprev = xit; xpend = true; xit += F.G; ++xn; }
    }
#undef GP_LOAD
    __syncthreads();
    if (xpend) XW_STORE(xprev, XTp);
    __syncthreads();
}

__device__ __forceinline__ void p_expert_weights(Frame& F) {
    const int nun = (int)blockIdx.x < 576 * 8 ? (576 * 8 - 1 - (int)blockIdx.x) / F.G + 1 : 0;
    int it = blockIdx.x + nun * F.G, nit = 0;
    f32x4 vn[16];
    if (it < XW_NIT) XW_LOAD(it);
    for (; it < XW_NIT; it += F.G, ++nit) {
        LAS unsigned char* T = F.lds + (nit & 1) * 36864;
        XW_CONVERT(T);
        if (it + F.G < XW_NIT) XW_LOAD(it + F.G);
        __syncthreads();
        XW_STORE(it, T);
    }
    __syncthreads();
}

constexpr int SC_STAGE = 57856, SC_QD = 0, SC_ATT = 16384, SC_KUT = 24576, SC_VT = 40960, SC_DEC = 57344, SC_ST = 2 * SC_STAGE;
__device__ __forceinline__ int sw16(int row, int c16) { return row * 256 + ((c16 ^ (row & 15)) << 4); }
__device__ __forceinline__ int sw8(int row, int c8) { return row * 128 + ((c8 ^ ((row >> 1) & 7)) << 4); }
constexpr float OSCALE = 1.f / 16.f;
struct ScanRegs { v4u q, a, k, v; f32x4 dec; };
__device__ __forceinline__ void scan_chunk_ids(int b, int dir, int s, bool& isctx, int& cgk, int& cga, int& rowq, int& rowk) {
    isctx = s < 4;
    const int ci = isctx ? (dir ? 3 - s : s) : (dir ? 31 - (s - 4) : (s - 4));
    cgk = isctx ? (512 + b * 4 + ci) : (b * 32 + ci); cga = b * 32 + ci;
    rowq = b * 2048 + 64 * ci; rowk = isctx ? (NTOK + b * 256 + 64 * ci) : rowq;
}
__device__ __forceinline__ void scan_issue(const unsigned char* ws, int tid, int b, int h, int dir, int dvh, int s, ScanRegs& R) {
    bool isctx; int cgk, cga, rowq, rowk; scan_chunk_ids(b, dir, s, isctx, cgk, cga, rowq, rowk);
    const int lane = tid & 63, w = tid >> 6;
    const unsigned char* kb_ = ws + WS_KUT + ((size_t)(dir * 576 + cgk) * 4 + h) * 8192;
    const unsigned char* vb_ = ws + WS_VB + (size_t)rowk * 1024 + 256 * h + 128 * dvh;
    unsigned ok = lane * 128 + 16 * w, ov = lane * 1024 + 16 * w, ot = 16 * tid, oq = (tid >> 3) * 512 + 16 * (tid & 7);
    asm volatile("" : "+v"(ok), "+v"(ov), "+v"(ot), "+v"(oq));
    R.k = *(const v4u*)(kb_ + ok);
    R.v = *(const v4u*)(vb_ + ov);
    if (tid < 32) R.dec = *(const f32x4*)(ws + WS_DEC + ((size_t)(dir * 576 + cgk) * 4 + h) * 512 + ot);
    if (!isctx) {
        const unsigned char* qb_ = ws + WS_QD + (size_t)dir * NTOK * 512 + (size_t)rowq * 512 + 128 * h;
        R.q = *(const v4u*)(qb_ + oq);
        if (tid < 256) R.a = *(const v4u*)(ws + WS_ATT + ((size_t)(dir * 512 + cga) * 4 + h) * 4096 + ot);
    }
}
__device__ __forceinline__ unsigned fp8x2_bf16(int wd, bool hi, float sc) {
    typedef float f32x2_ __attribute__((ext_vector_type(2)));
    const f32x2_ f = hi ? __builtin_amdgcn_cvt_pk_f32_fp8(wd, true) : __builtin_amdgcn_cvt_pk_f32_fp8(wd, false);
    return (__builtin_bit_cast(unsigned, f[0] * sc) >> 16) | (__builtin_bit_cast(unsigned, f[1] * sc) & 0xffff0000u);
}
__device__ __forceinline__ void scan_fill(Frame& F, LAS unsigned char* G, bool isctx, const ScanRegs& R) {
    const int tid = F.tid, lane = F.lane, w = F.wave;
#pragma unroll
    for (int d2 = 0; d2 < 4; ++d2) {
        const unsigned k01 = fp8x2_bf16((int)R.k[d2], false, 1.f), k23 = fp8x2_bf16((int)R.k[d2], true, 1.f);
        const unsigned v01 = fp8x2_bf16((int)R.v[d2], false, 1.f), v23 = fp8x2_bf16((int)R.v[d2], true, 1.f);
        const int r0 = 16 * w + 4 * d2, co = 2 * (lane & 7), cj = lane >> 3;
        *(LAS bf16*)(G + SC_KUT + sw8(r0, cj) + co) = (bf16)(k01 & 0xffffu); *(LAS bf16*)(G + SC_KUT + sw8(r0 + 1, cj) + co) = (bf16)(k01 >> 16);
        *(LAS bf16*)(G + SC_KUT + sw8(r0 + 2, cj) + co) = (bf16)(k23 & 0xffffu); *(LAS bf16*)(G + SC_KUT + sw8(r0 + 3, cj) + co) = (bf16)(k23 >> 16);
        *(LAS bf16*)(G + SC_VT + sw8(r0, cj) + co) = (bf16)(v01 & 0xffffu); *(LAS bf16*)(G + SC_VT + sw8(r0 + 1, cj) + co) = (bf16)(v01 >> 16);
        *(LAS bf16*)(G + SC_VT + sw8(r0 + 2, cj) + co) = (bf16)(v23 & 0xffffu); *(LAS bf16*)(G + SC_VT + sw8(r0 + 3, cj) + co) = (bf16)(v23 >> 16); }
    if (tid < 32) *(LAS f32x4*)(G + SC_DEC + 16 * tid) = R.dec;
    if (!isctx) {
        { const int row = tid >> 3, c = tid & 7; unsigned o[8];
#pragma unroll
          for (int d2 = 0; d2 < 4; ++d2) { o[2 * d2] = fp8x2_bf16((int)R.q[d2], false, QSCALE_INV); o[2 * d2 + 1] = fp8x2_bf16((int)R.q[d2], true, QSCALE_INV); }
          *(LAS v4u*)(G + SC_QD + sw16(row, 2 * c)) = (v4u){o[0], o[1], o[2], o[3]}; *(LAS v4u*)(G + SC_QD + sw16(row, 2 * c + 1)) = (v4u){o[4], o[5], o[6], o[7]}; }
        if (tid < 256) { const int row = tid >> 2, c = tid & 3; unsigned o[8];
#pragma unroll
          for (int d2 = 0; d2 < 4; ++d2) { o[2 * d2] = fp8x2_bf16((int)R.a[d2], false, 1.f); o[2 * d2 + 1] = fp8x2_bf16((int)R.a[d2], true, 1.f); }
          *(LAS v4u*)(G + SC_ATT + sw8(row, 2 * c)) = (v4u){o[0], o[1], o[2], o[3]}; *(LAS v4u*)(G + SC_ATT + sw8(row, 2 * c + 1)) = (v4u){o[4], o[5], o[6], o[7]}; }
    }
}
__device__ __forceinline__ void scan_mma(Frame& F, LAS unsigned char* G, bool isctx, int rowq, int h, int dvh, f32x4 (&S)[8], unsigned char* O) {
    const int lane = F.lane, w = F.wave, fr = lane & 15, fq = lane >> 4;
    const int wd = w & 3, wi = w >> 2, wk = ((w & 1) << 1) | (w >> 2);
    LAS unsigned char* L = F.lds;
    bf16x8 bv[4][2];
#define SC_DVT(nv) (2 * (wd ^ ((nv) >> 1)) + ((nv) & 1))
#pragma unroll
    for (int nv = 0; nv < 4; ++nv)
#pragma unroll
        for (int ks = 0; ks < 2; ++ks) bv[nv][ks] = *(const LAS bf16x8*)(G + SC_VT + sw8(16 * SC_DVT(nv) + fr, 4 * ks + fq));
    bf16x8 as_[2][4];
    if (!isctx) {
#pragma unroll
        for (int md = 0; md < 2; ++md)
#pragma unroll
            for (int ks = 0; ks < 4; ++ks) as_[md][ks] = *(const LAS bf16x8*)(L + SC_ST + (16 * (2 * wd + md) + fr) * 272 + (32 * ks + 8 * fq) * 2);
    }
    LDS_WAIT(); __syncthreads();
    if (!isctx) {
#pragma unroll
        for (int t2 = 0; t2 < 2; ++t2) { const int it = 2 * wi + t2;
            bf16x8 ba[2], bq[4];
#pragma unroll
            for (int ks = 0; ks < 2; ++ks) ba[ks] = *(const LAS bf16x8*)(G + SC_ATT + sw8(16 * it + fr, 4 * ks + fq));
#pragma unroll
            for (int ks = 0; ks < 4; ++ks) bq[ks] = *(const LAS bf16x8*)(G + SC_QD + sw16(16 * it + fr, 4 * ks + fq));
#pragma unroll
            for (int md = 0; md < 2; ++md) { f32x4 a4 = (f32x4){0.f, 0.f, 0.f, 0.f};
#pragma unroll
                for (int ks = 0; ks < 2; ++ks) a4 = mfma16(bv[md][ks], ba[ks], a4);
#pragma unroll
                for (int ks = 0; ks < 4; ++ks) a4 = mfma16(as_[md][ks], bq[ks], a4);
                int o8 = 0; o8 = __builtin_amdgcn_cvt_pk_fp8_f32(a4[0] * OSCALE, a4[1] * OSCALE, o8, false); o8 = __builtin_amdgcn_cvt_pk_fp8_f32(a4[2] * OSCALE, a4[3] * OSCALE, o8, true);
                *(int*)(O + (size_t)(rowq + 16 * it + fr) * 1024 + 256 * h + 128 * dvh + 16 * (2 * wd + md) + 4 * fq) = o8; } }
    }
    __builtin_amdgcn_sched_barrier(0);
    {
        bf16x8 ak[2][2]; f32x4 dc[2];
#pragma unroll
        for (int mk = 0; mk < 2; ++mk) { dc[mk] = *(const LAS f32x4*)(G + SC_DEC + (16 * (2 * wk + mk) + 4 * fq) * 4);
#pragma unroll
            for (int ks = 0; ks < 2; ++ks) ak[mk][ks] = *(const LAS bf16x8*)(G + SC_KUT + sw8(16 * (2 * wk + mk) + fr, 4 * ks + fq)); }
#pragma unroll
        for (int mk = 0; mk < 2; ++mk)
#pragma unroll
            for (int nv = 0; nv < 4; ++nv) { f32x4 a4 = S[4 * mk + nv] * dc[mk];
#pragma unroll
                for (int ks = 0; ks < 2; ++ks) a4 = mfma16(ak[mk][ks], bv[nv][ks], a4);
                S[4 * mk + nv] = a4; }
#pragma unroll
        for (int mk = 0; mk < 2; ++mk)
#pragma unroll
            for (int nv = 0; nv < 4; ++nv) { const f32x4 s4 = S[4 * mk + nv]; v2u o; o.x = pk2(s4[0], s4[1]); o.y = pk2(s4[2], s4[3]);
                *(LAS v2u*)(L + SC_ST + (16 * SC_DVT(nv) + fr) * 272 + (16 * (2 * wk + mk) + 4 * fq) * 2) = o; }
    }
#undef SC_DVT
}
__device__ __forceinline__ void scan_step(Frame& F, int b, int h, int dir, int dvh, int s, ScanRegs& Rn, f32x4 (&S)[8], unsigned char* O) {
    bool isctx; int cgk, cga, rowq, rowk; scan_chunk_ids(b, dir, s, isctx, cgk, cga, rowq, rowk);
    if (s + 1 < 36) { scan_fill(F, F.lds + ((s + 1) & 1) * SC_STAGE, s + 1 < 4, Rn); if (s + 3 < 36) scan_issue(F.ws, F.tid, b, h, dir, dvh, s + 3, Rn); }
    __builtin_amdgcn_sched_barrier(0);
    scan_mma(F, F.lds + (s & 1) * SC_STAGE, isctx, rowq, h, dvh, S, O);
    __syncthreads();
}
__device__ __forceinline__ void gla_scan(Frame& F, int u) {
    const int dvh = u & 1, dir = (u >> 1) & 1, h = (u >> 2) & 3, b = u >> 4;
    const int tid = F.tid;
    LAS unsigned char* L = F.lds;
    unsigned char* O = F.ws + (dir ? WS_OB : WS_OF);
    f32x4 S[8];
#pragma unroll
    for (int mt = 0; mt < 8; ++mt) S[mt] = (f32x4){0.f, 0.f, 0.f, 0.f};
    for (int i = tid; i < 34816 / 16; i += 512) *(LAS v4u*)(L + SC_ST + 16 * i) = (v4u){0u, 0u, 0u, 0u};
    ScanRegs R0, R1;
    scan_issue(F.ws, tid, b, h, dir, dvh, 0, R0);
    scan_issue(F.ws, tid, b, h, dir, dvh, 1, R1);
    scan_fill(F, L, true, R0);
    scan_issue(F.ws, tid, b, h, dir, dvh, 2, R0);
    __syncthreads();
#pragma nounroll
    for (int s = 0; s < 36; s += 2) {
        scan_step(F, b, h, dir, dvh, s, R1, S, O);
        scan_step(F, b, h, dir, dvh, s + 1, R0, S, O);
    }
}

__device__ __forceinline__ void hy_prep(Frame& F) {
    const bf16* HY = (const bf16*)(F.ws + WS_HY); bf16* X0C = (bf16*)(F.ws + WS_X0C); bf16* UT = (bf16*)(F.ws + WS_UT);
    const float* cw = F.in[I_HCW]; const float* cb_ = F.in[I_HCB];
    LAS unsigned char* L = F.lds;
    const int tl = F.tid >> 3, cg = F.tid & 7; int nit = 0;
    pg8::u32x4 ra[2][3][3], rb[2][3][3];
#define HP_LOAD(R, it0_) do { _Pragma("unroll") for (int k = 0; k < 2; ++k) { const int it = (it0_) + k * F.G; if (it < 8192) { \
            const int b = it >> 9, gr = (it >> 4) & 31, cb = it & 15, row0 = b * 2048 + 64 * gr, c0 = 64 * cb; \
            _Pragma("unroll") for (int gi = 0; gi < 3; ++gi) { const bf16* p = HY + (size_t)(row0 + tl) * 3072 + 1024 * gi + c0 + 8 * cg; \
                R[k][gi][0] = *(const pg8::u32x4*)p; R[k][gi][1] = (pg8::u32x4){0u, 0u, 0u, 0u}; R[k][gi][2] = (pg8::u32x4){0u, 0u, 0u, 0u}; \
                if (tl > 0) R[k][gi][1] = *(const pg8::u32x4*)(p - 3072); \
                if (tl < 63) R[k][gi][2] = *(const pg8::u32x4*)(p + 3072); } } } } while (0)
#define HP_TRIP(R, it0_) do { \
        LAS unsigned char* Lt = L + (nit & 1) * 18432; ++nit; \
        _Pragma("unroll") for (int k = 0; k < 2; ++k) { const int it = (it0_) + k * F.G; if (it < 8192) { \
            const int b = it >> 9, gr = (it >> 4) & 31, cb = it & 15, row0 = b * 2048 + 64 * gr, c0 = 64 * cb; (void)b; \
            float res[3][8]; \
            _Pragma("unroll") for (int gi = 0; gi < 3; ++gi) { const int col = 1024 * gi + c0 + 8 * cg; \
                float fc[8], fp[8], fn[8]; pg8::unpack8(R[k][gi][0], fc); pg8::unpack8(R[k][gi][1], fp); pg8::unpack8(R[k][gi][2], fn); \
                const LAS float* wl = WL + col; \
                const pg8::f32x4 w0a = *(const LAS pg8::f32x4*)(wl), w0b = *(const LAS pg8::f32x4*)(wl + 4), w1a = *(const LAS pg8::f32x4*)(wl + 3072), w1b = *(const LAS pg8::f32x4*)(wl + 3072 + 4); \
                const pg8::f32x4 w2a = *(const LAS pg8::f32x4*)(wl + 6144), w2b = *(const LAS pg8::f32x4*)(wl + 6144 + 4), wba = *(const LAS pg8::f32x4*)(wl + 9216), wbb = *(const LAS pg8::f32x4*)(wl + 9216 + 4); \
                _Pragma("unroll") for (int ch = 0; ch < 4; ++ch) { res[gi][ch] = w0a[ch] * fp[ch] + w1a[ch] * fc[ch] + w2a[ch] * fn[ch] + wba[ch]; \
                    res[gi][4 + ch] = w0b[ch] * fp[4 + ch] + w1b[ch] * fc[4 + ch] + w2b[ch] * fn[4 + ch] + wbb[ch]; } } \
            { v4u o; o.x = pk2(res[0][0], res[0][1]); o.y = pk2(res[0][2], res[0][3]); o.z = pk2(res[0][4], res[0][5]); o.w = pk2(res[0][6], res[0][7]); \
              *(v4u*)(X0C + (size_t)(row0 + tl) * 1024 + c0 + 8 * cg) = o; } \
            _Pragma("unroll") for (int ch = 0; ch < 8; ++ch) *(LAS bf16*)(Lt + k * 9216 + (8 * cg + ch) * 144 + 2 * tl) = (bf16)f2bf(res[2][ch] * res[1][ch]); } } \
        __syncthreads(); \
        _Pragma("unroll") for (int k = 0; k < 2; ++k) { const int it = (it0_) + k * F.G; if (it < 8192) { \
            const int b = it >> 9, gr = (it >> 4) & 31, cb = it & 15, c0 = 64 * cb; const int cl = F.tid >> 3, piece = F.tid & 7; \
            *(v4u*)(UT + ((size_t)(c0 + cl) * 16 + b) * 2048 + 64 * gr + 8 * piece) = *(const LAS v4u*)(Lt + k * 9216 + cl * 144 + 16 * piece); } } \
    } while (0)
    const LAS float* WL = (const LAS float*)(L + 40960);
    for (int i = F.tid; i < 3 * 3072 / 4; i += 512) *(LAS pg8::f32x4*)(L + 40960 + 16 * i) = *(const pg8::f32x4*)(cw + 4 * i);
    for (int i = F.tid; i < 3072 / 4; i += 512) *(LAS pg8::f32x4*)(L + 40960 + 3 * 3072 * 4 + 16 * i) = *(const pg8::f32x4*)(cb_ + 4 * i);
    __syncthreads();
    const int step = 2 * F.G;
    HP_LOAD(ra, (int)blockIdx.x);
    for (int it0 = blockIdx.x; it0 < 8192; it0 += 2 * step) {
        HP_LOAD(rb, it0 + step);
        HP_TRIP(ra, it0);
        if (it0 + step < 8192) {
            HP_LOAD(ra, it0 + 2 * step);
            HP_TRIP(rb, it0 + step);
        }
    }
#undef HP_LOAD
#undef HP_TRIP
    __syncthreads();
}

constexpr int CV_UL = 0, CV_UB = 4240, CV_HC = 16 * CV_UB, CV_HS = 8208;
__device__ __forceinline__ void hy_conv(Frame& F) {
    const bf16* UT = (const bf16*)(F.ws + WS_UT); const bf16* HR = (const bf16*)(F.ws + WS_HR); bf16* ZT = (bf16*)(F.ws + WS_ZT);
    LAS unsigned char* L = F.lds;
    const int tid = F.tid, lane = F.lane, w = F.wave;
    const int r = lane & 31, hk = lane >> 5, msh = (8 - (r & 7)) & 7;
    const int abase = CV_HC + msh * CV_HS + (2048 - r + 8 * hk - msh) * 2;
    const int bbase = CV_UL + (lane & 15) * CV_UB + 64 + ((lane & 31) >> 4) * 64 + 16 * hk;
    v4u ur[8], hv0, hv1;
#define CV_LOAD(cc) do { _Pragma("unroll") for (int kk = 0; kk < 8; ++kk) { const int p = tid + 512 * kk; ur[kk] = *(const v4u*)(UT + ((size_t)(cc) * 16 + (p >> 8)) * 2048 + 8 * (p & 255)); } \
        { const bf16* g = HR + (size_t)(cc) * HRL + 8 * tid; hv0 = *(const v4u*)g; hv1 = *(const v4u*)(g + 8); } } while (0)
    if ((int)blockIdx.x < 1024) CV_LOAD((int)blockIdx.x);
    for (int c = blockIdx.x; c < 1024; c += F.G) {
#pragma unroll
        for (int kk = 0; kk < 8; ++kk) { const int p = tid + 512 * kk, b = p >> 8, o16 = p & 255; *(LAS v4u*)(L + CV_UL + b * CV_UB + 64 + 16 * o16) = ur[kk]; }
        if (tid < 128) { const int b = tid >> 3, wh = (tid >> 2) & 1, q4 = tid & 3; *(LAS v4u*)(L + CV_UL + b * CV_UB + (wh ? 4160 : 0) + 16 * q4) = (v4u){0u, 0u, 0u, 0u}; }
        { unsigned W[8];
#pragma unroll
          for (int q = 0; q < 4; ++q) { W[q] = hv0[q]; W[4 + q] = hv1[q]; }
#pragma unroll
          for (int m = 0; m < 8; ++m) { v4u o;
#pragma unroll
              for (int q = 0; q < 4; ++q) o[q] = (m & 1) ? ((W[(m >> 1) + q] >> 16) | (W[(m >> 1) + q + 1] << 16)) : W[(m >> 1) + q];
              *(LAS v4u*)(L + CV_HC + m * CV_HS + 16 * tid) = o; } }
        if (c + F.G < 1024) CV_LOAD(c + F.G);
        __syncthreads();
        f32x16 acc[4];
#pragma unroll
        for (int i = 0; i < 4; ++i)
#pragma unroll
            for (int q = 0; q < 16; ++q) acc[i][q] = 0.f;
        bf16x8 Bs[4][2];
#define CV_STEP(S) do { const int j = 4 * g + (S); const int qn = 2 * (32 - j) - par; const int dl = 2 * (4 * w - 32 + j) + par; \
            if (qn >= -1 && qn <= 63) { Bs[(4 - (S)) & 3][0] = *(const LAS bf16x8*)(L + bbase + qn * 64); Bs[(4 - (S)) & 3][1] = *(const LAS bf16x8*)(L + bbase + qn * 64 + 32); } \
            if (qn + 6 >= -1 && qn <= 63) { \
                const bf16x8 A0 = *(const LAS bf16x8*)(L + abase - 64 * dl), A1 = *(const LAS bf16x8*)(L + abase - 64 * dl + 32); \
                _Pragma("unroll") for (int i = 0; i < 4; ++i) { const int q = qn + 2 * i; if (q >= -1 && q <= 63) { \
                    acc[i] = __builtin_amdgcn_mfma_f32_32x32x16_bf16(A0, Bs[(i - (S) + 4) & 3][0], acc[i], 0, 0, 0); \
                    acc[i] = __builtin_amdgcn_mfma_f32_32x32x16_bf16(A1, Bs[(i - (S) + 4) & 3][1], acc[i], 0, 0, 0); } } } } while (0)
        for (int par = 0; par < 2; ++par)
            for (int g = 0; g < 9; ++g) { CV_STEP(0); CV_STEP(1); CV_STEP(2); CV_STEP(3); }
#undef CV_STEP
        { const int qs = (lane & 31) >> 4, bb = lane & 15;
#pragma unroll
          for (int i = 0; i < 4; ++i) { const int p = 8 * w + 2 * i + qs; bf16* zp = ZT + ((size_t)c * 16 + bb) * 2048 + 32 * p + 4 * hk;
#pragma unroll
              for (int g4 = 0; g4 < 4; ++g4) { v2u o; o.x = pk2(acc[i][4 * g4], acc[i][4 * g4 + 1]); o.y = pk2(acc[i][4 * g4 + 2], acc[i][4 * g4 + 3]); *(v2u*)(zp + 8 * g4) = o; } } }
        __syncthreads();
    }
#undef CV_LOAD
}

__device__ __forceinline__ void p5_post(Frame& F) {
    const int gw = F.vcu * NWAVES + F.wave, NGW = F.G * NWAVES, lane = F.lane;
    { const unsigned char* Of = F.ws + WS_OF; const unsigned char* Ob = F.ws + WS_OB; const unsigned char* OG = F.ws + WS_OG; bf16* GA = (bf16*)(F.ws + WS_GA);
      typedef float f32x2_ __attribute__((ext_vector_type(2)));
      f32x4 gn[4];
#pragma unroll
      for (int q = 0; q < 4; ++q) gn[q] = *(const f32x4*)(F.in[I_GLAN] + 16 * (lane & 15) + 4 * q);
      v4u ra[2][3], rb[2][3];
#define PP_LOAD(R, r0_) do { _Pragma("unroll") for (int rr = 0; rr < 2; ++rr) { const int row = (r0_) + rr * NGW; if (row < NTOK) { const size_t o = (size_t)row * 1024 + 16 * lane; \
            R[rr][0] = *(const v4u*)(Of + o); R[rr][1] = *(const v4u*)(Ob + o); R[rr][2] = *(const v4u*)(OG + o); } } } while (0)
#define PP_TRIP(R, r0_) do { _Pragma("unroll") for (int rr = 0; rr < 2; ++rr) { const int row = (r0_) + rr * NGW; if (row < NTOK) { \
            f32x4 v[4], og[4]; float ss = 0.f; \
            _Pragma("unroll") for (int q = 0; q < 4; ++q) { \
                const f32x2_ al = __builtin_amdgcn_cvt_pk_f32_fp8((int)R[rr][0][q], false), ah = __builtin_amdgcn_cvt_pk_f32_fp8((int)R[rr][0][q], true); \
                const f32x2_ bl = __builtin_amdgcn_cvt_pk_f32_fp8((int)R[rr][1][q], false), bh = __builtin_amdgcn_cvt_pk_f32_fp8((int)R[rr][1][q], true); \
                const f32x2_ gl = __builtin_amdgcn_cvt_pk_f32_fp8((int)R[rr][2][q], false), gh = __builtin_amdgcn_cvt_pk_f32_fp8((int)R[rr][2][q], true); \
                v[q] = (f32x4){al[0] + bl[0], al[1] + bl[1], ah[0] + bh[0], ah[1] + bh[1]}; og[q] = (f32x4){gl[0], gl[1], gh[0], gh[1]}; \
                ss += (v[q].x * v[q].x + v[q].y * v[q].y) + (v[q].z * v[q].z + v[q].w * v[q].w); } \
            ss = DPP_ADD(ss, 0xB1); ss = DPP_ADD(ss, 0x4E); ss = DPP_ADD(ss, 0x141); ss = DPP_ADD(ss, 0x140);        \
            const float rs = __builtin_amdgcn_rsqf(ss * (1.f / 256.f) + EPS * (OSCALE * OSCALE));        \
            unsigned ow[8]; \
            _Pragma("unroll") for (int q = 0; q < 4; ++q) { f32x4 g = og[q]; \
                _Pragma("unroll") for (int e = 0; e < 4; ++e) g[e] = g[e] * sigmoidf_(g[e]);          \
                const f32x4 y = (v[q] * rs) * gn[q] * g; ow[2 * q] = pk2(y.x, y.y); ow[2 * q + 1] = pk2(y.z, y.w); } \
            bf16* gp = GA + (size_t)row * 1024 + 16 * lane; \
            *(v4u*)gp = (v4u){ow[0], ow[1], ow[2], ow[3]}; *(v4u*)(gp + 8) = (v4u){ow[4], ow[5], ow[6], ow[7]}; } } } while (0)
      const int rstep = 2 * NGW;
      PP_LOAD(ra, gw);
      for (int row0 = gw; row0 < NTOK; row0 += 2 * rstep) {
          PP_LOAD(rb, row0 + rstep);
          PP_TRIP(ra, row0);
          if (row0 + rstep < NTOK) { PP_LOAD(ra, row0 + 2 * rstep); PP_TRIP(rb, row0 + rstep); }
      }
#undef PP_LOAD
#undef PP_TRIP
    }
    { const bf16* ZT = (const bf16*)(F.ws + WS_ZT); const bf16* X0C = (const bf16*)(F.ws + WS_X0C); bf16* YH = (bf16*)(F.ws + WS_YH);
      LAS unsigned char* L = F.lds; int nit = 0;
      const int cl = F.tid >> 3, piece = F.tid & 7, tl = F.tid >> 3, cg = F.tid & 7;
      v4u za[2], zb[2]; pg8::u32x4 xa[2], xb[2];
#define PH_LOAD(Z, X, it0_) do { _Pragma("unroll") for (int k = 0; k < 2; ++k) { const int it = (it0_) + k * F.G; if (it < 8192) { const int b = it >> 9, tb = (it >> 4) & 31, cb = it & 15, row0 = b * 2048 + 64 * tb, c0 = 64 * cb; \
              Z[k] = *(const v4u*)(ZT + ((size_t)(c0 + cl) * 16 + b) * 2048 + 64 * tb + 8 * piece); \
              X[k] = *(const pg8::u32x4*)(X0C + (size_t)(row0 + tl) * 1024 + c0 + 8 * cg); } } } while (0)
#define PH_TRIP(Z, X, it0_) do { \
          LAS unsigned char* Lt = L + (nit & 1) * 18432; ++nit; \
          _Pragma("unroll") for (int k = 0; k < 2; ++k) { const int it = (it0_) + k * F.G; if (it < 8192) *(LAS v4u*)(Lt + k * 9216 + cl * 144 + 16 * piece) = Z[k]; } \
          __syncthreads(); \
          _Pragma("unroll") for (int k = 0; k < 2; ++k) { const int it = (it0_) + k * F.G; if (it < 8192) { const int b = it >> 9, tb = (it >> 4) & 31, cb = it & 15, row0 = b * 2048 + 64 * tb, c0 = 64 * cb; \
              float xf[8]; pg8::unpack8(X[k], xf); float y[8]; \
              _Pragma("unroll") for (int ch = 0; ch < 8; ++ch) y[ch] = xf[ch] * bf2f(*(const LAS bf16*)(Lt + k * 9216 + (8 * cg + ch) * 144 + 2 * tl)); \
              v4u o; o.x = pk2(y[0], y[1]); o.y = pk2(y[2], y[3]); o.z = pk2(y[4], y[5]); o.w = pk2(y[6], y[7]); \
              *(v4u*)(YH + (size_t)(row0 + tl) * 1024 + c0 + 8 * cg) = o; } } } while (0)
      const int step = 2 * F.G;
      PH_LOAD(za, xa, (int)blockIdx.x);
      for (int it0 = blockIdx.x; it0 < 8192; it0 += 2 * step) {
          PH_LOAD(zb, xb, it0 + step);
          PH_TRIP(za, xa, it0);
          if (it0 + step < 8192) { PH_LOAD(za, xa, it0 + 2 * step); PH_TRIP(zb, xb, it0 + step); }
      }
#undef PH_LOAD
#undef PH_TRIP
      __syncthreads(); }
}

constexpr int RT_RS = 2064;
constexpr int RT_WH = 0, RT_WL = 32 * RT_RS, RT_LG = 64 * RT_RS;
__device__ __forceinline__ void p9_router(Frame& F, bool count = true) {
    LAS unsigned char* L = F.lds;
    for (int it = 0; it < 64; ++it) { const int idx = F.tid + 512 * it, k = idx >> 5, e = idx & 31; const float wv = F.in[I_WRT][idx];
        const unsigned hi = f2bf(wv); const unsigned lo = f2bf(wv - bf2f(hi));
        *(LAS bf16*)(L + RT_WH + e * RT_RS + 2 * k) = (bf16)hi; *(LAS bf16*)(L + RT_WL + e * RT_RS + 2 * k) = (bf16)lo; }
    if (F.tid < 32) F.LC[LC_HIST + F.tid] = 0u;
    __syncthreads();
    const int gw = F.vcu * NWAVES + F.wave, NGW = F.G * NWAVES, lane = F.lane, fr = lane & 15, fq = lane >> 4;
    const float* mod = (const float*)(F.ws + WS_MOD);
    unsigned char* H8 = F.ws + WS_H8; int* toke = (int*)(F.ws + WS_TOKE); float* tokw = (float*)(F.ws + WS_TOKW);
    LAS float* LG = (LAS float*)(L + RT_LG + F.wave * 2048);
    for (int g = gw; g < NTOK / 16; g += NGW) {
        const int row = 16 * g + fr; const bf16* xr = (const bf16*)(F.ws + WS_XM) + (size_t)row * 1024 + 8 * fq; const float* mb = mod + (size_t)(row >> 11) * 6144 + 8 * fq;
        float ss = 0.f;
#pragma unroll 8
        for (int s = 0; s < 32; ++s) { float a[8]; pg8::unpack8(*(const pg8::u32x4*)(xr + 32 * s), a);
            ss += (a[0] * a[0] + a[1] * a[1]) + (a[2] * a[2] + a[3] * a[3]) + (a[4] * a[4] + a[5] * a[5]) + (a[6] * a[6] + a[7] * a[7]); }
        ss += __shfl_xor(ss, 16); ss += __shfl_xor(ss, 32);
        const float rs = __builtin_amdgcn_rsqf(ss * (1.f / 1024.f) + EPS);
        f32x4 acc0 = (f32x4){0.f, 0.f, 0.f, 0.f}, acc1 = (f32x4){0.f, 0.f, 0.f, 0.f};
        const float* nfp = F.in[I_NFFN] + 8 * fq;
#pragma unroll 2
        for (int s = 0; s < 32; ++s) {
            float x[8], w[8], sh[8], sc[8];
            pg8::unpack8(*(const pg8::u32x4*)(xr + 32 * s), x);
            *(f32x4*)&w[0] = *(const f32x4*)(nfp + 32 * s); *(f32x4*)&w[4] = *(const f32x4*)(nfp + 32 * s + 4);
            *(f32x4*)&sh[0] = *(const f32x4*)(mb + 3072 + 32 * s); *(f32x4*)&sh[4] = *(const f32x4*)(mb + 3072 + 32 * s + 4);
            *(f32x4*)&sc[0] = *(const f32x4*)(mb + 4096 + 32 * s); *(f32x4*)&sc[4] = *(const f32x4*)(mb + 4096 + 32 * s + 4);
            unsigned hi[8], lo[8]; float hv[8];
#pragma unroll
            for (int q = 0; q < 8; ++q) { const float h = (x[q] * rs) * w[q] * (sc[q] + 1.f) + sh[q]; hv[q] = h; hi[q] = f2bf(h); lo[q] = f2bf(h - bf2f(hi[q])); }
            v4u ah, al;
#pragma unroll
            for (int q = 0; q < 4; ++q) { ah[q] = hi[2 * q] | (hi[2 * q + 1] << 16); al[q] = lo[2 * q] | (lo[2 * q + 1] << 16); }
            { int w0 = 0, w1 = 0;
              w0 = __builtin_amdgcn_cvt_pk_fp8_f32(hv[0], hv[1], w0, false); w0 = __builtin_amdgcn_cvt_pk_fp8_f32(hv[2], hv[3], w0, true);
              w1 = __builtin_amdgcn_cvt_pk_fp8_f32(hv[4], hv[5], w1, false); w1 = __builtin_amdgcn_cvt_pk_fp8_f32(hv[6], hv[7], w1, true);
              *(v2u*)(H8 + (size_t)row * 1024 + 32 * s + 8 * fq) = (v2u){(unsigned)w0, (unsigned)w1}; }
            const bf16x8 AH = __builtin_bit_cast(bf16x8, ah), AL = __builtin_bit_cast(bf16x8, al);
            const int bo = fr * RT_RS + (32 * s + 8 * fq) * 2;
            const bf16x8 BH0 = *(const LAS bf16x8*)(L + RT_WH + bo), BH1 = *(const LAS bf16x8*)(L + RT_WH + 16 * RT_RS + bo);
            const bf16x8 BL0 = *(const LAS bf16x8*)(L + RT_WL + bo), BL1 = *(const LAS bf16x8*)(L + RT_WL + 16 * RT_RS + bo);
            acc0 = mfma16(AH, BH0, acc0); acc1 = mfma16(AH, BH1, acc1);
            acc0 = mfma16(AH, BL0, acc0); acc1 = mfma16(AH, BL1, acc1);
            acc0 = mfma16(AL, BH0, acc0); acc1 = mfma16(AL, BH1, acc1);
        }
#pragma unroll
        for (int r = 0; r < 4; ++r) { LG[(4 * fq + r) * 32 + fr] = acc0[r]; LG[(4 * fq + r) * 32 + 16 + fr] = acc1[r]; }
        LDS_WAIT(); asm volatile("" ::: "memory");
        if (lane < 16) {
            float lg[32];
#pragma unroll
            for (int q = 0; q < 8; ++q) { const f32x4 v = *(const LAS f32x4*)(LG + lane * 32 + 4 * q); const f32x4 bb = *(const f32x4*)(F.in[I_BRT] + 4 * q);
                lg[4 * q] = v.x + bb.x; lg[4 * q + 1] = v.y + bb.y; lg[4 * q + 2] = v.z + bb.z; lg[4 * q + 3] = v.w + bb.w; }
            int bi[4]; float bv[4];
#pragma unroll
            for (int k = 0; k < 4; ++k) { float best = -3.0e38f; int bidx = 0;
#pragma unroll
                for (int e = 0; e < 32; ++e) { if (lg[e] > best) { best = lg[e]; bidx = e; } }
#pragma unroll
                for (int e = 0; e < 32; ++e) lg[e] = (e == bidx) ? -3.4e38f : lg[e];
                bi[k] = bidx; bv[k] = best; }
            const float e1 = __expf(bv[1] - bv[0]), e2 = __expf(bv[2] - bv[0]), e3 = __expf(bv[3] - bv[0]); const float inv = 1.f / (1.f + e1 + e2 + e3);
            const int orow = 16 * g + lane;
            *(int4*)(toke + (size_t)orow * 4) = make_int4(bi[0], bi[1], bi[2], bi[3]); *(f32x4*)(tokw + (size_t)orow * 4) = (f32x4){inv, e1 * inv, e2 * inv, e3 * inv};
#pragma unroll
            for (int k = 0; k < 4; ++k) __hip_atomic_fetch_add((LAS unsigned*)&F.LC[LC_HIST + bi[k]], 1u, __ATOMIC_RELAXED, __HIP_MEMORY_SCOPE_WORKGROUP);
        }
        LDS_WAIT(); asm volatile("" ::: "memory");
    }
    __syncthreads();
    if (F.tid < 32 && count) atomicAdd(F.ctl + CW_CNT + F.tid, (unsigned)F.LC[LC_HIST + F.tid]);
    __syncthreads();
}

__device__ __forceinline__ int moe_offsets(Frame& F) {
    __syncthreads();
    if (F.tid < 64) {
        const unsigned c = (F.tid < 32) ? __hip_atomic_load(F.ctl + CW_CNT + F.tid, __ATOMIC_RELAXED, __HIP_MEMORY_SCOPE_AGENT) : 0u; const unsigned nt = (c + 255u) >> 8;
        unsigned incl = nt;
#pragma unroll
        for (int o = 1; o < 32; o <<= 1) { const unsigned tv = __shfl_up(incl, o); if (F.lane >= o) incl += tv; }
        if (F.tid < 32) F.LC[LC_OFF + F.tid] = (incl - nt) << 8;
        if (F.tid == 31) F.LC[LC_OFF + 32] = incl << 8;
    }
    __syncthreads();
    const int total = (int)(F.LC[LC_OFF + 32] >> 8);
    for (int t = F.tid; t < total; t += 512) { unsigned e = 0;
#pragma unroll
        for (int j = 1; j < 32; ++j) e += (F.LC[LC_OFF + j] <= (unsigned)(t * 256)) ? 1u : 0u;
        F.LC[LC_T2E + t] = e; }
    __syncthreads();
    return total;
}

__device__ __forceinline__ void p10_scatter(Frame& F, int cw_cur = CW_CUR) {
    (void)moe_offsets(F);
    const int* toke = (const int*)(F.ws + WS_TOKE); const float* tokw = (const float*)(F.ws + WS_TOKW);
    int* pairpos = (int*)(F.ws + WS_PAIRPOS); int* rowtok = (int*)(F.ws + WS_ROWTOK); float* roww = (float*)(F.ws + WS_ROWW);
    const unsigned char* H8 = F.ws + WS_H8; unsigned char* AX = F.ws + WS_AX;
    LAS int* PP = (LAS int*)F.lds; LAS int* PT = (LAS int*)(F.lds + 2048);
    for (int chunk = blockIdx.x; chunk < 256; chunk += F.G) {
        if (F.tid < 32) F.LC[LC_LCNT + F.tid] = 0u;
        __syncthreads();
        const int tok = chunk * 128 + (F.tid >> 2), k = F.tid & 3;
        const int e = toke[(size_t)tok * 4 + k];
        const unsigned lrank = __hip_atomic_fetch_add((LAS unsigned*)&F.LC[LC_LCNT + e], 1u, __ATOMIC_RELAXED, __HIP_MEMORY_SCOPE_WORKGROUP);
        __syncthreads();
        if (F.tid < 32) F.LC[LC_BASE + F.tid] = atomicAdd(F.ctl + cw_cur + F.tid, (unsigned)F.LC[LC_LCNT + F.tid]);
        __syncthreads();
        const int pos = (int)(F.LC[LC_OFF + e] + F.LC[LC_BASE + e] + lrank);
        rowtok[pos] = tok; roww[pos] = tokw[(size_t)tok * 4 + k]; pairpos[(size_t)tok * 4 + k] = pos;
        PP[F.tid] = pos; PT[F.tid] = tok;
        __syncthreads();
        for (int i0 = 0; i0 < 64; i0 += 8) { v4u a[8]; int ps[8];
#pragma unroll
            for (int i = 0; i < 8; ++i) { const int pi = F.wave * 64 + i0 + i; ps[i] = PP[pi]; const int tk = PT[pi]; a[i] = *(const v4u*)(H8 + (size_t)tk * 1024 + 16 * F.lane); }
#pragma unroll
            for (int i = 0; i < 8; ++i) *(v4u*)(AX + (size_t)ps[i] * 1024 + 16 * F.lane) = a[i]; }
        __syncthreads();
    }
}

__device__ __forceinline__ void p13_final(Frame& F, float* dst) {
    const int gw = F.vcu * NWAVES + F.wave, NGW = F.G * NWAVES, lane = F.lane;
    const float* mod = (const float*)(F.ws + WS_MOD); const int* pairpos = (const int*)(F.ws + WS_PAIRPOS); const unsigned char* Y = F.ws + WS_Y;
    typedef float f32x2_ __attribute__((ext_vector_type(2)));
    f32x4 nf[2][2];
#pragma unroll
    for (int j = 0; j < 2; ++j) { nf[j][0] = *(const f32x4*)(F.in[I_NFIN] + 8 * lane + 512 * j); nf[j][1] = *(const f32x4*)(F.in[I_NFIN] + 8 * lane + 512 * j + 4); }
    for (int row0 = 2 * gw; row0 < NTOK; row0 += 2 * NGW) {
        f32x4 v[2][2][2]; v2u yv[2][2][4]; f32x4 g2v[2][2][2];
#pragma unroll
        for (int rr = 0; rr < 2; ++rr) { const int row = row0 + rr; const bf16* xr = (const bf16*)(F.ws + WS_XM) + (size_t)row * 1024; const float* g2 = mod + (size_t)(row >> 11) * 6144 + 5120;
            const int4 pp = *(const int4*)(pairpos + (size_t)row * 4);
#pragma unroll
            for (int j = 0; j < 2; ++j) { const int col = 8 * lane + 512 * j;
                { float xf[8]; pg8::unpack8(*(const pg8::u32x4*)(xr + col), xf); v[rr][j][0] = (f32x4){xf[0], xf[1], xf[2], xf[3]}; v[rr][j][1] = (f32x4){xf[4], xf[5], xf[6], xf[7]}; }
                g2v[rr][j][0] = *(const f32x4*)(g2 + col); g2v[rr][j][1] = *(const f32x4*)(g2 + col + 4);
                yv[rr][j][0] = *(const v2u*)(Y + (size_t)pp.x * 1024 + col); yv[rr][j][1] = *(const v2u*)(Y + (size_t)pp.y * 1024 + col);
                yv[rr][j][2] = *(const v2u*)(Y + (size_t)pp.z * 1024 + col); yv[rr][j][3] = *(const v2u*)(Y + (size_t)pp.w * 1024 + col); } }
#pragma unroll
        for (int rr = 0; rr < 2; ++rr) { float* xr = dst + (size_t)(row0 + rr) * 1024; float ss = 0.f;
#pragma unroll
            for (int j = 0; j < 2; ++j) { float m8[8];
#pragma unroll
                for (int q = 0; q < 8; ++q) m8[q] = 0.f;
#pragma unroll
                for (int k = 0; k < 4; ++k)
#pragma unroll
                    for (int d2 = 0; d2 < 2; ++d2) { const int wd = (int)yv[rr][j][k][d2];
                        const f32x2_ lo = __builtin_amdgcn_cvt_pk_f32_fp8(wd, false), hi = __builtin_amdgcn_cvt_pk_f32_fp8(wd, true);
                        m8[4 * d2] += lo[0]; m8[4 * d2 + 1] += lo[1]; m8[4 * d2 + 2] += hi[0]; m8[4 * d2 + 3] += hi[1]; }
#pragma unroll
                for (int q = 0; q < 8; ++q) { const float x = v[rr][j][q >> 2][q & 3] + g2v[rr][j][q >> 2][q & 3] * (m8[q] * pg8::YSCALE_INV); v[rr][j][q >> 2][q & 3] = x; ss += x * x; } }
            const float rs = __builtin_amdgcn_rsqf(wave_sum(ss) * (1.f / 1024.f) + EPS);
#pragma unroll
            for (int j = 0; j < 2; ++j) { const int col = 8 * lane + 512 * j; *(f32x4*)(xr + col) = (v[rr][j][0] * rs) * nf[j][0]; *(f32x4*)(xr + col + 4) = (v[rr][j][1] * rs) * nf[j][1]; } }
    }
}

constexpr int N_PHASES = 14;
struct Args { const float* in[35]; float* out; unsigned char* ws; int ph_lo, ph_hi, flags, pad; };
__global__ void __launch_bounds__(NWAVES * 64, 2) fwd(Args args) {
    extern __shared__ __attribute__((aligned(16))) unsigned char lds[];
    Frame F;
    F.lds = (LAS unsigned char*)lds;
    F.LC = (volatile LAS unsigned*)(F.lds + LDSCTL_OFF);
    F.tid = threadIdx.x; F.lane = F.tid & 63; F.wave = __builtin_amdgcn_readfirstlane(F.tid >> 6);
    F.G = gridDim.x; { const int bx = blockIdx.x; F.vcu = (F.G % 8 == 0) ? (bx % 8) * (F.G / 8) + bx / 8 : bx; }
    F.ws = args.ws; F.out = args.out; F.ctl = (unsigned*)(args.ws + WS_CTL);
#pragma unroll
    for (int i = 0; i < 35; ++i) F.in[i] = args.in[i];
    for (int u = F.tid; u < (LDS_BYTES - LDSCTL_OFF) / 4; u += NWAVES * 64) ((LAS unsigned*)(F.lds + LDSCTL_OFF))[u] = 0u;
    __syncthreads();
    const int lo = args.ph_lo, hi = args.ph_hi;
    XcdBarrier bar; bar.bar = F.ctl + CW_BAR; bar.x = 0; bar.st = nullptr;
    if (hi - lo > 1) bar = xcd_barrier_post(F.ctl + CW_BAR, F.LC + LC_BAR);
#define IN(k) (lo <= (k) && (k) < hi)
#define REP(k) _Pragma("unroll") for (int rep_ = 0; rep_ < (((k) == PROBE_PHASE) ? 2 : 1); ++rep_)
#define SEAM(k) do { if (IN(k) && IN((k) + 1)) xcd_barrier(bar); } while (0)
    unsigned char* ws = args.ws;
    LAS unsigned char* ring = F.lds;

    if (IN(0)) REP(0) { p0_prologue(F); } SEAM(0);
    if (IN(1)) REP(1) { p1_norm(F); } SEAM(1);
    if (PROBE_PHASE == 99) { _Pragma("nounroll") for (int r_ = 0; r_ < 10; ++r_) xcd_barrier(bar); }
    if (IN(2)) REP(2) {
        pg8::Sched1 S{(const char*)(ws + WS_HX), (const char*)(ws + WS_WB1), F.G, (int)blockIdx.x};
        pg8::Epi1 E{(bf16*)(ws + WS_KB), (bf16*)(ws + WS_VB), (bf16*)(ws + WS_QB), (bf16*)(ws + WS_OG), (bf16*)(ws + WS_HY), (bf16*)(ws + WS_MA), (bf16*)(ws + WS_MB), (float*)(ws + WS_RF)};
        pg8::gemm_phase<pg8::Epi1, pg8::Sched1, false, true>(ring, 1024, S, E);
        pg8::SchedG8 S8{(const char*)(ws + WS_HX8), (const char*)(ws + WS_WB8), F.G, (int)blockIdx.x};
        pg8::EpiG8 E8{ws + WS_OG, (bf16*)(ws + WS_MA), (bf16*)(ws + WS_MB), (bf16*)(ws + WS_HY), ws + WS_VB, (bf16*)(ws + WS_KB), (bf16*)(ws + WS_QB)};
        pg8::gemm_phase<pg8::EpiG8, pg8::SchedG8, true, true, true>(ring, 512, S8, E8);
    } SEAM(2);
    if (IN(3)) { REP(30) { gla_prep(F); } REP(31) { hy_prep(F); } } SEAM(3);
    if (IN(4)) { REP(40) { for (int ub = blockIdx.x; ub < 256; ub += F.G) {
            const int u = ((((ub >> 4) << 3) | (ub & 7)) << 1) | ((ub >> 3) & 1); gla_scan(F, u); } } REP(4) { hy_conv(F); } } SEAM(4);
    if (IN(5)) REP(5) { p5_post(F); } SEAM(5);
    if (IN(6)) REP(6) {
        pg8::SchedPair S{(const char*)ws, (const char*)ws, (unsigned)WS_GA, (unsigned)WS_YH, (unsigned)WS_WG, (unsigned)WS_WH, 128, 4, F.G, (int)blockIdx.x};
        pg8::EpiMix E{(const bf16*)(ws + WS_MA), (const bf16*)(ws + WS_MB), (bf16*)(ws + WS_YM)};
        pg8::gemm_phase<pg8::EpiMix, pg8::SchedPair, true, true>(ring, 1024, S, E);
    }
    SEAM(7);
    if (IN(8)) REP(8) {
        pg8::SchedStd S{(const char*)(ws + WS_YM), (const char*)(ws + WS_WO), 128, 4, F.G, (int)blockIdx.x};
        pg8::EpiRes E{F.in[I_X], (const float*)(ws + WS_MOD), (bf16*)(ws + WS_XM)};
        pg8::gemm_phase<pg8::EpiRes, pg8::SchedStd, true, true>(ring, 1024, S, E);
    } SEAM(8);
    if (IN(9)) {
REP(90) { p_expert_weights(F); } p9_router(F, args.flags == 0); } SEAM(9);
    if (IN(10)) {
_Pragma("nounroll") for (int rep_ = (PROBE_PHASE == 10 ? 0 : 1); rep_ < 2; ++rep_) { p10_scatter(F, rep_ == 1 ? CW_CUR : CW_CUR + 64); if (rep_ == 0) xcd_barrier(bar); } } SEAM(10);
    if (IN(11)) REP(11) {
        const int nt = moe_offsets(F);
        pg8::SchedMoE S{(const char*)(ws + WS_AX), (const char*)(ws + WS_WUP), nt, 8, F.G, (int)blockIdx.x, 2048u * 1024u, (const volatile LAS unsigned*)(F.LC + LC_T2E)};
        pg8::EpiUp E{F.in[I_BUP], ws + WS_ACT};
        pg8::gemm_phase<pg8::EpiUp, pg8::SchedMoE, true, true, true>(ring, 512, S, E);
    } SEAM(11);
    if (IN(12)) REP(12) {
        const int nt = moe_offsets(F);
        pg8::SchedMoE S{(const char*)(ws + WS_ACT), (const char*)(ws + WS_WDN), nt, 4, F.G, (int)blockIdx.x, 1024u * 1024u, (const volatile LAS unsigned*)(F.LC + LC_T2E)};
        pg8::EpiDown E{F.in[I_BDN], (const float*)(ws + WS_ROWW), ws + WS_Y};
        pg8::gemm_phase<pg8::EpiDown, pg8::SchedMoE, true, true, true>(ring, 512, S, E);
    } SEAM(12);
    if (IN(13)) {
_Pragma("nounroll") for (int rep_ = (PROBE_PHASE == 13 ? 0 : 1); rep_ < 2; ++rep_) p13_final(F, rep_ == 1 ? F.out : (float*)(ws + WS_ACT)); }
#undef IN
#undef REP
#undef SEAM
}

extern "C" void kernel_launch(void* const* d_in, const int* in_sizes, int n_in, void* d_out, int out_size, void* d_ws, size_t ws_size, hipStream_t stream) {
    static int grid = 0;
    if (grid == 0) {
        if (n_in != 35 || in_sizes[0] != NTOK * D || out_size != NTOK * D || ws_size < WS_END) {
            fprintf(stderr, "kernel_launch: unexpected shapes (n_in %d, in0 %d, out %d, ws %zu < %zu); nothing launched\n", n_in, n_in > 0 ? in_sizes[0] : -1, out_size, ws_size, (size_t)WS_END); grid = -1; return; }
        int dev = 0, cus = 0, per_cu = 0;
        if (hipGetDevice(&dev) != hipSuccess || hipDeviceGetAttribute(&cus, hipDeviceAttributeMultiprocessorCount, dev) != hipSuccess) { grid = -1; return; }
        if (hipFuncSetAttribute((const void*)fwd, hipFuncAttributeMaxDynamicSharedMemorySize, LDS_BYTES) != hipSuccess) { fprintf(stderr, "kernel_launch: hipFuncSetAttribute failed\n"); grid = -1; return; }
        if (hipOccupancyMaxActiveBlocksPerMultiprocessor(&per_cu, (const void*)fwd, NWAVES * 64, LDS_BYTES) != hipSuccess || per_cu < 1)
            fprintf(stderr, "kernel_launch: note: occupancy query reports %d workgroups per CU\n", per_cu);
        (void)hipGetLastError();
        grid = cus;
    }
    if (grid < 0) return;
    if (hipMemsetAsync((char*)d_ws + WS_CTL, 0, CTL_ZERO_BYTES, stream) != hipSuccess) return;
    Args a{};
    for (int i = 0; i < 35; ++i) a.in[i] = (const float*)d_in[i];
    a.out = (float*)d_out; a.ws = (unsigned char*)d_ws;
#if MK_N_LAUNCHES == 1
    a.ph_lo = 0; a.ph_hi = N_PHASES;
    hipLaunchKernelGGL(fwd, dim3(grid), dim3(NWAVES * 64), LDS_BYTES, stream, a);
#else
    for (int k = 0; k < N_PHASES; ++k) { a.ph_lo = k; a.ph_hi = k + 1;
        if (k == PROBE_PHASE && k == 9) { a.flags = 1; hipLaunchKernelGGL(fwd, dim3(grid), dim3(NWAVES * 64), LDS_BYTES, stream, a); a.flags = 0; }
        hipLaunchKernelGGL(fwd, dim3(grid), dim3(NWAVES * 64), LDS_BYTES, stream, a); }
#endif
}
```

```cpp
#include <hip/hip_runtime.h>
#include <cstdio>
#include <cstdint>

#ifndef MK_N_LAUNCHES
#define MK_N_LAUNCHES 1
#endif
#ifndef SCAN_DUP
#define SCAN_DUP 0
#endif
#ifndef PROBE_PHASE
#define PROBE_PHASE -1
#endif

namespace pg8 {
#define PG8_LAS __attribute__((address_space(3)))
typedef unsigned short bf16_t;
typedef short bf16x8 __attribute__((ext_vector_type(8)));
typedef float f32x4 __attribute__((ext_vector_type(4)));
typedef unsigned u32x4 __attribute__((ext_vector_type(4)));
constexpr int EPI_VEC = 131072 + 2048;
constexpr int EPI_SIDE = 131072;
constexpr int BM = 256, BK = 64, HALF = 128, HTB = HALF * BK * 2  , STAGE_BYTES = 8 * HTB, NXCD = 8, WGM = 8;

__host__ __device__ __forceinline__ int lds_byte(int r, int c) { const int st = (r >> 4) * 2 + (c >> 5), rr = r & 15, cc = c & 31, ob = rr * 64 + cc * 2; return st * 1024 + (ob ^ (((ob >> 9) & 1) << 5)); }
__host__ __device__ __forceinline__ void stage_rc(int b, int& R, int& C) { const int st = b / 1024, sb = b % 1024, swz = sb ^ (((sb >> 9) & 1) << 5); R = (st >> 1) * 16 + swz / 64; C = (st & 1) * 32 + (swz % 64) / 2; }
__host__ __device__ __forceinline__ int perm32(int rho) { const int n = rho >> 4, i = rho & 15; return 8 * (i >> 2) + 4 * n + (i & 3); }

struct Unit { int pm, pn, e, x; };

__device__ __forceinline__ void tile_order(int L, int nM, int nN, int& pm, int& pn) {
    const int nwg = nM * nN; int wgid = L;
    { const int q = nwg / NXCD, r = nwg % NXCD, xcd = wgid % NXCD, off = wgid / NXCD; wgid = (xcd < r ? xcd * (q + 1) : r * (q + 1) + (xcd - r) * q) + off; }
    const int nig = WGM * nN, gid = wgid / nig, fm = gid * WGM, gsz = (nM - fm) < WGM ? (nM - fm) : WGM;
    pm = fm + ((wgid % nig) % gsz); pn = (wgid % nig) / gsz;
}

typedef int i32x8 __attribute__((ext_vector_type(8)));
typedef int i32x4_ __attribute__((ext_vector_type(4)));
__device__ __forceinline__ i32x8 cat8(bf16x8 a, bf16x8 b) { return __builtin_shufflevector(__builtin_bit_cast(i32x4_, a), __builtin_bit_cast(i32x4_, b), 0, 1, 2, 3, 4, 5, 6, 7); }
__device__ __forceinline__ void mfma_fp8_inplace(f32x4& acc, const i32x8 a, const i32x8 b) { asm volatile("v_mfma_f32_16x16x128_f8f6f4 %0, %1, %2, %0" : "+v"(acc) : "v"(a), "v"(b)); }
template <int N> __device__ __forceinline__ void wait_vm() { asm volatile("s_waitcnt vmcnt(%0)" :: "n"(N) : "memory"); }
__device__ __forceinline__ unsigned cvt_pk_bf16(float lo, float hi) { unsigned r; asm volatile("v_cvt_pk_bf16_f32 %0, %1, %2" : "=v"(r) : "v"(lo), "v"(hi)); return r; }

template <class Epi, class Sched, bool ALIGN_EPI = false, bool SP2 = false, bool FP8 = false>
__device__ __forceinline__ void gemm_phase(PG8_LAS unsigned char* lds, const int K, const Sched& S, const Epi& E) {
    const int tid = threadIdx.x, wid = __builtin_amdgcn_readfirstlane(tid >> 6), lane = tid & 63, wr = wid >> 2, wc = wid & 3, fr = lane & 15, fq = lane >> 4;
    const int nt = K / BK;
    unsigned voffA[2], voffB[2];
#pragma unroll
    for (int i = 0; i < 2; ++i) { int R, C; stage_rc(tid * 16 + i * 8192, R, C); const int Rb = Epi::PERM ? ((R & ~31) + perm32(R & 31)) : R;
        voffA[i] = (unsigned)(R * K + C) * 2u; voffB[i] = (unsigned)(Rb * K + C) * 2u; }
    const unsigned kstep = (unsigned)(BK * 2);
    const unsigned hstep = (unsigned)HALF * K * 2;
    const unsigned tstep = 2 * hstep; (void)tstep;
    const __amdgpu_buffer_rsrc_t rsA = __builtin_amdgcn_make_buffer_rsrc((void*)S.A, 0, -1, 0x00020000), rsB = __builtin_amdgcn_make_buffer_rsrc((void*)S.B, 0, -1, 0x00020000);
    const unsigned ldsw = (unsigned)wid * 1024u;
    const int aoff = lds_byte(wr * 64 + fr, fq * 8), boff = lds_byte(wc * 32 + fr, fq * 8);
#define PG8_SA(b, h) (((b) * 2 + (h)) * HTB)
#define PG8_SB(b, h) ((4 + (b) * 2 + (h)) * HTB)
#define PG8_STAGE_R(rs, bufoff, soff, voff) do { _Pragma("unroll") for (int _i = 0; _i < 2; ++_i) \
        __builtin_amdgcn_raw_ptr_buffer_load_lds((rs), (PG8_LAS void*)(lds + (bufoff) + ldsw + _i * 8192), 16, (int)(voff)[_i], (int)(soff), 0, 0); } while (0)
#define PG8_STAGE(bufoff, gbase, voff) PG8_STAGE_R(PG8_RS_##voff, bufoff, gbase, voff)
#define PG8_STAGE_A(bufoff, h, gbase, NX) do { if constexpr (Sched::GATHER) { unsigned vg_[2]; vg_[0] = (NX) ? nvg[h][0] : cvg[h][0]; vg_[1] = (NX) ? nvg[h][1] : cvg[h][1]; PG8_STAGE_R(rsA, bufoff, gbase, vg_); } \
        else PG8_STAGE_R(rsA, bufoff, (gbase) + (h) * hstep, voffA); } while (0)
#define PG8_RS_voffA rsA
#define PG8_RS_voffB rsB
#define PG8_LDA(dst, b, h) do { _Pragma("unroll") for (int m = 0; m < 4; ++m) _Pragma("unroll") for (int k = 0; k < 2; ++k) dst[m][k] = *(const PG8_LAS bf16x8*)(lds + PG8_SA(b, h) + aoff + m * 2048 + k * 1024); } while (0)
#define PG8_LDB(dst, b, h) do { _Pragma("unroll") for (int n = 0; n < 2; ++n) _Pragma("unroll") for (int k = 0; k < 2; ++k) dst[n][k] = *(const PG8_LAS bf16x8*)(lds + PG8_SB(b, h) + boff + n * 2048 + k * 1024); } while (0)
#define PG8_MMA(ai, bj, At, Bt) do { __builtin_amdgcn_s_setprio(1); _Pragma("unroll") for (int m = 0; m < 4; ++m) _Pragma("unroll") for (int n = 0; n < 2; ++n) { \
        if constexpr (FP8) { mfma_fp8_inplace(acc[ai][bj][m][n], cat8(Bt[n][0], Bt[n][1]), cat8(At[m][0], At[m][1])); } \
        else { _Pragma("unroll") for (int k = 0; k < 2; ++k) acc[ai][bj][m][n] = __builtin_amdgcn_mfma_f32_16x16x32_bf16(Bt[n][k], At[m][k], acc[ai][bj][m][n], 0, 0, 0); } } \
        __builtin_amdgcn_s_setprio(0); } while (0)
#define PG8_WAIT_V(n) asm volatile("s_waitcnt vmcnt(" #n ")" ::: "memory")
#define PG8_WAIT_L(n) asm volatile("s_waitcnt lgkmcnt(" #n ")" ::: "memory")
#define PG8_BAR __builtin_amdgcn_s_barrier()
#define PG8_SCHED __builtin_amdgcn_sched_barrier(0)
    Unit cur, nxt; int ui = 0; bool rlx_unit = false;
    if (!S.next(0, cur)) return;
    f32x4 acc[2][2][4][2];
#pragma unroll
    for (int a = 0; a < 2; ++a)
#pragma unroll
        for (int b = 0; b < 2; ++b)
#pragma unroll
            for (int m = 0; m < 4; ++m)
#pragma unroll
                for (int n = 0; n < 2; ++n) acc[a][b][m][n] = (f32x4){0.f, 0.f, 0.f, 0.f};
    bf16x8 At[4][2], B0[2][2], B1[2][2];
    unsigned cA = S.aoff(cur), cB = S.boff(cur);
    S.a_ready(cur);
    unsigned cvg[2][2] = {{0u, 0u}, {0u, 0u}}, nvg[2][2] = {{0u, 0u}, {0u, 0u}};
    unsigned gR[2] = {0u, 0u}, gC[2] = {0u, 0u};
    if constexpr (Sched::GATHER) {
#pragma unroll
        for (int i = 0; i < 2; ++i) { int R, C; stage_rc(tid * 16 + i * 8192, R, C); gR[i] = (unsigned)R * 4u; gC[i] = (unsigned)C * 2u; }
        if (wid == 0) S.ids_to_lds(cur, lds + EPI_SIDE, lane);
        asm volatile("s_waitcnt vmcnt(0)" ::: "memory"); PG8_BAR;
#pragma unroll
        for (int h = 0; h < 2; ++h)
#pragma unroll
            for (int i = 0; i < 2; ++i) { const unsigned tk = *(const PG8_LAS unsigned*)(lds + EPI_SIDE + gR[i] + h * 512) & 32767u; cvg[h][i] = tk * 1024u + gC[i]; nvg[h][i] = cvg[h][i]; }
    }
    if constexpr (SP2) {
        PG8_STAGE(PG8_SB(0, 0), cB, voffB); PG8_STAGE(PG8_SB(0, 1), cB + hstep, voffB); PG8_STAGE_A(PG8_SA(0, 0), 0, cA, false); PG8_STAGE_A(PG8_SA(0, 1), 1, cA, false);
        if (wr == 1) PG8_BAR;
        PG8_WAIT_V(2); PG8_BAR;
        PG8_STAGE(PG8_SB(1, 0), cB + kstep, voffB); PG8_STAGE_A(PG8_SA(1, 0), 0, cA + kstep, false); PG8_STAGE(PG8_SB(1, 1), cB + hstep + kstep, voffB);
        PG8_WAIT_V(6); PG8_BAR;
    } else {
        PG8_STAGE(PG8_SB(0, 0), cB, voffB); PG8_STAGE(PG8_SA(0, 0), cA, voffA); PG8_STAGE(PG8_SB(0, 1), cB + hstep, voffB); PG8_STAGE(PG8_SA(0, 1), cA + hstep, voffA);
        if (wr == 1) PG8_BAR;
        PG8_WAIT_V(4); PG8_BAR;
        PG8_STAGE(PG8_SB(1, 0), cB + kstep, voffB); PG8_STAGE(PG8_SA(1, 0), cA + kstep, voffA); PG8_STAGE(PG8_SB(1, 1), cB + hstep + kstep, voffB);
        PG8_WAIT_V(6); PG8_BAR;
    }
    for (;;) {
        cur.x = ui & 1;
        if constexpr (Epi::NPRE > 0) { if (wid == 0) E.prefetch(cur, lds + EPI_VEC + cur.x * 2048, lane); }
        const bool has_next = S.next(ui + 1, nxt);
        const unsigned nA = has_next ? S.aoff(nxt) : cA, nB = has_next ? S.boff(nxt) : cB;
        if constexpr (Sched::GATHER) { if (has_next && wid == 0) S.ids_to_lds(nxt, lds + EPI_SIDE + ((ui + 1) & 1) * 1024, lane); }
        constexpr int KREP = (PROBE_PHASE == 300 + Epi::ID) ? 2 : 1;
#pragma nounroll
        for (int krep = 0; krep < KREP; ++krep) {
        if (KREP == 2 && krep == 1) {
#pragma unroll
        for (int a = 0; a < 2; ++a)
#pragma unroll
            for (int b = 0; b < 2; ++b)
#pragma unroll
                for (int m = 0; m < 4; ++m)
#pragma unroll
                    for (int n = 0; n < 2; ++n) acc[a][b][m][n] = (f32x4){0.f, 0.f, 0.f, 0.f};
        }
        for (int t = 0; t < nt; t += 2) {
            const bool last = (t == nt - 2);
            const unsigned a1 = cA + (unsigned)(t + 1) * kstep;
            const unsigned nA_ = (KREP == 2 && krep == 0) ? cA : nA, nB_ = (KREP == 2 && krep == 0) ? cB : nB;
            const unsigned a2 = last ? nA_ : cA + (unsigned)(t + 2) * kstep, b2 = last ? nB_ : cB + (unsigned)(t + 2) * kstep;
            const unsigned a3 = a2 + kstep, b3 = b2 + kstep;
            if (last && has_next) S.a_ready(nxt);
            const bool rlx = FP8 && (t == 0) && (krep == 0) && rlx_unit;
            if constexpr (Sched::GATHER) { if (last && has_next) {
#pragma unroll
                for (int h = 0; h < 2; ++h)
#pragma unroll
                    for (int i = 0; i < 2; ++i) { const unsigned tk = *(const PG8_LAS unsigned*)(lds + EPI_SIDE + ((ui + 1) & 1) * 1024 + gR[i] + h * 512) & 32767u; nvg[h][i] = tk * 1024u + gC[i]; } } }
            if constexpr (SP2) {
            PG8_LDB(B0, 0, 0); PG8_LDB(B1, 0, 1); PG8_SCHED; PG8_LDA(At, 0, 0); PG8_STAGE_A(PG8_SA(1, 1), 1, a1, false);
            if (rlx) wait_vm<8 + 2 * Epi::NSTH>(); else wait_vm<8>();
            PG8_WAIT_L(0); PG8_BAR; PG8_MMA(0, 0, At, B0); PG8_MMA(0, 1, At, B1); PG8_BAR; PG8_SCHED;
            PG8_LDA(At, 0, 1); PG8_STAGE(PG8_SB(0, 0), b2, voffB); PG8_STAGE(PG8_SB(0, 1), b2 + hstep, voffB); PG8_STAGE_A(PG8_SA(0, 0), 0, a2, last);
            if (rlx) wait_vm<8 + 2 * Epi::NSTH>(); else wait_vm<8>();
            PG8_WAIT_L(0); PG8_BAR; PG8_MMA(1, 0, At, B0); PG8_MMA(1, 1, At, B1); PG8_BAR; PG8_SCHED;
            PG8_LDB(B0, 1, 0); PG8_LDB(B1, 1, 1); PG8_SCHED; PG8_LDA(At, 1, 0); PG8_STAGE_A(PG8_SA(0, 1), 1, a2, last);
            PG8_WAIT_V(8); PG8_WAIT_L(0); PG8_BAR; PG8_MMA(0, 0, At, B0); PG8_MMA(0, 1, At, B1); PG8_BAR; PG8_SCHED;
            PG8_LDA(At, 1, 1); PG8_STAGE(PG8_SB(1, 0), b3, voffB); PG8_STAGE(PG8_SB(1, 1), b3 + hstep, voffB); PG8_STAGE_A(PG8_SA(1, 0), 0, a3, last);
            PG8_WAIT_V(8); PG8_WAIT_L(0); PG8_BAR; PG8_MMA(1, 0, At, B0); PG8_MMA(1, 1, At, B1); PG8_BAR; PG8_SCHED;
            } else {
            PG8_LDB(B0, 0, 0); PG8_SCHED; PG8_LDA(At, 0, 0); PG8_STAGE(PG8_SA(1, 1), a1 + hstep, voffA);
            PG8_WAIT_L(8); PG8_BAR; PG8_WAIT_L(0); PG8_MMA(0, 0, At, B0); PG8_BAR; PG8_SCHED;
            PG8_LDB(B1, 0, 1); PG8_STAGE(PG8_SB(0, 0), b2, voffB);
            PG8_BAR; PG8_WAIT_L(0); PG8_MMA(0, 1, At, B1); PG8_BAR;
            PG8_LDA(At, 0, 1); PG8_STAGE(PG8_SA(0, 0), a2, voffA);
            PG8_BAR; PG8_WAIT_L(0); PG8_MMA(1, 0, At, B0); PG8_BAR; PG8_SCHED;
            PG8_STAGE(PG8_SB(0, 1), b2 + hstep, voffB);
            PG8_WAIT_V(6); PG8_BAR; PG8_MMA(1, 1, At, B1); PG8_BAR;
            PG8_LDB(B0, 1, 0); PG8_SCHED; PG8_LDA(At, 1, 0); PG8_STAGE(PG8_SA(0, 1), a2 + hstep, voffA);
            PG8_WAIT_L(8); PG8_BAR; PG8_WAIT_L(0); PG8_MMA(0, 0, At, B0); PG8_BAR; PG8_SCHED;
            PG8_LDB(B1, 1, 1); PG8_STAGE(PG8_SB(1, 0), b3, voffB);
            PG8_BAR; PG8_WAIT_L(0); PG8_MMA(0, 1, At, B1); PG8_BAR;
            PG8_LDA(At, 1, 1); PG8_STAGE(PG8_SA(1, 0), a3, voffA);
            PG8_BAR; PG8_WAIT_L(0); PG8_MMA(1, 0, At, B0); PG8_BAR; PG8_SCHED;
            PG8_STAGE(PG8_SB(1, 1), b3 + hstep, voffB);
            PG8_WAIT_V(6); PG8_BAR; PG8_MMA(1, 1, At, B1); PG8_BAR;
            }
        }
        }
        if constexpr (FP8) {
            asm volatile("s_nop 15\n\ts_nop 15" : "+v"(acc[0][0][0][0]), "+v"(acc[0][0][0][1]));
#pragma unroll
            for (int a = 0; a < 2; ++a)
#pragma unroll
                for (int b = 0; b < 2; ++b)
#pragma unroll
                    for (int m = 0; m < 4; ++m) asm volatile("" : "+v"(acc[a][b][m][0]), "+v"(acc[a][b][m][1]));
        }
        if constexpr (ALIGN_EPI) { if (wr == 0) PG8_BAR; }
        if constexpr (!Epi::AFTER_DRAIN) { E(acc, cur, wr, wc, fr, fq); if constexpr (PROBE_PHASE == 200 + Epi::ID) { asm volatile("" ::: "memory"); E(acc, cur, wr, wc, fr, fq); } S.done(cur); }
        if (!has_next) break;
        if (!E.keep(cur)) {
#pragma unroll
        for (int a = 0; a < 2; ++a)
#pragma unroll
            for (int b = 0; b < 2; ++b)
#pragma unroll
                for (int m = 0; m < 4; ++m)
#pragma unroll
                    for (int n = 0; n < 2; ++n) acc[a][b][m][n] = (f32x4){0.f, 0.f, 0.f, 0.f};
        }
        rlx_unit = E.relax_ok(cur) && !(PROBE_PHASE == 200 + Epi::ID);
        cur = nxt; cA = nA; cB = nB; ++ui;
        if constexpr (Sched::GATHER) { cvg[0][0] = nvg[0][0]; cvg[0][1] = nvg[0][1]; cvg[1][0] = nvg[1][0]; cvg[1][1] = nvg[1][1]; }
        if constexpr (ALIGN_EPI) { if (wr == 1) PG8_BAR; }
    }
    PG8_WAIT_V(0);
    if constexpr (!ALIGN_EPI) { if (wr == 0) PG8_BAR; }
    PG8_BAR;
    if constexpr (Epi::AFTER_DRAIN) { E.fused(acc, cur, wr, wc, fr, fq, lds, wid, lane); S.done(cur); }
#undef PG8_SA
#undef PG8_SB
#undef PG8_STAGE
#undef PG8_STAGE_A
#undef PG8_LDA
#undef PG8_LDB
#undef PG8_MMA
#undef PG8_WAIT_V
#undef PG8_WAIT_L
#undef PG8_BAR
#undef PG8_SCHED
}

template <class Epi, class Sched, bool FP8 = false>
__device__ __forceinline__ void gemm_phase_sp(PG8_LAS unsigned char* lds, const int K, const Sched& S, const Epi& E) {
    const int tid = threadIdx.x, wid = __builtin_amdgcn_readfirstlane(tid >> 6), lane = tid & 63, wr = wid >> 2, wc = wid & 3, fr = lane & 15, fq = lane >> 4;
    const int nt = K / BK;
    unsigned voffA[2], voffB[2];
#pragma unroll
    for (int i = 0; i < 2; ++i) { int R, C; stage_rc(tid * 16 + i * 8192, R, C); const int Rb = Epi::PERM ? ((R & ~31) + perm32(R & 31)) : R;
        voffA[i] = (unsigned)(R * K + C) * 2u; voffB[i] = (unsigned)(Rb * K + C) * 2u; }
    const unsigned kstep = (unsigned)(BK * 2);
    const unsigned hstep = (unsigned)HALF * K * 2;
    const unsigned tstep = 2 * hstep; (void)tstep;
    const __amdgpu_buffer_rsrc_t rsA = __builtin_amdgcn_make_buffer_rsrc((void*)S.A, 0, -1, 0x00020000), rsB = __builtin_amdgcn_make_buffer_rsrc((void*)S.B, 0, -1, 0x00020000);
    const unsigned ldsw = (unsigned)wid * 1024u;
    const int aoff = lds_byte(wr * 64 + fr, fq * 8), boff = lds_byte(wc * 32 + fr, fq * 8);
#define PG8_SA(b, h) (((b) * 2 + (h)) * HTB)
#define PG8_SB(b, h) ((4 + (b) * 2 + (h)) * HTB)
#define PG8_STAGE_R(rs, bufoff, soff, voff) do { _Pragma("unroll") for (int _i = 0; _i < 2; ++_i) \
        __builtin_amdgcn_raw_ptr_buffer_load_lds((rs), (PG8_LAS void*)(lds + (bufoff) + ldsw + _i * 8192), 16, (int)(voff)[_i], (int)(soff), 0, 0); } while (0)
#define PG8_STAGE(bufoff, gbase, voff) PG8_STAGE_R(PG8_RS_##voff, bufoff, gbase, voff)
#define PG8_RS_voffA rsA
#define PG8_RS_voffB rsB
#define PG8_LDA(dst, b, h) do { _Pragma("unroll") for (int m = 0; m < 4; ++m) _Pragma("unroll") for (int k = 0; k < 2; ++k) dst[m][k] = *(const PG8_LAS bf16x8*)(lds + PG8_SA(b, h) + aoff + m * 2048 + k * 1024); } while (0)
#define PG8_LDB(dst, b, h) do { _Pragma("unroll") for (int n = 0; n < 2; ++n) _Pragma("unroll") for (int k = 0; k < 2; ++k) dst[n][k] = *(const PG8_LAS bf16x8*)(lds + PG8_SB(b, h) + boff + n * 2048 + k * 1024); } while (0)
#define PG8_MMA(ai, bj, At, Bt) do { __builtin_amdgcn_s_setprio(1); _Pragma("unroll") for (int m = 0; m < 4; ++m) _Pragma("unroll") for (int n = 0; n < 2; ++n) { \
        if constexpr (FP8) { mfma_fp8_inplace(acc[ai][bj][m][n], cat8(Bt[n][0], Bt[n][1]), cat8(At[m][0], At[m][1])); } \
        else { _Pragma("unroll") for (int k = 0; k < 2; ++k) acc[ai][bj][m][n] = __builtin_amdgcn_mfma_f32_16x16x32_bf16(Bt[n][k], At[m][k], acc[ai][bj][m][n], 0, 0, 0); } } \
        __builtin_amdgcn_s_setprio(0); } while (0)
#define PG8_WAIT_V(n) asm volatile("s_waitcnt vmcnt(" #n ")" ::: "memory")
#define PG8_WAIT_L(n) asm volatile("s_waitcnt lgkmcnt(" #n ")" ::: "memory")
#define PG8_BAR __builtin_amdgcn_s_barrier()
#define PG8_SCHED __builtin_amdgcn_sched_barrier(0)
    static_assert(!Epi::AFTER_DRAIN, "split epilogue");
    Unit cur, nxt, prv; int ui = 0; bool pend = false;
    if (!S.next(0, cur)) return;
    prv = cur;
    f32x4 acc[2][2][4][2];
#pragma unroll
    for (int a = 0; a < 2; ++a)
#pragma unroll
        for (int b = 0; b < 2; ++b)
#pragma unroll
            for (int m = 0; m < 4; ++m)
#pragma unroll
                for (int n = 0; n < 2; ++n) acc[a][b][m][n] = (f32x4){0.f, 0.f, 0.f, 0.f};
    bf16x8 At[4][2], B0[2][2], B1[2][2];
    unsigned cA = S.aoff(cur), cB = S.boff(cur);
    S.a_ready(cur);
#define PG8_EPI_HALF(un, h) do { \
        if constexpr (FP8) { asm volatile("s_nop 15\n\ts_nop 15" : "+v"(acc[h][0][0][0]), "+v"(acc[h][0][0][1])); \
            _Pragma("unroll") for (int b_ = 0; b_ < 2; ++b_) _Pragma("unroll") for (int m_ = 0; m_ < 4; ++m_) asm volatile("" : "+v"(acc[h][b_][m_][0]), "+v"(acc[h][b_][m_][1])); } \
        E(acc, un, wr, wc, fr, fq, h, h + 1); \
        if (!E.keep(un)) { _Pragma("unroll") for (int b_ = 0; b_ < 2; ++b_) _Pragma("unroll") for (int m_ = 0; m_ < 4; ++m_) _Pragma("unroll") for (int n_ = 0; n_ < 2; ++n_) acc[h][b_][m_][n_] = (f32x4){0.f, 0.f, 0.f, 0.f}; } \
        if constexpr (FP8) { _Pragma("unroll") for (int b_ = 0; b_ < 2; ++b_) _Pragma("unroll") for (int m_ = 0; m_ < 4; ++m_) asm volatile("s_nop 1" : "+v"(acc[h][b_][m_][0]), "+v"(acc[h][b_][m_][1])); } \
    } while (0)
    PG8_STAGE(PG8_SB(0, 0), cB, voffB); PG8_STAGE(PG8_SB(0, 1), cB + hstep, voffB); PG8_STAGE(PG8_SA(0, 0), cA, voffA); PG8_STAGE(PG8_SA(0, 1), cA + hstep, voffA);
    if (wr == 1) PG8_BAR;
    PG8_WAIT_V(2); PG8_BAR;
    PG8_STAGE(PG8_SB(1, 0), cB + kstep, voffB); PG8_STAGE(PG8_SA(1, 0), cA + kstep, voffA); PG8_STAGE(PG8_SB(1, 1), cB + hstep + kstep, voffB);
    PG8_WAIT_V(6); PG8_BAR;
    for (;;) {
        const bool has_next = S.next(ui + 1, nxt);
        const unsigned nA = has_next ? S.aoff(nxt) : cA, nB = has_next ? S.boff(nxt) : cB;
        for (int t = 0; t < nt; t += 2) {
            const bool last = (t == nt - 2);
            const unsigned a1 = cA + (unsigned)(t + 1) * kstep;
            const unsigned a2 = last ? nA : cA + (unsigned)(t + 2) * kstep, b2 = last ? nB : cB + (unsigned)(t + 2) * kstep;
            const unsigned a3 = a2 + kstep, b3 = b2 + kstep;
            if (last && has_next) S.a_ready(nxt);
            const bool rlxB = (t == 0) && pend && E.relax_ok(prv), rlxA = last && E.relax_ok(cur);
            if (t == 0 && pend) { PG8_SCHED; PG8_EPI_HALF(prv, 1); S.done(prv); pend = false; PG8_SCHED; }
            PG8_LDB(B0, 0, 0); PG8_LDB(B1, 0, 1); PG8_SCHED; PG8_LDA(At, 0, 0); PG8_STAGE(PG8_SA(1, 1), a1 + hstep, voffA);
            if (rlxB) wait_vm<8 + 2 * Epi::NSTH>(); else wait_vm<8>();
            PG8_WAIT_L(0); PG8_BAR; PG8_MMA(0, 0, At, B0); PG8_MMA(0, 1, At, B1); PG8_BAR; PG8_SCHED;
            PG8_LDA(At, 0, 1); PG8_STAGE(PG8_SB(0, 0), b2, voffB); PG8_STAGE(PG8_SB(0, 1), b2 + hstep, voffB); PG8_STAGE(PG8_SA(0, 0), a2, voffA);
            if (rlxB) wait_vm<8 + Epi::NSTH>(); else wait_vm<8>();
            PG8_WAIT_L(0); PG8_BAR; PG8_MMA(1, 0, At, B0); PG8_MMA(1, 1, At, B1); PG8_BAR; PG8_SCHED;
            PG8_LDB(B0, 1, 0); PG8_LDB(B1, 1, 1); PG8_SCHED; PG8_LDA(At, 1, 0); PG8_STAGE(PG8_SA(0, 1), a2 + hstep, voffA);
            PG8_WAIT_V(8); PG8_WAIT_L(0); PG8_BAR; PG8_MMA(0, 0, At, B0); PG8_MMA(0, 1, At, B1); PG8_BAR; PG8_SCHED;
            if (last) { PG8_SCHED; PG8_EPI_HALF(cur, 0); PG8_SCHED; }
            PG8_LDA(At, 1, 1); PG8_STAGE(PG8_SB(1, 0), b3, voffB); PG8_STAGE(PG8_SB(1, 1), b3 + hstep, voffB); PG8_STAGE(PG8_SA(1, 0), a3, voffA);
            if (rlxA) wait_vm<8 + Epi::NSTH>(); else wait_vm<8>();
            PG8_WAIT_L(0); PG8_BAR; PG8_MMA(1, 0, At, B0); PG8_MMA(1, 1, At, B1); PG8_BAR; PG8_SCHED;
        }
        prv = cur; pend = true;
        if (!has_next) break;
        cur = nxt; cA = nA; cB = nB; ++ui;
    }
    PG8_EPI_HALF(prv, 1); S.done(prv);
    PG8_WAIT_V(0);
    if (wr == 0) PG8_BAR;
    PG8_BAR;
#undef PG8_EPI_HALF
#undef PG8_SA
#undef PG8_SB
#undef PG8_STAGE
#undef PG8_LDA
#undef PG8_LDB
#undef PG8_MMA
#undef PG8_WAIT_V
#undef PG8_WAIT_L
#undef PG8_BAR
#undef PG8_SCHED
}

}

constexpr int NB = 16, SEQ = 2048, D = 1024, CTXL = 256;
constexpr int NTOK = NB * SEQ, NCTX = NB * CTXL, NROW = NTOK + NCTX;
constexpr int NT1 = 33, N1 = NT1 * 256;
constexpr int NE = 32, TOPK = 4, DFF = 1024;
constexpr int MAXTILES = 544, MAXROWS = MAXTILES * 256;
constexpr float EPS = 1e-6f;
constexpr int NWAVES = 8;
constexpr int HRL = 4104;

constexpr size_t KiB = 1024, MiB = 1u << 20;
constexpr size_t WS_CTL = 0, CTL_ZERO_BYTES = 1 * MiB;
constexpr size_t WS_MOD = 1 * MiB;
constexpr size_t WS_TOKE = 1536 * KiB, WS_TOKW = 2048 * KiB, WS_PAIRPOS = 2560 * KiB, WS_ROWTOK = 3072 * KiB, WS_ROWW = 3840 * KiB;
constexpr size_t WS_HR = 5 * MiB;
constexpr size_t WS_WB1 = 13824 * KiB;
constexpr size_t WS_WG = 30 * MiB, WS_WH = 32 * MiB, WS_WO = 34 * MiB;
constexpr size_t WS_WUP = 68 * MiB, WS_WDN = 168 * MiB;
constexpr size_t WS_HX = 228 * MiB, WS_KB = 300 * MiB, WS_VB = 336 * MiB, WS_RF = 408 * MiB, WS_QB = 408 * MiB + 4608 * KiB;
constexpr size_t WS_OG = WS_QB + 32 * MiB, WS_HY = WS_OG + 64 * MiB, WS_MA = WS_HY + 192 * MiB, WS_MB = WS_MA + 64 * MiB;
constexpr size_t WS_OF = WS_MB + 64 * MiB, WS_OB = WS_OF + 64 * MiB, WS_UT = WS_OB + 64 * MiB, WS_END = WS_UT + 64 * MiB;
constexpr size_t WS_X0C = WS_HX, WS_ZT = WS_HY, WS_GA = WS_KB, WS_YH = WS_KB + 64 * MiB, WS_YA = WS_HY, WS_YM = WS_HY + 128 * MiB;
constexpr size_t WS_HX8 = 36 * MiB, WS_WB8 = 68 * MiB;
constexpr size_t WS_QD = 36 * MiB, WS_ATT = 207 * MiB, WS_KUT = 132 * MiB, WS_DEC = 204 * MiB;
static_assert(WS_DEC + 2 * (size_t)576 * 4 * 128 * 4 <= WS_ATT && WS_ATT + 2 * (size_t)512 * 4 * 4096 <= WS_HX && WS_QD + 2 * (size_t)NTOK * 512 <= WS_WUP && WS_WUP + (size_t)NE * 2048 * 1024 <= WS_KUT, "ws map gla");
static_assert(WS_KUT + 2 * (size_t)576 * 4 * 64 * 128 <= WS_WDN && WS_WDN + (size_t)NE * 1024 * 1024 <= WS_DEC && WS_WB8 + (size_t)32 * 256 * 1024 <= WS_KUT, "ws map gla 2");
constexpr size_t WS_XM = 428 * MiB;
constexpr size_t WS_H8 = WS_HX, WS_AX = 292 * MiB, WS_Y = WS_AX, WS_ACT = 564 * MiB;
static_assert(WS_WB1 + (size_t)N1 * 1024 * 2 <= WS_WG && WS_HR + (size_t)1024 * HRL * 2 <= WS_WB1, "ws map 1");
static_assert(WS_RF + (size_t)NROW * 32 * 4 <= WS_QB && WS_END <= 1024 * MiB && WS_YH + 64 * MiB <= WS_OG, "ws map 2");
static_assert(WS_ACT + (size_t)MAXROWS * 1024 <= WS_END && WS_Y + (size_t)MAXROWS * 1024 <= WS_ACT && WS_H8 + 32 * MiB <= WS_AX, "ws map 3");
static_assert(WS_ROWTOK + (size_t)MAXROWS * 4 <= WS_ROWW && WS_ROWW + (size_t)MAXROWS * 4 <= WS_HR, "ws map 4");
constexpr int CW_CNT = 64, CW_CUR = 128, CW_BAR = 4096;

constexpr int LDS_BYTES = 163840;
constexpr int LDSCTL_OFF = 159744;
constexpr int LC_BAR = 0  , LC_OFF = 8  , LC_HIST = 48  , LC_LCNT = 80  , LC_BASE = 112  , LC_T2E = 160  ;
static_assert((LC_T2E + MAXTILES) * 4 <= 4096, "LDS control area");

#define GAS __attribute__((address_space(1)))
#define LAS __attribute__((address_space(3)))
typedef unsigned short bf16;
typedef unsigned v4u __attribute__((ext_vector_type(4)));
typedef unsigned v2u __attribute__((ext_vector_type(2)));
typedef float f32x4 __attribute__((ext_vector_type(4)));
typedef float f32x16 __attribute__((ext_vector_type(16)));
typedef short bf16x8 __attribute__((ext_vector_type(8)));
#define LDS_WAIT() asm volatile("s_waitcnt lgkmcnt(0)" ::: "memory")
typedef __bf16 hwbf16x2 __attribute__((ext_vector_type(2)));
typedef float hwf32x2 __attribute__((ext_vector_type(2)));
__device__ __forceinline__ unsigned f2bf(float f) { return (unsigned)__builtin_bit_cast(unsigned short, (__bf16)f); }
__device__ __forceinline__ unsigned pk2(float lo, float hi) { return __builtin_bit_cast(unsigned, __builtin_convertvector((hwf32x2){lo, hi}, hwbf16x2)); }
__device__ __forceinline__ float bf2f(unsigned h) { return __builtin_bit_cast(float, h << 16); }
__device__ __forceinline__ float bflo(unsigned w) { return __builtin_bit_cast(float, w << 16); }
__device__ __forceinline__ float bfhi(unsigned w) { return __builtin_bit_cast(float, w & 0xffff0000u); }
#define DPP_ADD(v, ctrl) ((v) + __builtin_bit_cast(float, __builtin_amdgcn_update_dpp(0, __builtin_bit_cast(int, (v)), (ctrl), 0xf, 0xf, true)))
__device__ __forceinline__ float wave_sum(float v) {
    v = DPP_ADD(v, 0xB1);
    v = DPP_ADD(v, 0x4E);
    v = DPP_ADD(v, 0x141);
    v = DPP_ADD(v, 0x140);
    const float r0 = __builtin_bit_cast(float, __builtin_amdgcn_readlane(__builtin_bit_cast(int, v), 0)), r1 = __builtin_bit_cast(float, __builtin_amdgcn_readlane(__builtin_bit_cast(int, v), 16));
    const float r2 = __builtin_bit_cast(float, __builtin_amdgcn_readlane(__builtin_bit_cast(int, v), 32)), r3 = __builtin_bit_cast(float, __builtin_amdgcn_readlane(__builtin_bit_cast(int, v), 48));
    return (r0 + r1) + (r2 + r3);
}
__device__ __forceinline__ float sigmoidf_(float x) { return __builtin_amdgcn_rcpf(1.f + __expf(-x)); }

#define XB_TMO      128
#define XB_XCNT(j)  (256  + 64 * (j))
#define XB_XSUB(j)  (1280 + 64 * (j))
#define XB_XGEN(j)  (2304 + 64 * (j))
#define XB_TOP      3328
#define XB_TOPGEN   3392
#define XCD_BAR_WORDS 3456
#define XB_SPIN_CAP (1u << 18)
__device__ __forceinline__ unsigned xb_ld(unsigned* p)              { return __hip_atomic_load(p, __ATOMIC_RELAXED, __HIP_MEMORY_SCOPE_AGENT); }
__device__ __forceinline__ unsigned xb_add(unsigned* p, unsigned v) { return __hip_atomic_fetch_add(p, v, __ATOMIC_RELAXED, __HIP_MEMORY_SCOPE_AGENT); }
__device__ __forceinline__ unsigned xb_xcc_id() { return (unsigned)__builtin_amdgcn_s_getreg((3 << 11) | 20) & 0xFu; }
#define XB_SPIN(cond, bar) do { unsigned _sp = 0; while (cond) { __builtin_amdgcn_s_sleep(1); \
    if ((++_sp & 255u) == 0u) { if (xb_ld(&(bar)[XB_TMO])) break; if (_sp > XB_SPIN_CAP) { atomicAdd(&(bar)[XB_TMO], 1u); break; } } } } while (0)
struct XcdBarrier { unsigned* bar; unsigned x; volatile LAS unsigned* st; };
__device__ __forceinline__ XcdBarrier xcd_barrier_post(unsigned* bar, volatile LAS unsigned* st) {
    XcdBarrier b; b.bar = bar; b.x = xb_xcc_id(); b.st = st;
    if (threadIdx.x == 0) (void)xb_add(&bar[XB_XCNT(b.x)], 1u);
    return b;
}
__device__ __forceinline__ void xcd_barrier_complete(unsigned* bar, unsigned x, unsigned& nloc, unsigned& nx) {
    const unsigned G = gridDim.x * gridDim.y * gridDim.z;
    unsigned sum, cnt, mine, sp = 0u;
    for (;;) {
        sum = 0u; cnt = 0u; mine = 0u;
#pragma unroll
        for (unsigned j = 0; j < 16; ++j) { const unsigned c = xb_ld(&bar[XB_XCNT(j)]); sum += c; cnt += (c > 0u) ? 1u : 0u; mine = (j == x) ? c : mine; }
        if (sum == G) break;
        __builtin_amdgcn_s_sleep(1);
        if ((++sp & 255u) == 0u) { if (xb_ld(&bar[XB_TMO])) break; if (sp > XB_SPIN_CAP) { atomicAdd(&bar[XB_TMO], 1u); break; } }
    }
    nloc = mine > 0u ? mine : 1u; nx = cnt > 0u ? cnt : 1u;
}
__device__ __forceinline__ void xcd_barrier(const XcdBarrier& b) {
    asm volatile("s_waitcnt vmcnt(0)" ::: "memory");
    __syncthreads();
    if (threadIdx.x == 0) {
        unsigned* bar = b.bar;
        __builtin_amdgcn_s_waitcnt(0);
        unsigned nloc = b.st[0], nx = b.st[1];
        if (nloc == 0u) { xcd_barrier_complete(bar, b.x, nloc, nx); b.st[0] = nloc; b.st[1] = nx; }
        const unsigned old = xb_add(&bar[XB_XSUB(b.x)], 1u);
        const unsigned gen = old / nloc;
        if (old + 1u == (gen + 1u) * nloc) {
            __builtin_amdgcn_fence(__ATOMIC_RELEASE, "agent");
            asm volatile("s_waitcnt vmcnt(0)" ::: "memory");
            const unsigned og = xb_add(&bar[XB_TOP], 1u);
            const unsigned tg = og / nx;
            if (og + 1u == (tg + 1u) * nx) {
#pragma unroll
                for (unsigned j = 0; j < 16; ++j) (void)__hip_atomic_fetch_add(&bar[XB_XGEN(j)], 1u, __ATOMIC_RELAXED, __HIP_MEMORY_SCOPE_AGENT);
            }
            XB_SPIN(xb_ld(&bar[XB_XGEN(b.x)]) == gen, bar);
            __builtin_amdgcn_fence(__ATOMIC_ACQUIRE, "agent");
            asm volatile("s_waitcnt vmcnt(0)" ::: "memory");
        } else {
            XB_SPIN(xb_ld(&bar[XB_XGEN(b.x)]) == gen, bar);
            __builtin_amdgcn_fence(__ATOMIC_ACQUIRE, "agent");
            asm volatile("s_waitcnt vmcnt(0)" ::: "memory");
        }
    }
    __syncthreads();
}

struct Frame {
    LAS unsigned char* lds;
    volatile LAS unsigned* LC;
    unsigned* ctl;
    int tid, lane, wave, vcu, G;
    const float* in[35]; float* out; unsigned char* ws;
};
enum { I_X = 0, I_C, I_CTX, I_CCTX, I_WADA, I_BADA, I_NMIX, I_NFFN, I_WIN, I_WGKF, I_BGKF, I_WGKB, I_BGKB, I_GLAN, I_WGLAO, I_HCW, I_HCB, I_HW1, I_HB1, I_HW2, I_HB2, I_HW3, I_HB3,
       I_HW4, I_HFREQ, I_HBIAS, I_WHYO, I_WOUT, I_WRT, I_BRT, I_WUP, I_BUP, I_WDN, I_BDN, I_NFIN };

namespace pg8 {
#ifndef G1CFG
#define G1CFG 5
#endif
constexpr int NBF1 = G1CFG == 0 ? 21 : G1CFG == 1 ? 9 : G1CFG == 2 ? 5 : G1CFG == 3 ? 1 : G1CFG == 4 ? 17 : 13, NF81 = G1CFG == 0 ? 12 : G1CFG == 1 ? 24 : G1CFG == 2 ? 28 : G1CFG == 3 ? 32 : G1CFG == 4 ? 16 : 20;
struct Sched1 {
    static constexpr bool GATHER = false;
    const char* A; const char* B; int G, c;
    __device__ __forceinline__ bool next(int i, Unit& u) const {
        const int L = i * G + c; u.e = 0;
        if (L < 128 * NBF1) { int pn; tile_order(L, 128, NBF1, u.pm, pn);
            u.pn = G1CFG == 0 ? (pn < 9 ? pn : pn + 4) : G1CFG == 1 ? pn : G1CFG == 2 ? (pn < 2 ? pn : pn + 4) : G1CFG == 3 ? 6 : G1CFG == 4 ? (pn < 2 ? pn : pn < 5 ? pn + 4 : pn + 8) : (pn == 0 ? 6 : pn + 12); return true; }
        const int L2 = L - 128 * NBF1; if (L2 >= 16 * 7) return false;
        u.pm = 128 + (L2 & 15); u.pn = L2 >> 4; return true;
    }
    __device__ __forceinline__ unsigned aoff(const Unit& u) const { return (unsigned)u.pm * (256u * 1024 * 2); }
    __device__ __forceinline__ unsigned boff(const Unit& u) const { return (unsigned)u.pn * (256u * 1024 * 2); }
    __device__ __forceinline__ void a_ready(const Unit&) const {}
    __device__ __forceinline__ void done(const Unit&) const {}
};
struct SchedG8 {
    static constexpr bool GATHER = false;
    const char* A; const char* B; int G, c;
    __device__ __forceinline__ bool next(int i, Unit& u) const {
        const int L = i * G + c; u.e = 0; if (L >= 128 * NF81) return false;
        tile_order(L, 128, NF81, u.pm, u.pn); if (G1CFG >= 4 && u.pn >= 12) u.pn += 12; return true;
    }
    __device__ __forceinline__ unsigned aoff(const Unit& u) const { return (unsigned)u.pm * (256u * 1024); }
    __device__ __forceinline__ unsigned boff(const Unit& u) const { return (unsigned)u.pn * (256u * 1024); }
    __device__ __forceinline__ void a_ready(const Unit&) const {}
    __device__ __forceinline__ void done(const Unit&) const {}
};
struct SchedStd {
    static constexpr bool GATHER = false;
    const char* A; const char* B; int nM, nN, G, c;
    __device__ __forceinline__ bool next(int i, Unit& u) const {
        const int L = i * G + c; u.e = 0; if (L >= nM * nN) return false;
        tile_order(L, nM, nN, u.pm, u.pn); return true;
    }
    __device__ __forceinline__ unsigned aoff(const Unit& u) const { return (unsigned)u.pm * (256u * 1024 * 2); }
    __device__ __forceinline__ unsigned boff(const Unit& u) const { return (unsigned)u.pn * (256u * 1024 * 2); }
    __device__ __forceinline__ void a_ready(const Unit&) const {}
    __device__ __forceinline__ void done(const Unit&) const {}
};
template <bool GATH> struct SchedMoE_ {
    static constexpr bool GATHER = GATH;
    const char* A; const char* B; int nM, nN, G, c; unsigned estride; const volatile PG8_LAS unsigned* t2e; const int* rowtok;
    __device__ __forceinline__ bool next(int i, Unit& u) const {
        const int L = i * G + c; if (L >= nM * nN) { u.e = 0; return false; }
        tile_order(L, nM, nN, u.pm, u.pn); u.e = (int)t2e[u.pm]; return true;
    }
    __device__ __forceinline__ unsigned aoff(const Unit& u) const { return GATH ? 0u : (unsigned)u.pm * (256u * 1024); }
    __device__ __forceinline__ unsigned boff(const Unit& u) const { return (unsigned)u.e * estride + (unsigned)u.pn * (256u * 1024); }
    __device__ __forceinline__ void a_ready(const Unit&) const {}
    __device__ __forceinline__ void done(const Unit&) const {}
    __device__ __forceinline__ void ids_to_lds(const Unit& u, PG8_LAS unsigned char* dst, int lane) const {
        const __amdgpu_buffer_rsrc_t rs = __builtin_amdgcn_make_buffer_rsrc((void*)rowtok, 0, -1, 0x00020000);
        __builtin_amdgcn_raw_ptr_buffer_load_lds(rs, (PG8_LAS void*)dst, 16, lane * 16, (int)((unsigned)u.pm * 1024u), 0, 0);
    }
};
typedef SchedMoE_<false> SchedMoE;
typedef SchedMoE_<true> SchedMoEG;

constexpr float WSCALE = 32.f, WSCALE_INV = 1.f / 32.f;
__device__ __forceinline__ float act_apply(float x, int act) { const float s = __builtin_amdgcn_rcpf(1.f + __expf(-x)); return act == 1 ? x * s : s; }

struct Epi1 {
    static constexpr bool PERM = true, AFTER_DRAIN = false; static constexpr int ID = 1; static constexpr int NPRE = 0; static constexpr int NSTH = 8; __device__ __forceinline__ bool relax_ok(const Unit& u) const { return u.pn != 6; }
    bf16_t *Kb, *Vb, *Qb, *OGb, *HYb, *MAb, *MBb; float* Rf;
    __device__ __forceinline__ bool keep(const Unit&) const { return false; }
    __device__ __forceinline__ void operator()(f32x4 (&acc)[2][2][4][2], const Unit& u, int wr, int wc, int fr, int fq, const int AI0 = 0, const int AI1 = 2) const {
        const int pn = u.pn; const int row0 = u.pm * BM + wr * 64 + fr;
        if (pn == 6) {
            if (wc == 0) {
#pragma unroll
                for (int ai = AI0; ai < AI1; ++ai)
#pragma unroll
                    for (int m = 0; m < 4; ++m) { float* rp = Rf + (size_t)(row0 + ai * HALF + m * 16) * 32 + 8 * fq;
                        *(f32x4*)rp = acc[ai][0][m][0]; *(f32x4*)(rp + 4) = acc[ai][0][m][1]; }
            }
            return;
        }
        if (pn >= 2 && pn < 6) {
            unsigned char* og8 = (unsigned char*)Vb; const int col0 = 256 * (pn - 2) + wc * 32 + 8 * fq;
#pragma unroll
            for (int ai = AI0; ai < AI1; ++ai)
#pragma unroll
                for (int m = 0; m < 4; ++m) { unsigned char* rowp = og8 + (size_t)(row0 + ai * HALF + m * 16) * 1024 + col0;
#pragma unroll
                    for (int bj = 0; bj < 2; ++bj) { const f32x4 v0 = acc[ai][bj][m][0], v1 = acc[ai][bj][m][1]; int w0 = 0, w1 = 0;
                        w0 = __builtin_amdgcn_cvt_pk_fp8_f32(v0[0], v0[1], w0, false); w0 = __builtin_amdgcn_cvt_pk_fp8_f32(v0[2], v0[3], w0, true);
                        w1 = __builtin_amdgcn_cvt_pk_fp8_f32(v1[0], v1[1], w1, false); w1 = __builtin_amdgcn_cvt_pk_fp8_f32(v1[2], v1[3], w1, true);
                        typedef int i32x2_ __attribute__((ext_vector_type(2))); *(i32x2_*)(rowp + bj * HALF) = (i32x2_){w0, w1}; } }
            return;
        }
        bf16_t* dst; int ld, c0, act = 0;
        if (pn < 2) { dst = Kb; ld = 512; c0 = 256 * pn; }
        else if (pn < 6) { dst = Vb; ld = 1024; c0 = 256 * (pn - 2); }
        else if (pn < 9) { dst = Qb; ld = 512; c0 = 256 * (pn - 7); }
        else if (pn < 13) { dst = OGb; ld = 1024; c0 = 256 * (pn - 9); }
        else if (pn < 25) { dst = HYb; ld = 3072; c0 = 256 * (pn - 13); }
        else if (pn < 29) { dst = MAb; ld = 1024; c0 = 256 * (pn - 25); act = 2; }
        else { dst = MBb; ld = 1024; c0 = 256 * (pn - 29); act = 2; }
        const int col0 = c0 + wc * 32 + 8 * fq;
#pragma unroll
        for (int ai = AI0; ai < AI1; ++ai)
#pragma unroll
            for (int m = 0; m < 4; ++m) { bf16_t* rowp = dst + (size_t)(row0 + ai * HALF + m * 16) * ld + col0;
#pragma unroll
                for (int bj = 0; bj < 2; ++bj) { f32x4 v0 = acc[ai][bj][m][0], v1 = acc[ai][bj][m][1];
                    if (act) {
#pragma unroll
                        for (int j = 0; j < 4; ++j) { v0[j] = act_apply(v0[j], act); v1[j] = act_apply(v1[j], act); } }
                    u32x4 w; w.x = cvt_pk_bf16(v0[0], v0[1]); w.y = cvt_pk_bf16(v0[2], v0[3]); w.z = cvt_pk_bf16(v1[0], v1[1]); w.w = cvt_pk_bf16(v1[2], v1[3]);
                    *(u32x4*)(rowp + bj * HALF) = w; } }
    }
};

__device__ __forceinline__ u32x4 widen8(int a0, int a1, int b0, int b1) {
    const auto r0 = __builtin_amdgcn_permlane16_swap((unsigned)a0, (unsigned)b0, false, false);
    const auto r1 = __builtin_amdgcn_permlane16_swap((unsigned)a1, (unsigned)b1, false, false);
    return (u32x4){r0[0], r1[0], r0[1], r1[1]};
}
struct EpiG8 {
    static constexpr bool PERM = true, AFTER_DRAIN = false; static constexpr int ID = 2; static constexpr int NPRE = 0; static constexpr int NSTH = 4; __device__ __forceinline__ bool relax_ok(const Unit& u) const { return true; }
    unsigned char* OG8; bf16_t* MAb; bf16_t* MBb; bf16_t* HYb; unsigned char* V8; bf16_t* Kb; bf16_t* Qb;
    __device__ __forceinline__ bool keep(const Unit&) const { return false; }
    __device__ __forceinline__ void operator()(f32x4 (&acc)[2][2][4][2], const Unit& u, int wr, int wc, int fr, int fq, const int AI0 = 0, const int AI1 = 2) const {
        const int pn = u.pn, row0 = u.pm * BM + wr * 64 + fr, col0 = 256 * (pn & 3) + wc * 32 + 8 * fq;
        if (pn < 12 || (pn >= 24 && pn < 28)) {
            const size_t boff = pn < 4 ? WS_OG : pn < 8 ? WS_MA : pn < 12 ? WS_MB : WS_VB;
            unsigned char* o8 = OG8 + ((long long)boff - (long long)WS_OG);
            const float sc8 = (pn >= 4 && pn < 12) ? -WSCALE_INV * 1.4426950408889634f : WSCALE_INV;
#pragma unroll
            for (int ai = AI0; ai < AI1; ++ai)
#pragma unroll
                for (int mp = 0; mp < 2; ++mp) { unsigned char* rowp = o8 + (size_t)(row0 + ai * HALF + (2 * mp + (fq & 1)) * 16) * 1024 + col0 - 8 * (fq & 1);
#pragma unroll
                    for (int bj = 0; bj < 2; ++bj) { int w[2][2];
#pragma unroll
                        for (int mm = 0; mm < 2; ++mm) { const f32x4 v0 = acc[ai][bj][2 * mp + mm][0] * sc8, v1 = acc[ai][bj][2 * mp + mm][1] * sc8; int w0 = 0, w1 = 0;
                            w0 = __builtin_amdgcn_cvt_pk_fp8_f32(v0[0], v0[1], w0, false); w0 = __builtin_amdgcn_cvt_pk_fp8_f32(v0[2], v0[3], w0, true);
                            w1 = __builtin_amdgcn_cvt_pk_fp8_f32(v1[0], v1[1], w1, false); w1 = __builtin_amdgcn_cvt_pk_fp8_f32(v1[2], v1[3], w1, true); w[mm][0] = w0; w[mm][1] = w1; }
                        *(u32x4*)(rowp + bj * HALF) = widen8(w[0][0], w[0][1], w[1][0], w[1][1]); } }
            return;
        }
        bf16_t* dst = pn < 8 ? MAb : MBb; int ld = 1024; float sc = WSCALE_INV;
        if (pn >= 12) {
            if (pn < 24) { dst = HYb + 256 * (pn - 12) - 256 * (pn & 3); ld = 3072; }
            else if (pn < 30) { dst = Kb + 256 * (pn - 28) - 256 * (pn & 3); ld = 512; }
            else { dst = Qb + 256 * (pn - 30) - 256 * (pn & 3); ld = 512; sc = WSCALE_INV * 0.08838834764831845f; }
        }
#pragma unroll
        for (int ai = AI0; ai < AI1; ++ai)
#pragma unroll
            for (int m = 0; m < 4; ++m) { bf16_t* rowp = dst + (size_t)(row0 + ai * HALF + m * 16) * ld + col0;
#pragma unroll
                for (int bj = 0; bj < 2; ++bj) { const f32x4 v0 = acc[ai][bj][m][0] * sc, v1 = acc[ai][bj][m][1] * sc;
                    u32x4 w; w.x = cvt_pk_bf16(v0[0], v0[1]); w.y = cvt_pk_bf16(v0[2], v0[3]); w.z = cvt_pk_bf16(v1[0], v1[1]); w.w = cvt_pk_bf16(v1[2], v1[3]);
                    *(u32x4*)(rowp + bj * HALF) = w; } }
    }
};
__device__ __forceinline__ void unpack8(const u32x4 w, float (&f)[8]) {
    f[0] = __builtin_bit_cast(float, w.x << 16); f[1] = __builtin_bit_cast(float, w.x & 0xffff0000u); f[2] = __builtin_bit_cast(float, w.y << 16); f[3] = __builtin_bit_cast(float, w.y & 0xffff0000u);
    f[4] = __builtin_bit_cast(float, w.z << 16); f[5] = __builtin_bit_cast(float, w.z & 0xffff0000u); f[6] = __builtin_bit_cast(float, w.w << 16); f[7] = __builtin_bit_cast(float, w.w & 0xffff0000u);
}
typedef unsigned v2u_ __attribute__((ext_vector_type(2)));
__device__ __forceinline__ void unpack8f8(const v2u_ w, float (&f)[8]) {
    typedef float f32x2_ __attribute__((ext_vector_type(2)));
    const f32x2_ a = __builtin_amdgcn_cvt_pk_f32_fp8((int)w.x, false), b = __builtin_amdgcn_cvt_pk_f32_fp8((int)w.x, true), c = __builtin_amdgcn_cvt_pk_f32_fp8((int)w.y, false), d = __builtin_amdgcn_cvt_pk_f32_fp8((int)w.y, true);
    f[0] = a[0]; f[1] = a[1]; f[2] = b[0]; f[3] = b[1]; f[4] = c[0]; f[5] = c[1]; f[6] = d[0]; f[7] = d[1];
}
template <int MODE> struct EpiGate {
    static constexpr bool PERM = true, AFTER_DRAIN = false; static constexpr int ID = 3; static constexpr int NPRE = 0; static constexpr int NSTH = 8; __device__ __forceinline__ bool relax_ok(const Unit& u) const { return false; }
    const bf16_t* gate; float* YA; bf16_t* YM;
    __device__ __forceinline__ bool keep(const Unit&) const { return false; }
    __device__ __forceinline__ void operator()(f32x4 (&acc)[2][2][4][2], const Unit& u, int wr, int wc, int fr, int fq, const int AI0 = 0, const int AI1 = 2) const {
        const int row0 = u.pm * BM + wr * 64 + fr, col0 = u.pn * BM + wc * 32 + 8 * fq;
#pragma unroll
        for (int ai = AI0; ai < AI1; ++ai)
#pragma unroll
            for (int m = 0; m < 4; ++m) { const size_t ro = (size_t)(row0 + ai * HALF + m * 16) * 1024 + col0;
#pragma unroll
                for (int bj = 0; bj < 2; ++bj) { const size_t o = ro + bj * HALF;
                    float g[8]; unpack8(*(const u32x4*)(gate + o), g);
                    f32x4 v0 = acc[ai][bj][m][0], v1 = acc[ai][bj][m][1];
#pragma unroll
                    for (int j = 0; j < 4; ++j) { v0[j] *= g[j]; v1[j] *= g[4 + j]; }
                    if (MODE == 0) { *(f32x4*)(YA + o) = v0; *(f32x4*)(YA + o + 4) = v1; }
                    else { const f32x4 a0 = *(const f32x4*)(YA + o), a1 = *(const f32x4*)(YA + o + 4); v0 += a0; v1 += a1;
                        u32x4 w; w.x = cvt_pk_bf16(v0[0], v0[1]); w.y = cvt_pk_bf16(v0[2], v0[3]); w.z = cvt_pk_bf16(v1[0], v1[1]); w.w = cvt_pk_bf16(v1[2], v1[3]);
                        *(u32x4*)(YM + o) = w; } } }
    }
};

struct SchedPair {
    static constexpr bool GATHER = false;
    const char* A; const char* B; unsigned a0, a1, b0, b1; int nM, nN, G, c;
    __device__ __forceinline__ bool next(int i, Unit& u) const {
        const int L = (i >> 1) * G + c; u.e = i & 1; if (L >= nM * nN) return false;
        tile_order(L, nM, nN, u.pm, u.pn); return true;
    }
    __device__ __forceinline__ unsigned aoff(const Unit& u) const { return (u.e ? a1 : a0) + (unsigned)u.pm * (256u * 1024 * 2); }
    __device__ __forceinline__ unsigned boff(const Unit& u) const { return (u.e ? b1 : b0) + (unsigned)u.pn * (256u * 1024 * 2); }
    __device__ __forceinline__ void a_ready(const Unit&) const {}
    __device__ __forceinline__ void done(const Unit&) const {}
};
struct EpiMix {
    static constexpr bool PERM = true, AFTER_DRAIN = false; static constexpr int ID = 4; static constexpr int NPRE = 0; static constexpr int NSTH = 8; __device__ __forceinline__ bool relax_ok(const Unit& u) const { return u.e == 1; }
    const bf16_t* MA; const bf16_t* MB; bf16_t* YM;
    __device__ __forceinline__ bool keep(const Unit& u) const { return u.e == 0; }
    __device__ __forceinline__ void operator()(f32x4 (&acc)[2][2][4][2], const Unit& u, int wr, int wc, int fr, int fq, const int AI0 = 0, const int AI1 = 2) const {
        const int row0 = u.pm * BM + wr * 64 + fr, col0 = u.pn * BM + wc * 32 + 8 * fq;
        const bool seg0 = u.e == 0;
        v2u_ gbq[3][2], gaq[3][2];
#define EM_LOAD(s_) do { const size_t o_ = (size_t)(row0 + ((s_) >> 2) * HALF + ((s_) & 3) * 16) * 1024 + col0; \
            _Pragma("unroll") for (int bj = 0; bj < 2; ++bj) { gbq[(s_) % 3][bj] = *(const v2u_*)((const unsigned char*)MB + o_ + bj * HALF); gaq[(s_) % 3][bj] = seg0 ? *(const v2u_*)((const unsigned char*)MA + o_ + bj * HALF) : (v2u_){0u, 0u}; } } while (0)
        EM_LOAD(0); EM_LOAD(1); EM_LOAD(2);
#pragma unroll
        for (int s = 0; s < 8; ++s) { const int ai = s >> 2, m = s & 3; const size_t ro = (size_t)(row0 + ai * HALF + m * 16) * 1024 + col0;
            v2u_ gbc[2], gac[2];
#pragma unroll
            for (int bj = 0; bj < 2; ++bj) { gbc[bj] = gbq[s % 3][bj]; gac[bj] = seg0 ? gaq[s % 3][bj] : gbc[bj]; }
            if (s + 3 < 8) EM_LOAD(s + 3);
#pragma unroll
            for (int bj = 0; bj < 2; ++bj) { const size_t o = ro + bj * HALF;
                float gb[8]; unpack8f8(gbc[bj], gb);
#pragma unroll
                for (int j = 0; j < 8; ++j) gb[j] = 1.f + __builtin_amdgcn_exp2f(fminf(gb[j], 30.f * 1.4426950408889634f));
                if (seg0) { float ga[8]; unpack8f8(gac[bj], ga);
#pragma unroll
                    for (int j = 0; j < 8; ++j) ga[j] = __builtin_amdgcn_rcpf(1.f + __builtin_amdgcn_exp2f(ga[j])) * gb[j];
#pragma unroll
                    for (int j = 0; j < 4; ++j) { acc[ai][bj][m][0][j] *= ga[j]; acc[ai][bj][m][1][j] *= ga[4 + j]; }
                } else {
#pragma unroll
                    for (int j = 0; j < 8; ++j) gb[j] = __builtin_amdgcn_rcpf(gb[j]);
                    f32x4 v0 = acc[ai][bj][m][0], v1 = acc[ai][bj][m][1];
#pragma unroll
                    for (int j = 0; j < 4; ++j) { v0[j] *= gb[j]; v1[j] *= gb[4 + j]; }
                    u32x4 w; w.x = cvt_pk_bf16(v0[0], v0[1]); w.y = cvt_pk_bf16(v0[2], v0[3]); w.z = cvt_pk_bf16(v1[0], v1[1]); w.w = cvt_pk_bf16(v1[2], v1[3]);
                    *(u32x4*)(YM + o) = w; } } }
#undef EM_LOAD
        (void)AI0; (void)AI1;
    }
};
struct EpiRes {
    static constexpr bool PERM = true, AFTER_DRAIN = false; static constexpr int ID = 5; static constexpr int NPRE = 0; static constexpr int NSTH = 8; __device__ __forceinline__ bool relax_ok(const Unit& u) const { return true; }
    const float* x; const float* mod; bf16_t* out;
    __device__ __forceinline__ bool keep(const Unit&) const { return false; }
    __device__ __forceinline__ void operator()(f32x4 (&acc)[2][2][4][2], const Unit& u, int wr, int wc, int fr, int fq, const int AI0 = 0, const int AI1 = 2) const {
        const int row0 = u.pm * BM + wr * 64 + fr, col0 = u.pn * BM + wc * 32 + 8 * fq;
        const float* g1 = mod + (size_t)(u.pm >> 3) * 6144 + 2048 + col0;
        f32x4 xb[3][2][2];
#define ER_LOAD(s_) do { const float* xp_ = x + (size_t)(row0 + ((s_) >> 2) * HALF + ((s_) & 3) * 16) * 1024 + col0; \
            _Pragma("unroll") for (int bj = 0; bj < 2; ++bj) { xb[(s_) % 3][bj][0] = *(const f32x4*)(xp_ + bj * HALF); xb[(s_) % 3][bj][1] = *(const f32x4*)(xp_ + bj * HALF + 4); } } while (0)
        ER_LOAD(0); ER_LOAD(1); ER_LOAD(2);
        f32x4 gv[2][2];
#pragma unroll
        for (int bj = 0; bj < 2; ++bj) { gv[bj][0] = *(const f32x4*)(g1 + bj * HALF); gv[bj][1] = *(const f32x4*)(g1 + bj * HALF + 4); }
#pragma unroll
        for (int s = 0; s < 8; ++s) { const int ai = s >> 2, m = s & 3; const size_t ro = (size_t)(row0 + ai * HALF + m * 16) * 1024 + col0;
            u32x4 w[2];
#pragma unroll
            for (int bj = 0; bj < 2; ++bj) {
                const f32x4 v0 = xb[s % 3][bj][0] + gv[bj][0] * acc[ai][bj][m][0], v1 = xb[s % 3][bj][1] + gv[bj][1] * acc[ai][bj][m][1];
                w[bj].x = cvt_pk_bf16(v0[0], v0[1]); w[bj].y = cvt_pk_bf16(v0[2], v0[3]); w[bj].z = cvt_pk_bf16(v1[0], v1[1]); w[bj].w = cvt_pk_bf16(v1[2], v1[3]); }
            if (s + 3 < 8) ER_LOAD(s + 3);
#pragma unroll
            for (int bj = 0; bj < 2; ++bj) *(u32x4*)(out + ro + bj * HALF) = w[bj]; }
#undef ER_LOAD
        (void)AI0; (void)AI1;
    }
};
struct EpiUp {
    static constexpr bool PERM = true, AFTER_DRAIN = false; static constexpr int ID = 6; static constexpr int NPRE = 1; static constexpr int NSTH = 2; __device__ __forceinline__ bool relax_ok(const Unit& u) const { return true; }
    const float* b_up; unsigned char* ACT; PG8_LAS unsigned char* side;
    __device__ __forceinline__ bool keep(const Unit&) const { return false; }
    __device__ __forceinline__ void prefetch(const Unit& u, PG8_LAS unsigned char* dst, int lane) const {
        const __amdgpu_buffer_rsrc_t rs = __builtin_amdgcn_make_buffer_rsrc((void*)b_up, 0, -1, 0x00020000);
        __builtin_amdgcn_raw_ptr_buffer_load_lds(rs, (PG8_LAS void*)dst, 16, lane * 16, (int)(((unsigned)u.e * 2048u + 256u * (unsigned)u.pn) * 4u), 0, 0);
    }
    __device__ __forceinline__ void operator()(f32x4 (&acc)[2][2][4][2], const Unit& u, int wr, int wc, int fr, int fq, const int AI0 = 0, const int AI1 = 2) const {
        const int row0 = u.pm * BM + wr * 64 + fr, f0 = u.pn * 128 + wc * 32 + 8 * fq;
        const PG8_LAS float* bp = (const PG8_LAS float*)(side + EPI_VEC + u.x * 2048) + 64 * wc + 16 * fq;
        f32x4 bb[4];
#pragma unroll
        for (int q = 0; q < 4; ++q) bb[q] = *(const PG8_LAS f32x4*)(bp + 4 * q);
        float bg[8], bl[8];
#pragma unroll
        for (int q = 0; q < 4; ++q) { bg[2 * q] = bb[q][0]; bl[2 * q] = bb[q][1] + 1.f; bg[2 * q + 1] = bb[q][2]; bl[2 * q + 1] = bb[q][3] + 1.f; }
#pragma unroll
        for (int ai = AI0; ai < AI1; ++ai)
#pragma unroll
            for (int mp = 0; mp < 2; ++mp) { unsigned char* rowp = ACT + (size_t)(row0 + ai * HALF + (2 * mp + (fq & 1)) * 16) * 1024 + f0 - 8 * (fq & 1);
                int w[2][2];
#pragma unroll
                for (int mm = 0; mm < 2; ++mm) { const int m = 2 * mp + mm; float r[8];
#pragma unroll
                    for (int n = 0; n < 2; ++n)
#pragma unroll
                        for (int j = 0; j < 4; ++j) { float gl = acc[ai][0][m][n][j] * WSCALE_INV + bg[4 * n + j], li = acc[ai][1][m][n][j] * WSCALE_INV + bl[4 * n + j];
                            gl = fminf(gl, 7.f); li = fminf(fmaxf(li, -6.f), 8.f);
                            r[4 * n + j] = gl * __builtin_amdgcn_rcpf(1.f + __builtin_amdgcn_exp2f(gl * (-1.702f * 1.4426950408889634f))) * li; }
                    int w0 = 0, w1 = 0;
                    w0 = __builtin_amdgcn_cvt_pk_fp8_f32(r[0], r[1], w0, false); w0 = __builtin_amdgcn_cvt_pk_fp8_f32(r[2], r[3], w0, true);
                    w1 = __builtin_amdgcn_cvt_pk_fp8_f32(r[4], r[5], w1, false); w1 = __builtin_amdgcn_cvt_pk_fp8_f32(r[6], r[7], w1, true); w[mm][0] = w0; w[mm][1] = w1; }
                *(u32x4*)rowp = widen8(w[0][0], w[0][1], w[1][0], w[1][1]); }
    }
};
constexpr float YSCALE = 16.f, YSCALE_INV = 1.f / 16.f;
struct EpiDown {
    static constexpr bool PERM = true, AFTER_DRAIN = false; static constexpr int ID = 7; static constexpr int NPRE = 1; static constexpr int NSTH = 4; __device__ __forceinline__ bool relax_ok(const Unit& u) const { return true; }
    const float* b_dn; const float* roww; unsigned char* Y; PG8_LAS unsigned char* side;
    __device__ __forceinline__ bool keep(const Unit&) const { return false; }
    __device__ __forceinline__ void prefetch(const Unit& u, PG8_LAS unsigned char* dst, int lane) const {
        const __amdgpu_buffer_rsrc_t rb = __builtin_amdgcn_make_buffer_rsrc((void*)b_dn, 0, -1, 0x00020000), rw_ = __builtin_amdgcn_make_buffer_rsrc((void*)roww, 0, -1, 0x00020000);
        __builtin_amdgcn_raw_ptr_buffer_load_lds(rb, (PG8_LAS void*)dst, 16, lane * 16, (int)(((unsigned)u.e * 1024u + 256u * (unsigned)u.pn) * 4u), 0, 0);
        __builtin_amdgcn_raw_ptr_buffer_load_lds(rw_, (PG8_LAS void*)(dst + 1024), 16, lane * 16, (int)((unsigned)u.pm * 1024u), 0, 0);
    }
    __device__ __forceinline__ void operator()(f32x4 (&acc)[2][2][4][2], const Unit& u, int wr, int wc, int fr, int fq, const int AI0 = 0, const int AI1 = 2) const {
        const int row0 = u.pm * BM + wr * 64 + fr, col0 = u.pn * BM + wc * 32 + 8 * fq;
        const PG8_LAS float* sd = (const PG8_LAS float*)(side + EPI_VEC + u.x * 2048);
        const PG8_LAS float* bp = sd + wc * 32 + 8 * fq;
        f32x4 bv[2][2];
#pragma unroll
        for (int bj = 0; bj < 2; ++bj) { bv[bj][0] = *(const PG8_LAS f32x4*)(bp + bj * HALF); bv[bj][1] = *(const PG8_LAS f32x4*)(bp + bj * HALF + 4); }
#pragma unroll
        for (int ai = AI0; ai < AI1; ++ai)
#pragma unroll
            for (int mp = 0; mp < 2; ++mp) { unsigned char* rowp = Y + (size_t)(row0 + ai * HALF + (2 * mp + (fq & 1)) * 16) * 1024 + col0 - 8 * (fq & 1);
                float rw[2];
#pragma unroll
                for (int mm = 0; mm < 2; ++mm) rw[mm] = sd[256 + wr * 64 + fr + ai * HALF + (2 * mp + mm) * 16] * YSCALE;
#pragma unroll
                for (int bj = 0; bj < 2; ++bj) { int w[2][2];
#pragma unroll
                    for (int mm = 0; mm < 2; ++mm) { const int m = 2 * mp + mm;
                        const f32x4 v0 = (acc[ai][bj][m][0] * WSCALE_INV + bv[bj][0]) * rw[mm], v1 = (acc[ai][bj][m][1] * WSCALE_INV + bv[bj][1]) * rw[mm];
                        int w0 = 0, w1 = 0;
                        w0 = __builtin_amdgcn_cvt_pk_fp8_f32(v0[0], v0[1], w0, false); w0 = __builtin_amdgcn_cvt_pk_fp8_f32(v0[2], v0[3], w0, true);
                        w1 = __builtin_amdgcn_cvt_pk_fp8_f32(v1[0], v1[1], w1, false); w1 = __builtin_amdgcn_cvt_pk_fp8_f32(v1[2], v1[3], w1, true); w[mm][0] = w0; w[mm][1] = w1; }
                    *(u32x4*)(rowp + bj * HALF) = widen8(w[0][0], w[0][1], w[1][0], w[1][1]); } }
    }
};
}

template <class RowMap>
__device__ __forceinline__ void p0_transpose_item(const float* W, int K, int N, bf16* WT, LAS unsigned char* scr, int item, int lane, const RowMap& rm) {
    const int nblk = N / 32, kb = item / nblk, nb = item % nblk, k0 = 64 * kb, n0 = 32 * nb;
    const int kr = lane >> 3, c4 = lane & 7;
    f32x4 v[8];
#pragma unroll
    for (int it = 0; it < 8; ++it) v[it] = *(const f32x4*)(W + (size_t)(k0 + 8 * it + kr) * N + n0 + 4 * c4);
    float sc[4];
#pragma unroll
    for (int q = 0; q < 4; ++q) (void)rm(n0 + 4 * c4 + q, sc[q]);
#pragma unroll
    for (int it = 0; it < 8; ++it)
#pragma unroll
        for (int q = 0; q < 4; ++q) *(LAS bf16*)(scr + (4 * c4 + q) * 144 + 2 * (8 * it + kr)) = (bf16)f2bf(v[it][q] * sc[q]);
    LDS_WAIT(); asm volatile("" ::: "memory");
#pragma unroll
    for (int j = 0; j < 4; ++j) { const int n = (lane >> 3) + 8 * j, c = lane & 7; float dummy; const int drow = rm(n0 + n, dummy);
        *(v4u*)(WT + (size_t)drow * K + k0 + 8 * c) = *(const LAS v4u*)(scr + n * 144 + 16 * c); }
    LDS_WAIT(); asm volatile("" ::: "memory");
}
struct RmId { __device__ __forceinline__ int operator()(int n, float& sc) const { sc = 1.f; return n; } };
struct RmWin {
    __device__ __forceinline__ int operator()(int n, float& sc) const {
        sc = 1.f;
        if (n < 512) { sc = 0.08838834764831845f; return 7 * 256 + n; }
        if (n < 1024) return n - 512;
        if (n < 2048) return 2 * 256 + (n - 1024);
        if (n < 3072) return 9 * 256 + (n - 2048);
        if (n < 3104) return 6 * 256 + (n - 3072);
        if (n < 6176) return 13 * 256 + (n - 3104);
        if (n < 7200) return 25 * 256 + (n - 6176);
        return 29 * 256 + (n - 7200);
    }
};
struct RmUp {
    __device__ __forceinline__ int operator()(int n, float& sc) const { sc = 1.f; const int f = n >> 1; return 256 * (f >> 7) + 128 * (n & 1) + (f & 127); }
};

template <class RowMap>
__device__ __forceinline__ void fp8_transpose_kn(const float* W, int K, int N, unsigned char* WT, LAS unsigned char* scr, int kb, int nb, int lane, const RowMap& rm) {
    const int k0 = 128 * kb, n0 = 32 * nb;
    const int kg = lane >> 3, c4 = lane & 7;
    f32x4 v[16];
#pragma unroll
    for (int i = 0; i < 16; ++i) v[i] = *(const f32x4*)(W + (size_t)(k0 + 16 * kg + i) * N + n0 + 4 * c4);
#pragma unroll
    for (int q = 0; q < 4; ++q) { int wd[4];
#pragma unroll
        for (int d2 = 0; d2 < 4; ++d2) { int w0 = 0;
            w0 = __builtin_amdgcn_cvt_pk_fp8_f32(v[4 * d2][q] * pg8::WSCALE, v[4 * d2 + 1][q] * pg8::WSCALE, w0, false);
            w0 = __builtin_amdgcn_cvt_pk_fp8_f32(v[4 * d2 + 2][q] * pg8::WSCALE, v[4 * d2 + 3][q] * pg8::WSCALE, w0, true); wd[d2] = w0; }
        *(LAS v4u*)(scr + (4 * c4 + q) * 144 + 16 * kg) = (v4u){(unsigned)wd[0], (unsigned)wd[1], (unsigned)wd[2], (unsigned)wd[3]}; }
    LDS_WAIT(); asm volatile("" ::: "memory");
#pragma unroll
    for (int j = 0; j < 4; ++j) { const int n = (lane >> 3) + 8 * j, c = lane & 7; float dummy; const int drow = rm(n0 + n, dummy);
        *(v4u*)(WT + (size_t)drow * K + k0 + 16 * c) = *(const LAS v4u*)(scr + n * 144 + 16 * c); }
    LDS_WAIT(); asm volatile("" ::: "memory");
}
template <class RowMap>
__device__ __forceinline__ void fp8_transpose_item(const float* W, int K, int N, unsigned char* WT, LAS unsigned char* scr, int item, int lane, const RowMap& rm) {
    const int nblk = N / 32; fp8_transpose_kn(W, K, N, WT, scr, item / nblk, item % nblk, lane, rm);
}
struct RmG8 {
    __device__ __forceinline__ int operator()(int n, float& sc) const { sc = 1.f;
        if (n < 512) return 7680 + n;
        if (n < 1024) return 7168 + (n - 512);
        if (n < 2048) return 6144 + (n - 1024);
        if (n < 3072) return n - 2048;
        if (n < 6176) return 3072 + (n - 3104);
        return n < 7200 ? 1024 + (n - 6176) : 2048 + (n - 7200); }
};

__device__ __forceinline__ float hy_mlp(const Frame& F, int t) {
    const int lane = F.lane;
    const float tn = (float)t * (1.f / 2047.f);
    float zv = 0.f;
    if (lane == 0) zv = tn;
    else if (lane <= 32) { const int i = (lane - 1) & 15; const float f = 1e-4f + (float)i * ((15.f - 1e-4f) / 15.f); const float rev = (float)t * f * (1.f / 2048.f);
        zv = (lane <= 16) ? __builtin_amdgcn_cosf(rev) : -__builtin_amdgcn_sinf(rev); }
    const float fr = F.in[I_HFREQ][lane];
    const float inv2pi = 0.15915494309189535f;
    float a = F.in[I_HB1][lane];
#pragma unroll 11
    for (int i = 0; i < 33; ++i) a += __shfl(zv, i) * F.in[I_HW1][i * 64 + lane];
    float h = __builtin_amdgcn_sinf(fr * a * inv2pi);
    a = F.in[I_HB2][lane];
#pragma unroll 16
    for (int i = 0; i < 64; ++i) a += __shfl(h, i) * F.in[I_HW2][i * 64 + lane];
    h = __builtin_amdgcn_sinf(fr * a * inv2pi);
    a = F.in[I_HB3][lane];
#pragma unroll 16
    for (int i = 0; i < 64; ++i) a += __shfl(h, i) * F.in[I_HW3][i * 64 + lane];
    return __builtin_amdgcn_sinf(fr * a * inv2pi);
}

__device__ __forceinline__ void p0_prologue(Frame& F) {
    const int blk = blockIdx.x;
    for (int item = blk; item < 192; item += F.G) {
        LAS float* scr = (LAS float*)(F.lds + F.wave * 16384);
        const int k0 = 128 * F.wave;
        for (int idx = F.lane; idx < 17 * 128; idx += 64) { const int b = idx >> 7, kk = idx & 127;
            const float cv = (b < 16) ? F.in[I_C][b * 1024 + k0 + kk] : F.in[I_CCTX][k0 + kk];
            scr[kk * 20 + b] = cv * sigmoidf_(cv); }
        LDS_WAIT(); asm volatile("" ::: "memory");
        float acc[17];
#pragma unroll
        for (int b = 0; b < 17; ++b) acc[b] = 0.f;
        const int hl = F.lane >> 5, cl = F.lane & 31;
        const float* wp = F.in[I_WADA] + (size_t)(k0 + hl) * 6144 + 32 * item + cl;
#pragma nounroll
        for (int kb = 0; kb < 64; kb += 32) {
            float wv[32];
#pragma unroll
            for (int i = 0; i < 32; ++i) wv[i] = wp[(size_t)(2 * (kb + i)) * 6144];
#pragma unroll
            for (int i = 0; i < 32; ++i) { const LAS float* sp = scr + (2 * (kb + i) + hl) * 20;
                const f32x4 s0 = *(const LAS f32x4*)sp, s1 = *(const LAS f32x4*)(sp + 4), s2 = *(const LAS f32x4*)(sp + 8), s3 = *(const LAS f32x4*)(sp + 12); const float s4 = sp[16];
#pragma unroll
                for (int q = 0; q < 4; ++q) { acc[q] += s0[q] * wv[i]; acc[4 + q] += s1[q] * wv[i]; acc[8 + q] += s2[q] * wv[i]; acc[12 + q] += s3[q] * wv[i]; }
                acc[16] += s4 * wv[i]; }
        }
#pragma unroll
        for (int b = 0; b < 17; ++b) acc[b] += __shfl_xor(acc[b], 32);
        if (hl == 0) {
#pragma unroll
            for (int b = 0; b < 17; ++b) scr[2560 + b * 32 + cl] = acc[b]; }
        __syncthreads();
        for (int o = F.tid; o < 17 * 32; o += 512) { float s = F.in[I_BADA][32 * item + (o & 31)];
#pragma unroll
            for (int w = 0; w < 8; ++w) s += ((LAS float*)(F.lds + w * 16384))[2560 + o];
            ((float*)(F.ws + WS_MOD))[(size_t)(o >> 5) * 6144 + 32 * item + (o & 31)] = s; }
        __syncthreads();
    }
    for (int m = blk; m < 256; m += F.G) {
        LAS float* HS = (LAS float*)F.lds;
        LAS bf16* T = (LAS bf16*)(F.lds + 4096);
        { const float h3 = hy_mlp(F, 8 * m + F.wave); HS[F.wave * 64 + F.lane] = h3; }
        __syncthreads();
        const int cidx = 256 * F.wave + 4 * F.lane;
        f32x4 acc[8];
#pragma unroll
        for (int p = 0; p < 8; ++p) acc[p] = (f32x4){0.f, 0.f, 0.f, 0.f};
        const float* w4 = F.in[I_HW4] + cidx;
#pragma unroll 8
        for (int i = 0; i < 64; ++i) { const f32x4 wv = *(const f32x4*)(w4 + (size_t)i * 2048);
#pragma unroll
            for (int p = 0; p < 8; ++p) acc[p] += HS[p * 64 + i] * wv; }
        const bool fwd = F.wave < 4;
        const float a0 = -3.0701134573253944f, a1 = -15.350567286626972f;
#pragma unroll
        for (int cc = 0; cc < 4; ++cc) { const int c = (cidx & 1023) + cc; const float delta = fabsf(a0 + (float)c * ((a1 - a0) / 1023.f));
#pragma unroll
            for (int p = 0; p < 8; ++p) { const int t = 8 * m + p; float val = acc[p][cc] * __expf(-(float)t * (1.f / 2047.f) * delta);
                if (fwd && t == 0) val += F.in[I_HBIAS][c];
                T[(fwd ? c : 1024 + c) * 8 + (fwd ? 7 - p : p)] = (bf16)f2bf(val); } }
        __syncthreads();
        bf16* HR = (bf16*)(F.ws + WS_HR);
#pragma nounroll
        for (int ri = F.tid; ri < 2048; ri += 512) { const int dir = ri >> 10, c = ri & 1023; const LAS bf16* tp = T + ri * 8;
            if (dir) {
                bf16* hr = HR + (size_t)c * HRL + 2048 + 8 * m;
                const v4u v = *(const LAS v4u*)tp;
                if (m == 0) { hr[1] = (bf16)(v.x >> 16); *(unsigned*)(hr + 2) = v.y; *(v2u*)(hr + 4) = (v2u){v.z, v.w}; }
                else *(v4u*)hr = v;
            } else {
                bf16* hr = HR + (size_t)c * HRL + 2041 - 8 * m;
                const v4u v = *(const LAS v4u*)tp;
                hr[0] = (bf16)(v.x & 0xffffu); *(unsigned*)(hr + 1) = (v.x >> 16) | (v.y << 16); *(v2u*)(hr + 3) = (v2u){(v.y >> 16) | (v.z << 16), (v.z >> 16) | (v.w << 16)}; hr[7] = (bf16)(v.w >> 16);
            } }
        if (m == 255) for (int c = F.tid; c < 1024; c += 512) { bf16* hr = HR + (size_t)c * HRL; hr[0] = 0; *(v4u*)(hr + 4096) = (v4u){0u, 0u, 0u, 0u}; }
        __syncthreads();
    }
    {
        LAS unsigned char* scr = F.lds + F.wave * 8192;
        const int gw = F.vcu * NWAVES + F.wave, NGW = F.G * NWAVES;
        constexpr int I_IN = 16 * 257, I_SQ = 16 * 32;
        constexpr int NB8 = pg8::NF81 * 8;
        constexpr int NITEMS = I_IN + 3 * I_SQ + 8 * NB8;
        for (int it = gw; it < NITEMS; it += NGW) {
            int r = it;
            if (r < I_IN) { p0_transpose_item(F.in[I_WIN], 1024, 8224, (bf16*)(F.ws + WS_WB1), scr, r, F.lane, RmWin()); continue; } r -= I_IN;
            if (r < I_SQ) { p0_transpose_item(F.in[I_WGLAO], 1024, 1024, (bf16*)(F.ws + WS_WG), scr, r, F.lane, RmId()); continue; } r -= I_SQ;
            if (r < I_SQ) { p0_transpose_item(F.in[I_WHYO], 1024, 1024, (bf16*)(F.ws + WS_WH), scr, r, F.lane, RmId()); continue; } r -= I_SQ;
            if (r < I_SQ) { p0_transpose_item(F.in[I_WOUT], 1024, 1024, (bf16*)(F.ws + WS_WO), scr, r, F.lane, RmId()); continue; } r -= I_SQ;
            { const int kb = r / NB8, s2_ = r % NB8, s2 = (G1CFG >= 4 && s2_ >= 96) ? s2_ + 96 : s2_, nb = s2 < 32 ? 64 + s2 : s2 < 96 ? 193 + (s2 - 32) : s2 < 192 ? 97 + (s2 - 96) : s2 < 224 ? 32 + (s2 - 192) : s2 - 224;
              fp8_transpose_kn(F.in[I_WIN], 1024, 8224, F.ws + WS_WB8, scr, kb, nb, F.lane, RmG8()); }
        }
    }
    __syncthreads();
}

__device__ __forceinline__ void p1_norm(Frame& F) {
    const int gw = F.vcu * NWAVES + F.wave, NGW = F.G * NWAVES;
    const float* mod = (const float*)(F.ws + WS_MOD);
    bf16* HX = (bf16*)(F.ws + WS_HX);
    f32x4 wn[4];
#pragma unroll
    for (int j = 0; j < 4; ++j) wn[j] = *(const f32x4*)(F.in[I_NMIX] + 4 * F.lane + 256 * j);
    for (int r0 = gw; r0 < NROW; r0 += 2 * NGW) {
        f32x4 v[2][4];
#pragma unroll
        for (int rr = 0; rr < 2; ++rr) { const int row = r0 + rr * NGW; if (row < NROW) {
            const float* xr = row < NTOK ? F.in[I_X] + (size_t)row * 1024 : F.in[I_CTX] + (size_t)(row - NTOK) * 1024;
#pragma unroll
            for (int j = 0; j < 4; ++j) v[rr][j] = *(const f32x4*)(xr + 4 * F.lane + 256 * j); } }
#pragma unroll
        for (int rr = 0; rr < 2; ++rr) { const int row = r0 + rr * NGW; if (row < NROW) {
            const int b = row < NTOK ? (row >> 11) : 16; const float* mb = mod + (size_t)b * 6144; float ss = 0.f;
#pragma unroll
            for (int j = 0; j < 4; ++j) ss += (v[rr][j].x * v[rr][j].x + v[rr][j].y * v[rr][j].y) + (v[rr][j].z * v[rr][j].z + v[rr][j].w * v[rr][j].w);
            const float rs = __builtin_amdgcn_rsqf(wave_sum(ss) * (1.f / 1024.f) + EPS);
#pragma unroll
            for (int j = 0; j < 4; ++j) { const int col = 4 * F.lane + 256 * j;
                const f32x4 w = wn[j], sh = *(const f32x4*)(mb + col), sc = *(const f32x4*)(mb + 1024 + col);
                const f32x4 y = (v[rr][j] * rs) * w * (sc + 1.f) + sh;
                v2u o; o.x = pk2(y.x, y.y); o.y = pk2(y.z, y.w);
                *(v2u*)(HX + (size_t)row * 1024 + col) = o;
                if (row < NTOK) { int w8 = 0; w8 = __builtin_amdgcn_cvt_pk_fp8_f32(y.x, y.y, w8, false); w8 = __builtin_amdgcn_cvt_pk_fp8_f32(y.z, y.w, w8, true); *(int*)(F.ws + WS_HX8 + (size_t)row * 1024 + col) = w8; } } } }
    }
}

constexpr int GL_QD = 0, GL_KI = 17408, GL_WGK = 34816, GL_BIAS = 43008;
constexpr float QSCALE = 16.f, QSCALE_INV = 1.f / 16.f;
__device__ __forceinline__ f32x4 mfma16(bf16x8 a, bf16x8 b, f32x4 c) { return __builtin_amdgcn_mfma_f32_16x16x32_bf16(a, b, c, 0, 0, 0); }
#define DPP_ADDM(v, ctrl, rmask) ((v) + __builtin_bit_cast(float, __builtin_amdgcn_update_dpp(0, __builtin_bit_cast(int, (v)), (ctrl), (rmask), 0xf, true)))
__device__ __forceinline__ float wave_incl_scan(float v) {
    v = DPP_ADDM(v, 0x111, 0xf); v = DPP_ADDM(v, 0x112, 0xf); v = DPP_ADDM(v, 0x114, 0xf); v = DPP_ADDM(v, 0x118, 0xf);
    v = DPP_ADDM(v, 0x142, 0xa);
    v = DPP_ADDM(v, 0x143, 0xc);
    return v;
}
constexpr int XW_UP = 8 * 8, XW_DN = 8 * 4, XW_NIT = NE * (XW_UP + XW_DN), XW_LDS = 49152;
#define XW_DECODE(it_) const bool isup_ = (it_) < NE * XW_UP; const int r_ = isup_ ? (it_) : (it_) - NE * XW_UP; const int sh_ = isup_ ? 6 : 5; const int e_ = r_ >> sh_, q_ = r_ & ((1 << sh_) - 1); \
        const int N_ = isup_ ? 2048 : 1024, kb_ = q_ >> (sh_ - 3), nb_ = q_ & ((1 << (sh_ - 3)) - 1); const float* W_ = (isup_ ? F.in[I_WUP] : F.in[I_WDN]) + (size_t)e_ * 1024 * N_;
#define XW_LOAD(it_) do { XW_DECODE(it_) _Pragma("unroll") for (int i = 0; i < 16; ++i) vn[i] = *(const f32x4*)(W_ + (size_t)(128 * kb_ + 16 * F.wave + i) * N_ + 256 * nb_ + 4 * F.lane); } while (0)
#define XW_CONVERT(T_) do { _Pragma("unroll") for (int q = 0; q < 4; ++q) { int wd[4]; \
            _Pragma("unroll") for (int d2 = 0; d2 < 4; ++d2) { int w0 = 0; \
                w0 = __builtin_amdgcn_cvt_pk_fp8_f32(vn[4 * d2][q] * pg8::WSCALE, vn[4 * d2 + 1][q] * pg8::WSCALE, w0, false); \
                w0 = __builtin_amdgcn_cvt_pk_fp8_f32(vn[4 * d2 + 2][q] * pg8::WSCALE, vn[4 * d2 + 3][q] * pg8::WSCALE, w0, true); wd[d2] = w0; } \
            *(LAS v4u*)((T_) + (4 * F.lane + q) * 144 + 16 * F.wave) = (v4u){(unsigned)wd[0], (unsigned)wd[1], (unsigned)wd[2], (unsigned)wd[3]}; } } while (0)
#define XW_STORE(it_, T_) do { XW_DECODE(it_) (void)W_; unsigned char* WT = F.ws + (isup_ ? WS_WUP : WS_WDN) + (size_t)e_ * N_ * 1024; \
          _Pragma("unroll") for (int j = 0; j < 4; ++j) { const int p = F.tid + 512 * j, row = p >> 3, c = p & 7; const int n = 256 * nb_ + row; \
              const int drow = isup_ ? (256 * ((n >> 1) >> 7) + 128 * (n & 1) + ((n >> 1) & 127)) : n; \
              *(v4u*)(WT + (size_t)drow * 1024 + 128 * kb_ + 16 * c) = *(const LAS v4u*)((T_) + row * 144 + 16 * c); } } while (0)
__device__ __forceinline__ void gla_prep(Frame& F) {
    const int tid = F.tid, lane = F.lane, w = F.wave, fr = lane & 15, fq = lane >> 4;
    LAS unsigned char* L = F.lds;
    const bf16* Qb = (const bf16*)(F.ws + WS_QB); const bf16* Kb = (const bf16*)(F.ws + WS_KB); const float* Rf = (const float*)(F.ws + WS_RF);
    int cur_hd = -1;
    float wq[16][4];
#pragma unroll
    for (int m = 0; m < 16; ++m)
#pragma unroll
        for (int q = 0; q < 4; ++q) wq[m][q] = 0.f;
    f32x4 r4n[4]; v4u kvn[2], qvn[2];
#define GP_LOAD(uu) do { const int dir_ = (uu) & 1, h_ = ((uu) >> 1) & 3, cg_ = (uu) >> 3; const bool ic_ = cg_ >= 512; \
        const size_t row_ = (size_t)((ic_ ? (NTOK + ((cg_ - 512) >> 2) * 256 + 64 * ((cg_ - 512) & 3)) : ((cg_ >> 5) * 2048 + 64 * (cg_ & 31))) + lane); \
        _Pragma("unroll") for (int q = 0; q < 4; ++q) r4n[q] = *(const f32x4*)(Rf + row_ * 32 + 16 * dir_ + 4 * q); \
        _Pragma("unroll") for (int q = 0; q < 2; ++q) { kvn[q] = *(const v4u*)(Kb + row_ * 512 + 128 * h_ + 16 * w + 8 * q); qvn[q] = ic_ ? (v4u){0u, 0u, 0u, 0u} : *(const v4u*)(Qb + row_ * 512 + 128 * h_ + 16 * w + 8 * q); } } while (0)
    if ((int)blockIdx.x < 576 * 8) GP_LOAD((int)blockIdx.x);
    f32x4 vn[16]; int xit = blockIdx.x, xn = 0, xprev = 0; bool xpend = false; LAS unsigned char* XTp = L + XW_LDS;
    for (int u = blockIdx.x; u < 576 * 8; u += F.G) {
        const int dir = u & 1, h = (u >> 1) & 3, cg = u >> 3;
        const bool isctx = cg >= 512;
        const int rowbase = isctx ? (NTOK + ((cg - 512) >> 2) * 256 + 64 * ((cg - 512) & 3)) : ((cg >> 5) * 2048 + 64 * (cg & 31));
        const size_t row = (size_t)(rowbase + lane);
        f32x4 r4[4]; v4u kv[2], qv[2];
#pragma unroll
        for (int q = 0; q < 4; ++q) r4[q] = r4n[q];
#pragma unroll
        for (int q = 0; q < 2; ++q) { kv[q] = kvn[q]; qv[q] = qvn[q]; }
        if (u + F.G < 576 * 8) GP_LOAD(u + F.G);
        const bool xload = false && xit < XW_NIT;
        if (xload) XW_LOAD(xit);
        if ((u & 7) != cur_hd) {
            __syncthreads();
            { const int idx = 4 * tid, m = idx >> 7, dd = idx & 127; *(LAS f32x4*)(L + GL_WGK + idx * 4) = *(const f32x4*)(F.in[dir ? I_WGKB : I_WGKF] + m * 512 + 128 * h + dd); }
            if (tid < 32) *(LAS f32x4*)(L + GL_BIAS + 16 * tid) = *(const f32x4*)(F.in[dir ? I_BGKB : I_BGKF] + 128 * h + 4 * tid);
            __syncthreads();
            cur_hd = u & 7;
#pragma unroll
            for (int m = 0; m < 16; ++m)
#pragma unroll
                for (int q = 0; q < 4; ++q) wq[m][q] = *(const LAS float*)(L + GL_WGK + (m * 128 + 16 * w + 4 * q + (lane & 3)) * 4);
        }
        float a[16];
#pragma unroll
        for (int q = 0; q < 4; ++q) { const f32x4 bv = *(const LAS f32x4*)(L + GL_BIAS + (16 * w + 4 * q) * 4); a[4 * q] = bv.x; a[4 * q + 1] = bv.y; a[4 * q + 2] = bv.z; a[4 * q + 3] = bv.w; }
#define QF(acc_, w_, r_, k_) asm("v_fmac_f32_dpp %0, %1, %2 quad_perm:[" #k_ "," #k_ "," #k_ "," #k_ "] row_mask:0xf bank_mask:0xf" : "+v"(acc_) : "v"(w_), "v"(r_))
#pragma unroll
        for (int m = 0; m < 16; ++m) { const float rm = r4[m >> 2][m & 3];
#pragma unroll
            for (int q = 0; q < 4; ++q) { const float wv = wq[m][q];
                QF(a[4 * q], wv, rm, 0); QF(a[4 * q + 1], wv, rm, 1); QF(a[4 * q + 2], wv, rm, 2); QF(a[4 * q + 3], wv, rm, 3); } }
#undef QF
        const size_t ck = (size_t)(dir * 576 + cg) * 4 + h;
        unsigned qdw[8], kiw[8]; float decv[16]; int ku8[4] = {0, 0, 0, 0}, qd8[4] = {0, 0, 0, 0};
        float gch[16], inc[16];
#pragma unroll
        for (int d = 0; d < 16; ++d) { const float av = a[d]; const float t2 = __builtin_amdgcn_logf(1.f + __builtin_amdgcn_exp2f(fabsf(av) * -1.4426950408889634f));
            gch[d] = fminf(av, 0.f) * (1.4426950408889634f / 16.f) - t2 * (1.f / 16.f); inc[d] = gch[d]; }
#pragma unroll
        for (int d = 0; d < 16; ++d) inc[d] = DPP_ADDM(inc[d], 0x111, 0xf);
#pragma unroll
        for (int d = 0; d < 16; ++d) inc[d] = DPP_ADDM(inc[d], 0x112, 0xf);
#pragma unroll
        for (int d = 0; d < 16; ++d) inc[d] = DPP_ADDM(inc[d], 0x114, 0xf);
#pragma unroll
        for (int d = 0; d < 16; ++d) inc[d] = DPP_ADDM(inc[d], 0x118, 0xf);
#pragma unroll
        for (int d = 0; d < 16; ++d) inc[d] = DPP_ADDM(inc[d], 0x142, 0xa);
#pragma unroll
        for (int d = 0; d < 16; ++d) inc[d] = DPP_ADDM(inc[d], 0x143, 0xc);
#pragma unroll
        for (int dd = 0; dd < 16; dd += 2) {
            float ei[2], kk2[2], qq2[2], kuv[2];
#pragma unroll
            for (int x = 0; x < 2; ++x) {
                const float g = gch[dd + x];
                const float incl = inc[dd + x];
                const float tot = __builtin_bit_cast(float, __builtin_amdgcn_readlane(__builtin_bit_cast(int, incl), 63));
                const float bc = dir ? (tot - incl + g) : incl;
                ei[x] = __builtin_amdgcn_exp2f(-bc); const float dec = __builtin_amdgcn_exp2f(tot); decv[dd + x] = dec;
                const unsigned kw = kv[(dd + x) >> 3][((dd + x) >> 1) & 3], qw = qv[(dd + x) >> 3][((dd + x) >> 1) & 3];
                kk2[x] = x ? bfhi(kw) : bflo(kw); qq2[x] = x ? bfhi(qw) : bflo(qw);
                kuv[x] = kk2[x] * (dec * ei[x]); }
            kiw[dd >> 1] = pk2(kk2[0] * ei[0], kk2[1] * ei[1]);
            const float qd0 = qq2[0] * __builtin_amdgcn_rcpf(ei[0]), qd1 = qq2[1] * __builtin_amdgcn_rcpf(ei[1]);
            qdw[dd >> 1] = pk2(qd0, qd1);
            if ((dd >> 1) & 1) { ku8[dd >> 2] = __builtin_amdgcn_cvt_pk_fp8_f32(kuv[0], kuv[1], ku8[dd >> 2], true); qd8[dd >> 2] = __builtin_amdgcn_cvt_pk_fp8_f32(qd0 * QSCALE, qd1 * QSCALE, qd8[dd >> 2], true); }
            else { ku8[dd >> 2] = __builtin_amdgcn_cvt_pk_fp8_f32(kuv[0], kuv[1], ku8[dd >> 2], false); qd8[dd >> 2] = __builtin_amdgcn_cvt_pk_fp8_f32(qd0 * QSCALE, qd1 * QSCALE, qd8[dd >> 2], false); } }
        *(v4u*)(F.ws + WS_KUT + (ck * 64 + lane) * 128 + 16 * w) = (v4u){(unsigned)ku8[0], (unsigned)ku8[1], (unsigned)ku8[2], (unsigned)ku8[3]};
        if (lane == 0) { float* dp = (float*)(F.ws + WS_DEC) + ck * 128 + 16 * w;
#pragma unroll
            for (int q = 0; q < 4; ++q) *(f32x4*)(dp + 4 * q) = (f32x4){decv[4 * q], decv[4 * q + 1], decv[4 * q + 2], decv[4 * q + 3]}; }
        if (!isctx) {
            *(v4u*)(F.ws + WS_QD + (size_t)dir * NTOK * 512 + row * 512 + 128 * h + 16 * w) = (v4u){(unsigned)qd8[0], (unsigned)qd8[1], (unsigned)qd8[2], (unsigned)qd8[3]};
            *(LAS v4u*)(L + GL_QD + lane * 272 + 32 * w) = (v4u){qdw[0], qdw[1], qdw[2], qdw[3]}; *(LAS v4u*)(L + GL_QD + lane * 272 + 32 * w + 16) = (v4u){qdw[4], qdw[5], qdw[6], qdw[7]};
            *(LAS v4u*)(L + GL_KI + lane * 272 + 32 * w) = (v4u){kiw[0], kiw[1], kiw[2], kiw[3]}; *(LAS v4u*)(L + GL_KI + lane * 272 + 32 * w + 16) = (v4u){kiw[4], kiw[5], kiw[6], kiw[7]};
            __syncthreads();
            if (xpend) XW_STORE(xprev, XTp);
            unsigned char* ag = F.ws + WS_ATT + ((size_t)(dir * 512 + cg) * 4 + h) * 4096;
            bf16x8 fa[2][4], fb[2][4];
#pragma unroll
            for (int tt = 0; tt < 2; ++tt) { const int t = 2 * w + tt, jt = t >> 2, it = t & 3;
#pragma unroll
                for (int ks = 0; ks < 4; ++ks) { fa[tt][ks] = *(const LAS bf16x8*)(L + GL_KI + (16 * jt + fr) * 272 + (32 * ks + 8 * fq) * 2); fb[tt][ks] = *(const LAS bf16x8*)(L + GL_QD + (16 * it + fr) * 272 + (32 * ks + 8 * fq) * 2); } }
#pragma unroll
            for (int tt = 0; tt < 2; ++tt) { const int t = 2 * w + tt, jt = t >> 2, it = t & 3;
                f32x4 a4 = (f32x4){0.f, 0.f, 0.f, 0.f};
#pragma unroll
                for (int ks = 0; ks < 4; ++ks) a4 = mfma16(fa[tt][ks], fb[tt][ks], a4);
                const int i = 16 * it + fr;
#pragma unroll
                for (int rgi = 0; rgi < 4; ++rgi) { const int j = 16 * jt + 4 * fq + rgi; const bool keep = dir ? (j >= i) : (j <= i); a4[rgi] = keep ? a4[rgi] : 0.f; }
                int o8 = 0; o8 = __builtin_amdgcn_cvt_pk_fp8_f32(a4[0], a4[1], o8, false); o8 = __builtin_amdgcn_cvt_pk_fp8_f32(a4[2], a4[3], o8, true);
                *(int*)(ag + (16 * it + fr) * 64 + 16 * jt + 4 * fq) = o8; }
            __syncthreads();
        } else if (xpend) { __syncthreads(); XW_STORE(xprev, XTp); }
        xpend = false;
        if (xload) { XTp = L + XW_LDS + (xn & 1) * 36864; XW_CONVERT(XTp); xprev = xit; xpend = true; xit += F.G; ++xn; }
    }
#undef GP_LOAD
    __syncthreads();
    if (xpend) XW_STORE(xprev, XTp);
    __syncthreads();
}

__device__ __forceinline__ void p_expert_weights(Frame& F) {
    const int nun = (int)blockIdx.x < 576 * 8 ? (576 * 8 - 1 - (int)blockIdx.x) / F.G + 1 : 0;
    int it = XW_NIT + 0 * nun, nit = 0;
    f32x4 vn[16];
    if (it < XW_NIT) XW_LOAD(it);
    for (; it < XW_NIT; it += F.G, ++nit) {
        LAS unsigned char* T = F.lds + (nit & 1) * 36864;
        XW_CONVERT(T);
        if (it + F.G < XW_NIT) XW_LOAD(it + F.G);
        __syncthreads();
        XW_STORE(it, T);
    }
    __syncthreads();
}

constexpr int SC_STAGE = 57856, SC_QD = 0, SC_ATT = 16384, SC_KUT = 24576, SC_VT = 40960, SC_DEC = 57344, SC_ST = 2 * SC_STAGE;
__device__ __forceinline__ int sw16(int row, int c16) { return row * 256 + ((c16 ^ (row & 15)) << 4); }
__device__ __forceinline__ int sw8(int row, int c8) { return row * 128 + ((c8 ^ ((row >> 1) & 7)) << 4); }
constexpr float OSCALE = 1.f / 16.f;
struct ScanRegs { v4u q, a, k, v; f32x4 dec; };
__device__ __forceinline__ void scan_chunk_ids(int b, int dir, int s, bool& isctx, int& cgk, int& cga, int& rowq, int& rowk) {
    isctx = s < 4;
    const int ci = isctx ? (dir ? 3 - s : s) : (dir ? 31 - (s - 4) : (s - 4));
    cgk = isctx ? (512 + b * 4 + ci) : (b * 32 + ci); cga = b * 32 + ci;
    rowq = b * 2048 + 64 * ci; rowk = isctx ? (NTOK + b * 256 + 64 * ci) : rowq;
}
__device__ __forceinline__ void scan_issue(const unsigned char* ws, int tid, int b, int h, int dir, int dvh, int s, ScanRegs& R) {
    bool isctx; int cgk, cga, rowq, rowk; scan_chunk_ids(b, dir, s, isctx, cgk, cga, rowq, rowk);
    const int lane = tid & 63, w = tid >> 6;
    const unsigned char* kb_ = ws + WS_KUT + ((size_t)(dir * 576 + cgk) * 4 + h) * 8192;
    const unsigned char* vb_ = ws + WS_VB + (size_t)rowk * 1024 + 256 * h + 128 * dvh;
    unsigned ok = lane * 128 + 16 * w, ov = lane * 1024 + 16 * w, ot = 16 * tid, oq = (tid >> 3) * 512 + 16 * (tid & 7);
    asm volatile("" : "+v"(ok), "+v"(ov), "+v"(ot), "+v"(oq));
    R.k = *(const v4u*)(kb_ + ok);
    R.v = *(const v4u*)(vb_ + ov);
    if (tid < 32) R.dec = *(const f32x4*)(ws + WS_DEC + ((size_t)(dir * 576 + cgk) * 4 + h) * 512 + ot);
    if (!isctx) {
        const unsigned char* qb_ = ws + WS_QD + (size_t)dir * NTOK * 512 + (size_t)rowq * 512 + 128 * h;
        R.q = *(const v4u*)(qb_ + oq);
        if (tid < 256) R.a = *(const v4u*)(ws + WS_ATT + ((size_t)(dir * 512 + cga) * 4 + h) * 4096 + ot);
    }
}
__device__ __forceinline__ unsigned fp8x2_bf16(int wd, bool hi, float sc) {
    typedef float f32x2_ __attribute__((ext_vector_type(2)));
    const f32x2_ f = hi ? __builtin_amdgcn_cvt_pk_f32_fp8(wd, true) : __builtin_amdgcn_cvt_pk_f32_fp8(wd, false);
    return (__builtin_bit_cast(unsigned, f[0] * sc) >> 16) | (__builtin_bit_cast(unsigned, f[1] * sc) & 0xffff0000u);
}
__device__ __forceinline__ void scan_fill(Frame& F, LAS unsigned char* G, bool isctx, const ScanRegs& R) {
    const int tid = F.tid, lane = F.lane, w = F.wave;
#pragma unroll
    for (int d2 = 0; d2 < 4; ++d2) {
        const unsigned k01 = fp8x2_bf16((int)R.k[d2], false, 1.f), k23 = fp8x2_bf16((int)R.k[d2], true, 1.f);
        const unsigned v01 = fp8x2_bf16((int)R.v[d2], false, 1.f), v23 = fp8x2_bf16((int)R.v[d2], true, 1.f);
        const int r0 = 16 * w + 4 * d2, co = 2 * (lane & 7), cj = lane >> 3;
        *(LAS bf16*)(G + SC_KUT + sw8(r0, cj) + co) = (bf16)(k01 & 0xffffu); *(LAS bf16*)(G + SC_KUT + sw8(r0 + 1, cj) + co) = (bf16)(k01 >> 16);
        *(LAS bf16*)(G + SC_KUT + sw8(r0 + 2, cj) + co) = (bf16)(k23 & 0xffffu); *(LAS bf16*)(G + SC_KUT + sw8(r0 + 3, cj) + co) = (bf16)(k23 >> 16);
        *(LAS bf16*)(G + SC_VT + sw8(r0, cj) + co) = (bf16)(v01 & 0xffffu); *(LAS bf16*)(G + SC_VT + sw8(r0 + 1, cj) + co) = (bf16)(v01 >> 16);
        *(LAS bf16*)(G + SC_VT + sw8(r0 + 2, cj) + co) = (bf16)(v23 & 0xffffu); *(LAS bf16*)(G + SC_VT + sw8(r0 + 3, cj) + co) = (bf16)(v23 >> 16); }
    if (tid < 32) *(LAS f32x4*)(G + SC_DEC + 16 * tid) = R.dec;
    if (!isctx) {
        { const int row = tid >> 3, c = tid & 7; unsigned o[8];
#pragma unroll
          for (int d2 = 0; d2 < 4; ++d2) { o[2 * d2] = fp8x2_bf16((int)R.q[d2], false, QSCALE_INV); o[2 * d2 + 1] = fp8x2_bf16((int)R.q[d2], true, QSCALE_INV); }
          *(LAS v4u*)(G + SC_QD + sw16(row, 2 * c)) = (v4u){o[0], o[1], o[2], o[3]}; *(LAS v4u*)(G + SC_QD + sw16(row, 2 * c + 1)) = (v4u){o[4], o[5], o[6], o[7]}; }
        if (tid < 256) { const int row = tid >> 2, c = tid & 3; unsigned o[8];
#pragma unroll
          for (int d2 = 0; d2 < 4; ++d2) { o[2 * d2] = fp8x2_bf16((int)R.a[d2], false, 1.f); o[2 * d2 + 1] = fp8x2_bf16((int)R.a[d2], true, 1.f); }
          *(LAS v4u*)(G + SC_ATT + sw8(row, 2 * c)) = (v4u){o[0], o[1], o[2], o[3]}; *(LAS v4u*)(G + SC_ATT + sw8(row, 2 * c + 1)) = (v4u){o[4], o[5], o[6], o[7]}; }
    }
}
__device__ __forceinline__ void scan_mma(Frame& F, LAS unsigned char* G, bool isctx, int rowq, int h, int dvh, f32x4 (&S)[8], unsigned char* O) {
    const int lane = F.lane, w = F.wave, fr = lane & 15, fq = lane >> 4;
    const int wd = w & 3, wi = w >> 2, wk = ((w & 1) << 1) | (w >> 2);
    LAS unsigned char* L = F.lds;
    bf16x8 bv[4][2];
#define SC_DVT(nv) (2 * (wd ^ ((nv) >> 1)) + ((nv) & 1))
#pragma unroll
    for (int nv = 0; nv < 4; ++nv)
#pragma unroll
        for (int ks = 0; ks < 2; ++ks) bv[nv][ks] = *(const LAS bf16x8*)(G + SC_VT + sw8(16 * SC_DVT(nv) + fr, 4 * ks + fq));
    bf16x8 as_[2][4];
    if (!isctx) {
#pragma unroll
        for (int md = 0; md < 2; ++md)
#pragma unroll
            for (int ks = 0; ks < 4; ++ks) as_[md][ks] = *(const LAS bf16x8*)(L + SC_ST + (16 * (2 * wd + md) + fr) * 272 + (32 * ks + 8 * fq) * 2);
    }
    LDS_WAIT(); __syncthreads();
    if (!isctx) {
#pragma unroll
        for (int t2 = 0; t2 < 2; ++t2) { const int it = 2 * wi + t2;
            bf16x8 ba[2], bq[4];
#pragma unroll
            for (int ks = 0; ks < 2; ++ks) ba[ks] = *(const LAS bf16x8*)(G + SC_ATT + sw8(16 * it + fr, 4 * ks + fq));
#pragma unroll
            for (int ks = 0; ks < 4; ++ks) bq[ks] = *(const LAS bf16x8*)(G + SC_QD + sw16(16 * it + fr, 4 * ks + fq));
#pragma unroll
            for (int md = 0; md < 2; ++md) { f32x4 a4 = (f32x4){0.f, 0.f, 0.f, 0.f};
#pragma unroll
                for (int ks = 0; ks < 2; ++ks) a4 = mfma16(bv[md][ks], ba[ks], a4);
#pragma unroll
                for (int ks = 0; ks < 4; ++ks) a4 = mfma16(as_[md][ks], bq[ks], a4);
                int o8 = 0; o8 = __builtin_amdgcn_cvt_pk_fp8_f32(a4[0] * OSCALE, a4[1] * OSCALE, o8, false); o8 = __builtin_amdgcn_cvt_pk_fp8_f32(a4[2] * OSCALE, a4[3] * OSCALE, o8, true);
                *(int*)(O + (size_t)(rowq + 16 * it + fr) * 1024 + 256 * h + 128 * dvh + 16 * (2 * wd + md) + 4 * fq) = o8; } }
    }
    __builtin_amdgcn_sched_barrier(0);
    {
        bf16x8 ak[2][2]; f32x4 dc[2];
#pragma unroll
        for (int mk = 0; mk < 2; ++mk) { dc[mk] = *(const LAS f32x4*)(G + SC_DEC + (16 * (2 * wk + mk) + 4 * fq) * 4);
#pragma unroll
            for (int ks = 0; ks < 2; ++ks) ak[mk][ks] = *(const LAS bf16x8*)(G + SC_KUT + sw8(16 * (2 * wk + mk) + fr, 4 * ks + fq)); }
#pragma unroll
        for (int mk = 0; mk < 2; ++mk)
#pragma unroll
            for (int nv = 0; nv < 4; ++nv) { f32x4 a4 = S[4 * mk + nv] * dc[mk];
#pragma unroll
                for (int ks = 0; ks < 2; ++ks) a4 = mfma16(ak[mk][ks], bv[nv][ks], a4);
                S[4 * mk + nv] = a4; }
#pragma unroll
        for (int mk = 0; mk < 2; ++mk)
#pragma unroll
            for (int nv = 0; nv < 4; ++nv) { const f32x4 s4 = S[4 * mk + nv]; v2u o; o.x = pk2(s4[0], s4[1]); o.y = pk2(s4[2], s4[3]);
                *(LAS v2u*)(L + SC_ST + (16 * SC_DVT(nv) + fr) * 272 + (16 * (2 * wk + mk) + 4 * fq) * 2) = o; }
    }
#undef SC_DVT
}
__device__ __forceinline__ void scan_step(Frame& F, int b, int h, int dir, int dvh, int s, ScanRegs& Rn, f32x4 (&S)[8], unsigned char* O) {
    bool isctx; int cgk, cga, rowq, rowk; scan_chunk_ids(b, dir, s, isctx, cgk, cga, rowq, rowk);
    if (s + 1 < 36) { scan_fill(F, F.lds + ((s + 1) & 1) * SC_STAGE, s + 1 < 4, Rn); if (s + 3 < 36) scan_issue(F.ws, F.tid, b, h, dir, dvh, s + 3, Rn); }
    __builtin_amdgcn_sched_barrier(0);
    scan_mma(F, F.lds + (s & 1) * SC_STAGE, isctx, rowq, h, dvh, S, O);
    __syncthreads();
}
__device__ __forceinline__ void gla_scan(Frame& F, int u) {
    const int dvh = u & 1, dir = (u >> 1) & 1, h = (u >> 2) & 3, b = u >> 4;
    const int tid = F.tid;
    LAS unsigned char* L = F.lds;
    unsigned char* O = F.ws + (dir ? WS_OB : WS_OF);
    f32x4 S[8];
#pragma unroll
    for (int mt = 0; mt < 8; ++mt) S[mt] = (f32x4){0.f, 0.f, 0.f, 0.f};
    for (int i = tid; i < 34816 / 16; i += 512) *(LAS v4u*)(L + SC_ST + 16 * i) = (v4u){0u, 0u, 0u, 0u};
    ScanRegs R0, R1;
    scan_issue(F.ws, tid, b, h, dir, dvh, 0, R0);
    scan_issue(F.ws, tid, b, h, dir, dvh, 1, R1);
    scan_fill(F, L, true, R0);
    scan_issue(F.ws, tid, b, h, dir, dvh, 2, R0);
    __syncthreads();
#pragma nounroll
    for (int s = 0; s < 36; s += 2) {
        scan_step(F, b, h, dir, dvh, s, R1, S, O);
        scan_step(F, b, h, dir, dvh, s + 1, R0, S, O);
    }
}

__device__ __forceinline__ void hy_prep(Frame& F) {
    const bf16* HY = (const bf16*)(F.ws + WS_HY); bf16* X0C = (bf16*)(F.ws + WS_X0C); bf16* UT = (bf16*)(F.ws + WS_UT);
    const float* cw = F.in[I_HCW]; const float* cb_ = F.in[I_HCB];
    LAS unsigned char* L = F.lds;
    const int tl = F.tid >> 3, cg = F.tid & 7; int nit = 0;
        constexpr int HP_NK = 1;
    pg8::u32x4 ra[HP_NK][3][3], rb[HP_NK][3][3], rc[HP_NK][3][3];
#define HP_LOAD(R, it0_) do { _Pragma("unroll") for (int k = 0; k < HP_NK; ++k) { const int it = (it0_) + k * F.G; if (it < 8192) { \
            const int b = it >> 9, gr = (it >> 4) & 31, cb = it & 15, row0 = b * 2048 + 64 * gr, c0 = 64 * cb; \
            _Pragma("unroll") for (int gi = 0; gi < 3; ++gi) { const bf16* p = HY + (size_t)(row0 + tl) * 3072 + 1024 * gi + c0 + 8 * cg; \
                R[k][gi][0] = *(const pg8::u32x4*)p; R[k][gi][1] = (pg8::u32x4){0u, 0u, 0u, 0u}; R[k][gi][2] = (pg8::u32x4){0u, 0u, 0u, 0u}; \
                if (tl > 0) R[k][gi][1] = *(const pg8::u32x4*)(p - 3072); \
                if (tl < 63) R[k][gi][2] = *(const pg8::u32x4*)(p + 3072); } } } } while (0)
#define HP_TRIP(R, it0_, PRELOAD) do { \
        LAS unsigned char* Lt = L + (nit & 1) * 18432; ++nit; \
        _Pragma("unroll") for (int k = 0; k < HP_NK; ++k) { const int it = (it0_) + k * F.G; if (it < 8192) { \
            const int b = it >> 9, gr = (it >> 4) & 31, cb = it & 15, row0 = b * 2048 + 64 * gr, c0 = 64 * cb; (void)b; \
            float res[3][8]; \
            _Pragma("unroll") for (int gi = 0; gi < 3; ++gi) { const int col = 1024 * gi + c0 + 8 * cg; \
                float fc[8], fp[8], fn[8]; pg8::unpack8(R[k][gi][0], fc); pg8::unpack8(R[k][gi][1], fp); pg8::unpack8(R[k][gi][2], fn); \
                const LAS float* wl = WL + col; \
                const pg8::f32x4 w0a = *(const LAS pg8::f32x4*)(wl), w0b = *(const LAS pg8::f32x4*)(wl + 4), w1a = *(const LAS pg8::f32x4*)(wl + 3072), w1b = *(const LAS pg8::f32x4*)(wl + 3072 + 4); \
                const pg8::f32x4 w2a = *(const LAS pg8::f32x4*)(wl + 6144), w2b = *(const LAS pg8::f32x4*)(wl + 6144 + 4), wba = *(const LAS pg8::f32x4*)(wl + 9216), wbb = *(const LAS pg8::f32x4*)(wl + 9216 + 4); \
                _Pragma("unroll") for (int ch = 0; ch < 4; ++ch) { res[gi][ch] = w0a[ch] * fp[ch] + w1a[ch] * fc[ch] + w2a[ch] * fn[ch] + wba[ch]; \
                    res[gi][4 + ch] = w0b[ch] * fp[4 + ch] + w1b[ch] * fc[4 + ch] + w2b[ch] * fn[4 + ch] + wbb[ch]; } } \
            { v4u o; o.x = pk2(res[0][0], res[0][1]); o.y = pk2(res[0][2], res[0][3]); o.z = pk2(res[0][4], res[0][5]); o.w = pk2(res[0][6], res[0][7]); \
              *(v4u*)(X0C + (size_t)(row0 + tl) * 1024 + c0 + 8 * cg) = o; } \
            _Pragma("unroll") for (int ch = 0; ch < 8; ++ch) *(LAS bf16*)(Lt + k * 9216 + (8 * cg + ch) * 144 + 2 * tl) = (bf16)f2bf(res[2][ch] * res[1][ch]); } } \
        PRELOAD; \
        __syncthreads(); \
        _Pragma("unroll") for (int k = 0; k < HP_NK; ++k) { const int it = (it0_) + k * F.G; if (it < 8192) { \
            const int b = it >> 9, gr = (it >> 4) & 31, cb = it & 15, c0 = 64 * cb; const int cl = F.tid >> 3, piece = F.tid & 7; \
            *(v4u*)(UT + ((size_t)(c0 + cl) * 16 + b) * 2048 + 64 * gr + 8 * piece) = *(const LAS v4u*)(Lt + k * 9216 + cl * 144 + 16 * piece); } } \
    } while (0)
    const LAS float* WL = (const LAS float*)(L + 40960);
    for (int i = F.tid; i < 3 * 3072 / 4; i += 512) *(LAS pg8::f32x4*)(L + 40960 + 16 * i) = *(const pg8::f32x4*)(cw + 4 * i);
    for (int i = F.tid; i < 3072 / 4; i += 512) *(LAS pg8::f32x4*)(L + 40960 + 3 * 3072 * 4 + 16 * i) = *(const pg8::f32x4*)(cb_ + 4 * i);
    __syncthreads();
    const int step = HP_NK * F.G;
    HP_LOAD(ra, (int)blockIdx.x); HP_LOAD(rb, (int)blockIdx.x + step);
    for (int it0 = blockIdx.x; it0 < 8192; it0 += 3 * step) {
        HP_TRIP(ra, it0, HP_LOAD(rc, it0 + 2 * step));
        if (it0 + step < 8192) HP_TRIP(rb, it0 + step, HP_LOAD(ra, it0 + 3 * step));
        if (it0 + 2 * step < 8192) HP_TRIP(rc, it0 + 2 * step, HP_LOAD(rb, it0 + 4 * step));
    }
#undef HP_LOAD
#undef HP_TRIP
    __syncthreads();
}

constexpr int CV_UL = 0, CV_UB = 4240, CV_HC = 16 * CV_UB, CV_HS = 8208;
constexpr int XV_LDS = 133632, XV_TILE = 2560, XV_UPI = NE * 1024;
static_assert(XV_LDS >= CV_HC + 8 * CV_HS && XV_LDS + 8 * XV_TILE <= LDSCTL_OFF, "conv LDS");
#define XV_DECODE(wi_) const bool isup_ = (wi_) < XV_UPI; const int r_ = isup_ ? (wi_) : (wi_) - XV_UPI; const int sh_ = isup_ ? 10 : 9; const int e_ = r_ >> sh_, q_ = r_ & ((1 << sh_) - 1); \
        const int N_ = isup_ ? 2048 : 1024, kb_ = q_ >> (sh_ - 4), nb_ = q_ & ((1 << (sh_ - 4)) - 1); const float* W_ = (isup_ ? F.in[I_WUP] : F.in[I_WDN]) + (size_t)e_ * 1024 * N_;
#define XV_LOAD(wi_) do { XV_DECODE(wi_) _Pragma("unroll") for (int i = 0; i < 8; ++i) vw[i] = *(const f32x4*)(W_ + (size_t)(64 * kb_ + 8 * (lane >> 3) + i) * N_ + 32 * nb_ + 4 * (lane & 7)); } while (0)
#define XV_FINISH(wi_) do { LAS unsigned char* T_ = L + XV_LDS + w * XV_TILE; \
        _Pragma("unroll") for (int q = 0; q < 4; ++q) { int w0 = 0, w1 = 0; \
            w0 = __builtin_amdgcn_cvt_pk_fp8_f32(vw[0][q] * pg8::WSCALE, vw[1][q] * pg8::WSCALE, w0, false); w0 = __builtin_amdgcn_cvt_pk_fp8_f32(vw[2][q] * pg8::WSCALE, vw[3][q] * pg8::WSCALE, w0, true); \
            w1 = __builtin_amdgcn_cvt_pk_fp8_f32(vw[4][q] * pg8::WSCALE, vw[5][q] * pg8::WSCALE, w1, false); w1 = __builtin_amdgcn_cvt_pk_fp8_f32(vw[6][q] * pg8::WSCALE, vw[7][q] * pg8::WSCALE, w1, true); \
            *(LAS v2u*)(T_ + (4 * (lane & 7) + q) * 80 + 8 * (lane >> 3)) = (v2u){(unsigned)w0, (unsigned)w1}; } \
        LDS_WAIT(); asm volatile("" ::: "memory"); \
        { XV_DECODE(wi_) (void)W_; unsigned char* WT = F.ws + (isup_ ? WS_WUP : WS_WDN) + (size_t)e_ * N_ * 1024; \
          _Pragma("unroll") for (int j2 = 0; j2 < 2; ++j2) { const int p = lane + 64 * j2, row = p >> 2, c16 = p & 3; const int n = 32 * nb_ + row; \
              const int drow = isup_ ? (256 * ((n >> 1) >> 7) + 128 * (n & 1) + ((n >> 1) & 127)) : n; \
              *(v4u*)(WT + (size_t)drow * 1024 + 64 * kb_ + 16 * c16) = *(const LAS v4u*)(T_ + row * 80 + 16 * c16); } } \
        LDS_WAIT(); asm volatile("" ::: "memory"); } while (0)
__device__ __forceinline__ void hy_conv(Frame& F) {
    const bf16* UT = (const bf16*)(F.ws + WS_UT); const bf16* HR = (const bf16*)(F.ws + WS_HR); bf16* ZT = (bf16*)(F.ws + WS_ZT);
    LAS unsigned char* L = F.lds;
    const int tid = F.tid, lane = F.lane, w = F.wave;
    const int r = lane & 31, hk = lane >> 5, msh = (8 - (r & 7)) & 7;
    const int abase = CV_HC + msh * CV_HS + (2048 - r + 8 * hk - msh) * 2;
    const int bbase = CV_UL + (lane & 15) * CV_UB + 64 + ((lane & 31) >> 4) * 64 + 16 * hk;
    v4u ur[8], hv0, hv1;
#define CV_LOAD(cc) do { _Pragma("unroll") for (int kk = 0; kk < 8; ++kk) { const int p = tid + 512 * kk; ur[kk] = *(const v4u*)(UT + ((size_t)(cc) * 16 + (p >> 8)) * 2048 + 8 * (p & 255)); } \
        { const bf16* g = HR + (size_t)(cc) * HRL + 8 * tid; hv0 = *(const v4u*)g; hv1 = *(const v4u*)(g + 8); } } while (0)
    if ((int)blockIdx.x < 1024) CV_LOAD((int)blockIdx.x);
    for (int c = blockIdx.x; c < 1024; c += F.G) {
#pragma unroll
        for (int kk = 0; kk < 8; ++kk) { const int p = tid + 512 * kk, b = p >> 8, o16 = p & 255; *(LAS v4u*)(L + CV_UL + b * CV_UB + 64 + 16 * o16) = ur[kk]; }
        if (tid < 128) { const int b = tid >> 3, wh = (tid >> 2) & 1, q4 = tid & 3; *(LAS v4u*)(L + CV_UL + b * CV_UB + (wh ? 4160 : 0) + 16 * q4) = (v4u){0u, 0u, 0u, 0u}; }
        { unsigned W[8];
#pragma unroll
          for (int q = 0; q < 4; ++q) { W[q] = hv0[q]; W[4 + q] = hv1[q]; }
#pragma unroll
          for (int m = 0; m < 8; ++m) { v4u o;
#pragma unroll
              for (int q = 0; q < 4; ++q) o[q] = (m & 1) ? ((W[(m >> 1) + q] >> 16) | (W[(m >> 1) + q + 1] << 16)) : W[(m >> 1) + q];
              *(LAS v4u*)(L + CV_HC + m * CV_HS + 16 * tid) = o; } }
        if (c + F.G < 1024) CV_LOAD(c + F.G);
        __syncthreads();
        f32x16 acc[4];
#pragma unroll
        for (int i = 0; i < 4; ++i)
#pragma unroll
            for (int q = 0; q < 16; ++q) acc[i][q] = 0.f;
        bf16x8 Bs[4][2];
#define CV_STEP(S) do { const int j = 4 * g + (S); const int qn = 2 * (32 - j) - par; const int dl = 2 * (4 * w - 32 + j) + par; \
            if (qn >= -1 && qn <= 63) { Bs[(4 - (S)) & 3][0] = *(const LAS bf16x8*)(L + bbase + qn * 64); Bs[(4 - (S)) & 3][1] = *(const LAS bf16x8*)(L + bbase + qn * 64 + 32); } \
            if (qn + 6 >= -1 && qn <= 63) { \
                const bf16x8 A0 = *(const LAS bf16x8*)(L + abase - 64 * dl), A1 = *(const LAS bf16x8*)(L + abase - 64 * dl + 32); \
                _Pragma("unroll") for (int i = 0; i < 4; ++i) { const int q = qn + 2 * i; if (q >= -1 && q <= 63) { \
                    acc[i] = __builtin_amdgcn_mfma_f32_32x32x16_bf16(A0, Bs[(i - (S) + 4) & 3][0], acc[i], 0, 0, 0); \
                    acc[i] = __builtin_amdgcn_mfma_f32_32x32x16_bf16(A1, Bs[(i - (S) + 4) & 3][1], acc[i], 0, 0, 0); } } } } while (0)
        f32x4 vw[8];
        for (int par = 0; par < 2; ++par)
            for (int g = 0; g < 9; ++g) {
                { const int gi = par * 9 + g; if (gi % 3 == 0) { const int j = gi / 3; const int wi = j * 8192 + c * 8 + w;
                      if (j > 0) XV_FINISH(wi - 8192);
                      XV_LOAD(wi); } }
                CV_STEP(0); CV_STEP(1); CV_STEP(2); CV_STEP(3); }
        XV_FINISH(5 * 8192 + c * 8 + w);
#undef CV_STEP
        { const int qs = (lane & 31) >> 4, bb = lane & 15;
#pragma unroll
          for (int i = 0; i < 4; ++i) { const int p = 8 * w + 2 * i + qs; bf16* zp = ZT + ((size_t)c * 16 + bb) * 2048 + 32 * p + 4 * hk;
#pragma unroll
              for (int g4 = 0; g4 < 4; ++g4) { v2u o; o.x = pk2(acc[i][4 * g4], acc[i][4 * g4 + 1]); o.y = pk2(acc[i][4 * g4 + 2], acc[i][4 * g4 + 3]); *(v2u*)(zp + 8 * g4) = o; } } }
        __syncthreads();
    }
#undef CV_LOAD
}

__device__ __forceinline__ void p5_post(Frame& F) {
    const int gw = F.vcu * NWAVES + F.wave, NGW = F.G * NWAVES, lane = F.lane;
    { const unsigned char* Of = F.ws + WS_OF; const unsigned char* Ob = F.ws + WS_OB; const unsigned char* OG = F.ws + WS_OG; bf16* GA = (bf16*)(F.ws + WS_GA);
      typedef float f32x2_ __attribute__((ext_vector_type(2)));
      f32x4 gn[4];
#pragma unroll
      for (int q = 0; q < 4; ++q) gn[q] = *(const f32x4*)(F.in[I_GLAN] + 16 * (lane & 15) + 4 * q);
      v4u ra[2][3], rb[2][3], rc[2][3];
#define PP_LOAD(R, r0_) do { _Pragma("unroll") for (int rr = 0; rr < 2; ++rr) { const int row = (r0_) + rr * NGW; if (row < NTOK) { const size_t o = (size_t)row * 1024 + 16 * lane; \
            R[rr][0] = *(const v4u*)(Of + o); R[rr][1] = *(const v4u*)(Ob + o); R[rr][2] = *(const v4u*)(OG + o); } } } while (0)
#define PP_TRIP(R, r0_, PRELOAD) do { v4u c_[2][3]; _Pragma("unroll") for (int rr = 0; rr < 2; ++rr) _Pragma("unroll") for (int k = 0; k < 3; ++k) c_[rr][k] = R[rr][k]; \
        asm volatile("" : "+v"(c_[0][0]), "+v"(c_[0][1]), "+v"(c_[0][2]), "+v"(c_[1][0]), "+v"(c_[1][1]), "+v"(c_[1][2])); \
        PRELOAD; \
        _Pragma("unroll") for (int rr = 0; rr < 2; ++rr) { const int row = (r0_) + rr * NGW; if (row < NTOK) { \
            f32x4 v[4], og[4]; float ss = 0.f; \
            _Pragma("unroll") for (int q = 0; q < 4; ++q) { \
                const f32x2_ al = __builtin_amdgcn_cvt_pk_f32_fp8((int)c_[rr][0][q], false), ah = __builtin_amdgcn_cvt_pk_f32_fp8((int)c_[rr][0][q], true); \
                const f32x2_ bl = __builtin_amdgcn_cvt_pk_f32_fp8((int)c_[rr][1][q], false), bh = __builtin_amdgcn_cvt_pk_f32_fp8((int)c_[rr][1][q], true); \
                const f32x2_ gl = __builtin_amdgcn_cvt_pk_f32_fp8((int)c_[rr][2][q], false), gh = __builtin_amdgcn_cvt_pk_f32_fp8((int)c_[rr][2][q], true); \
                v[q] = (f32x4){al[0] + bl[0], al[1] + bl[1], ah[0] + bh[0], ah[1] + bh[1]}; og[q] = (f32x4){gl[0], gl[1], gh[0], gh[1]}; \
                ss += (v[q].x * v[q].x + v[q].y * v[q].y) + (v[q].z * v[q].z + v[q].w * v[q].w); } \
            ss = DPP_ADD(ss, 0xB1); ss = DPP_ADD(ss, 0x4E); ss = DPP_ADD(ss, 0x141); ss = DPP_ADD(ss, 0x140);        \
            const float rs = __builtin_amdgcn_rsqf(ss * (1.f / 256.f) + EPS * (OSCALE * OSCALE));        \
            unsigned ow[8]; \
            _Pragma("unroll") for (int q = 0; q < 4; ++q) { f32x4 g = og[q]; \
                _Pragma("unroll") for (int e = 0; e < 4; ++e) g[e] = g[e] * sigmoidf_(g[e]);          \
                const f32x4 y = (v[q] * rs) * gn[q] * g; ow[2 * q] = pk2(y.x, y.y); ow[2 * q + 1] = pk2(y.z, y.w); } \
            bf16* gp = GA + (size_t)row * 1024 + 16 * lane; \
            *(v4u*)gp = (v4u){ow[0], ow[1], ow[2], ow[3]}; *(v4u*)(gp + 8) = (v4u){ow[4], ow[5], ow[6], ow[7]}; } } } while (0)
      const int rstep = 2 * NGW;
      PP_LOAD(ra, gw); PP_LOAD(rb, gw + rstep);
      for (int row0 = gw; row0 < NTOK; row0 += 3 * rstep) {
          PP_TRIP(ra, row0, PP_LOAD(rc, row0 + 2 * rstep));
          if (row0 + rstep < NTOK) PP_TRIP(rb, row0 + rstep, PP_LOAD(ra, row0 + 3 * rstep));
          if (row0 + 2 * rstep < NTOK) PP_TRIP(rc, row0 + 2 * rstep, PP_LOAD(rb, row0 + 4 * rstep));
      }
#undef PP_LOAD
#undef PP_TRIP
    }
    { const bf16* ZT = (const bf16*)(F.ws + WS_ZT); const bf16* X0C = (const bf16*)(F.ws + WS_X0C); bf16* YH = (bf16*)(F.ws + WS_YH);
      LAS unsigned char* L = F.lds; int nit = 0;
      const int cl = F.tid >> 3, piece = F.tid & 7, tl = F.tid >> 3, cg = F.tid & 7;
      v4u za[2], zb[2], zc[2]; pg8::u32x4 xa[2], xb[2], xc[2];
#define PH_LOAD(Z, X, it0_) do { _Pragma("unroll") for (int k = 0; k < 2; ++k) { const int it = (it0_) + k * F.G; if (it < 8192) { const int b = it >> 9, tb = (it >> 4) & 31, cb = it & 15, row0 = b * 2048 + 64 * tb, c0 = 64 * cb; \
              Z[k] = *(const v4u*)(ZT + ((size_t)(c0 + cl) * 16 + b) * 2048 + 64 * tb + 8 * piece); \
              X[k] = *(const pg8::u32x4*)(X0C + (size_t)(row0 + tl) * 1024 + c0 + 8 * cg); } } } while (0)
#define PH_TRIP(Z, X, it0_, PRELOAD) do { \
          LAS unsigned char* Lt = L + (nit & 1) * 18432; ++nit; \
          _Pragma("unroll") for (int k = 0; k < 2; ++k) { const int it = (it0_) + k * F.G; if (it < 8192) *(LAS v4u*)(Lt + k * 9216 + cl * 144 + 16 * piece) = Z[k]; } \
          pg8::u32x4 xk_[2]; xk_[0] = X[0]; xk_[1] = X[1]; asm volatile("" : "+v"(xk_[0]), "+v"(xk_[1])); \
          PRELOAD; \
          __syncthreads(); \
          _Pragma("unroll") for (int k = 0; k < 2; ++k) { const int it = (it0_) + k * F.G; if (it < 8192) { const int b = it >> 9, tb = (it >> 4) & 31, cb = it & 15, row0 = b * 2048 + 64 * tb, c0 = 64 * cb; \
              float xf[8]; pg8::unpack8(xk_[k], xf); float y[8]; \
              _Pragma("unroll") for (int ch = 0; ch < 8; ++ch) y[ch] = xf[ch] * bf2f(*(const LAS bf16*)(Lt + k * 9216 + (8 * cg + ch) * 144 + 2 * tl)); \
              v4u o; o.x = pk2(y[0], y[1]); o.y = pk2(y[2], y[3]); o.z = pk2(y[4], y[5]); o.w = pk2(y[6], y[7]); \
              *(v4u*)(YH + (size_t)(row0 + tl) * 1024 + c0 + 8 * cg) = o; } } } while (0)
      const int step = 2 * F.G;
      PH_LOAD(za, xa, (int)blockIdx.x); PH_LOAD(zb, xb, (int)blockIdx.x + step);
      for (int it0 = blockIdx.x; it0 < 8192; it0 += 3 * step) {
          PH_TRIP(za, xa, it0, PH_LOAD(zc, xc, it0 + 2 * step));
          if (it0 + step < 8192) PH_TRIP(zb, xb, it0 + step, PH_LOAD(za, xa, it0 + 3 * step));
          if (it0 + 2 * step < 8192) PH_TRIP(zc, xc, it0 + 2 * step, PH_LOAD(zb, xb, it0 + 4 * step));
      }
#undef PH_LOAD
#undef PH_TRIP
      __syncthreads(); }
}

constexpr int RT_RS = 2064;
constexpr int RT_WH = 0, RT_WL = 32 * RT_RS, RT_LG = 64 * RT_RS, RT_AB = RT_LG + 8 * 2048;
static_assert(RT_AB + 8192 <= LDSCTL_OFF, "router LDS");
__device__ __forceinline__ void p9_router(Frame& F, bool count = true) {
    LAS unsigned char* L = F.lds;
    {
        f32x4 wq[16];
#pragma unroll
        for (int it = 0; it < 16; ++it) wq[it] = *(const f32x4*)(F.in[I_WRT] + 4 * (F.tid + 512 * it));
#pragma unroll
        for (int it = 0; it < 16; ++it) { const int idx = 4 * (F.tid + 512 * it), k = idx >> 5, e0 = idx & 31;
#pragma unroll
            for (int q = 0; q < 4; ++q) { const float wv = wq[it][q]; const unsigned hi = f2bf(wv); const unsigned lo = f2bf(wv - bf2f(hi));
                *(LAS bf16*)(L + RT_WH + (e0 + q) * RT_RS + 2 * k) = (bf16)hi; *(LAS bf16*)(L + RT_WL + (e0 + q) * RT_RS + 2 * k) = (bf16)lo; } } }
    if (F.tid < 32) F.LC[LC_HIST + F.tid] = 0u;
    __syncthreads();
    const int gw = F.vcu * NWAVES + F.wave, NGW = F.G * NWAVES, lane = F.lane, fr = lane & 15, fq = lane >> 4;
    const float* mod = (const float*)(F.ws + WS_MOD);
    unsigned char* H8 = F.ws + WS_H8; int* toke = (int*)(F.ws + WS_TOKE); float* tokw = (float*)(F.ws + WS_TOKW);
    LAS float* LG = (LAS float*)(L + RT_LG + F.wave * 2048);
    LAS float* AB = (LAS float*)(L + RT_AB);
    int staged = -1;
    for (int g = gw; g < NTOK / 16; g += NGW) {
        const int row = 16 * g + fr; const bf16* xr = (const bf16*)(F.ws + WS_XM) + (size_t)row * 1024 + 8 * fq;
        { const int bt = (16 * (g - F.wave)) >> 11;
          if (bt != staged) { __syncthreads();
              const float* mbb = mod + (size_t)bt * 6144; const int c = 4 * (F.tid & 255);
              if (F.tid < 256) { const f32x4 w4 = *(const f32x4*)(F.in[I_NFFN] + c), s4 = *(const f32x4*)(mbb + 4096 + c); *(LAS f32x4*)(AB + c) = w4 * (s4 + 1.f); }
              else *(LAS f32x4*)(AB + 1024 + c) = *(const f32x4*)(mbb + 3072 + c);
              __syncthreads(); staged = bt; } }
        float ss = 0.f;
#pragma unroll 8
        for (int s = 0; s < 32; ++s) { float a[8]; pg8::unpack8(*(const pg8::u32x4*)(xr + 32 * s), a);
            ss += (a[0] * a[0] + a[1] * a[1]) + (a[2] * a[2] + a[3] * a[3]) + (a[4] * a[4] + a[5] * a[5]) + (a[6] * a[6] + a[7] * a[7]); }
        ss += __shfl_xor(ss, 16); ss += __shfl_xor(ss, 32);
        const float rs = __builtin_amdgcn_rsqf(ss * (1.f / 1024.f) + EPS);
        f32x4 acc0 = (f32x4){0.f, 0.f, 0.f, 0.f}, acc1 = (f32x4){0.f, 0.f, 0.f, 0.f};
#pragma unroll 4
        for (int s = 0; s < 32; ++s) {
            float x[8];
            pg8::unpack8(*(const pg8::u32x4*)(xr + 32 * s), x);
            const LAS float* ap = AB + 32 * s + 8 * fq;
            const f32x4 a0 = *(const LAS f32x4*)ap, a1 = *(const LAS f32x4*)(ap + 4), b0 = *(const LAS f32x4*)(ap + 1024), b1 = *(const LAS f32x4*)(ap + 1028);
            unsigned hi[8], lo[8]; float hv[8];
#pragma unroll
            for (int q = 0; q < 8; ++q) { const float h = (x[q] * rs) * (q < 4 ? a0[q & 3] : a1[q & 3]) + (q < 4 ? b0[q & 3] : b1[q & 3]); hv[q] = h; hi[q] = f2bf(h); lo[q] = f2bf(h - bf2f(hi[q])); }
            v4u ah, al;
#pragma unroll
            for (int q = 0; q < 4; ++q) { ah[q] = hi[2 * q] | (hi[2 * q + 1] << 16); al[q] = lo[2 * q] | (lo[2 * q + 1] << 16); }
            { int w0 = 0, w1 = 0;
              w0 = __builtin_amdgcn_cvt_pk_fp8_f32(hv[0], hv[1], w0, false); w0 = __builtin_amdgcn_cvt_pk_fp8_f32(hv[2], hv[3], w0, true);
              w1 = __builtin_amdgcn_cvt_pk_fp8_f32(hv[4], hv[5], w1, false); w1 = __builtin_amdgcn_cvt_pk_fp8_f32(hv[6], hv[7], w1, true);
              *(v2u*)(H8 + (size_t)row * 1024 + 32 * s + 8 * fq) = (v2u){(unsigned)w0, (unsigned)w1}; }
            const bf16x8 AH = __builtin_bit_cast(bf16x8, ah), AL = __builtin_bit_cast(bf16x8, al);
            const int bo = fr * RT_RS + (32 * s + 8 * fq) * 2;
            const bf16x8 BH0 = *(const LAS bf16x8*)(L + RT_WH + bo), BH1 = *(const LAS bf16x8*)(L + RT_WH + 16 * RT_RS + bo);
            const bf16x8 BL0 = *(const LAS bf16x8*)(L + RT_WL + bo), BL1 = *(const LAS bf16x8*)(L + RT_WL + 16 * RT_RS + bo);
            acc0 = mfma16(AH, BH0, acc0); acc1 = mfma16(AH, BH1, acc1);
            acc0 = mfma16(AH, BL0, acc0); acc1 = mfma16(AH, BL1, acc1);
            acc0 = mfma16(AL, BH0, acc0); acc1 = mfma16(AL, BH1, acc1);
        }
#pragma unroll
        for (int r = 0; r < 4; ++r) { LG[(4 * fq + r) * 32 + fr] = acc0[r]; LG[(4 * fq + r) * 32 + 16 + fr] = acc1[r]; }
        LDS_WAIT(); asm volatile("" ::: "memory");
        if (lane < 16) {
            float lg[32];
#pragma unroll
            for (int q = 0; q < 8; ++q) { const f32x4 v = *(const LAS f32x4*)(LG + lane * 32 + 4 * q); const f32x4 bb = *(const f32x4*)(F.in[I_BRT] + 4 * q);
                lg[4 * q] = v.x + bb.x; lg[4 * q + 1] = v.y + bb.y; lg[4 * q + 2] = v.z + bb.z; lg[4 * q + 3] = v.w + bb.w; }
            int bi[4]; float bv[4];
#pragma unroll
            for (int k = 0; k < 4; ++k) { float best = -3.0e38f; int bidx = 0;
#pragma unroll
                for (int e = 0; e < 32; ++e) { if (lg[e] > best) { best = lg[e]; bidx = e; } }
#pragma unroll
                for (int e = 0; e < 32; ++e) lg[e] = (e == bidx) ? -3.4e38f : lg[e];
                bi[k] = bidx; bv[k] = best; }
            const float e1 = __expf(bv[1] - bv[0]), e2 = __expf(bv[2] - bv[0]), e3 = __expf(bv[3] - bv[0]); const float inv = 1.f / (1.f + e1 + e2 + e3);
            const int orow = 16 * g + lane;
            *(int4*)(toke + (size_t)orow * 4) = make_int4(bi[0], bi[1], bi[2], bi[3]); *(f32x4*)(tokw + (size_t)orow * 4) = (f32x4){inv, e1 * inv, e2 * inv, e3 * inv};
#pragma unroll
            for (int k = 0; k < 4; ++k) __hip_atomic_fetch_add((LAS unsigned*)&F.LC[LC_HIST + bi[k]], 1u, __ATOMIC_RELAXED, __HIP_MEMORY_SCOPE_WORKGROUP);
        }
        LDS_WAIT(); asm volatile("" ::: "memory");
    }
    __syncthreads();
    if (F.tid < 32 && count) atomicAdd(F.ctl + CW_CNT + F.tid, (unsigned)F.LC[LC_HIST + F.tid]);
    __syncthreads();
}

__device__ __forceinline__ int moe_offsets(Frame& F) {
    __syncthreads();
    if (F.tid < 64) {
        const unsigned c = (F.tid < 32) ? __hip_atomic_load(F.ctl + CW_CNT + F.tid, __ATOMIC_RELAXED, __HIP_MEMORY_SCOPE_AGENT) : 0u; const unsigned nt = (c + 255u) >> 8;
        unsigned incl = nt;
#pragma unroll
        for (int o = 1; o < 32; o <<= 1) { const unsigned tv = __shfl_up(incl, o); if (F.lane >= o) incl += tv; }
        if (F.tid < 32) F.LC[LC_OFF + F.tid] = (incl - nt) << 8;
        if (F.tid == 31) F.LC[LC_OFF + 32] = incl << 8;
    }
    __syncthreads();
    const int total = (int)(F.LC[LC_OFF + 32] >> 8);
    for (int t = F.tid; t < total; t += 512) { unsigned e = 0;
#pragma unroll
        for (int j = 1; j < 32; ++j) e += (F.LC[LC_OFF + j] <= (unsigned)(t * 256)) ? 1u : 0u;
        F.LC[LC_T2E + t] = e; }
    __syncthreads();
    return total;
}

__device__ __forceinline__ void p10_scatter(Frame& F, int cw_cur = CW_CUR) {
    (void)moe_offsets(F);
    const int* toke = (const int*)(F.ws + WS_TOKE); const float* tokw = (const float*)(F.ws + WS_TOKW);
    int* pairpos = (int*)(F.ws + WS_PAIRPOS); int* rowtok = (int*)(F.ws + WS_ROWTOK); float* roww = (float*)(F.ws + WS_ROWW);
    for (int chunk = blockIdx.x; chunk < 256; chunk += F.G) {
        if (F.tid < 32) F.LC[LC_LCNT + F.tid] = 0u;
        __syncthreads();
        const int tok = chunk * 128 + (F.tid >> 2), k = F.tid & 3;
        const int e = toke[(size_t)tok * 4 + k];
        const unsigned lrank = __hip_atomic_fetch_add((LAS unsigned*)&F.LC[LC_LCNT + e], 1u, __ATOMIC_RELAXED, __HIP_MEMORY_SCOPE_WORKGROUP);
        __syncthreads();
        if (F.tid < 32) F.LC[LC_BASE + F.tid] = atomicAdd(F.ctl + cw_cur + F.tid, (unsigned)F.LC[LC_LCNT + F.tid]);
        __syncthreads();
        const int pos = (int)(F.LC[LC_OFF + e] + F.LC[LC_BASE + e] + lrank);
        rowtok[pos] = tok; roww[pos] = tokw[(size_t)tok * 4 + k]; pairpos[(size_t)tok * 4 + k] = pos;
        __syncthreads();
    }
}

__device__ __forceinline__ void p13_final(Frame& F, float* dst) {
    const int gw = F.vcu * NWAVES + F.wave, NGW = F.G * NWAVES, lane = F.lane;
    const float* mod = (const float*)(F.ws + WS_MOD); const int* pairpos = (const int*)(F.ws + WS_PAIRPOS); const unsigned char* Y = F.ws + WS_Y;
    typedef float f32x2_ __attribute__((ext_vector_type(2)));
    f32x4 nf[2][2];
#pragma unroll
    for (int j = 0; j < 2; ++j) { nf[j][0] = *(const f32x4*)(F.in[I_NFIN] + 8 * lane + 512 * j); nf[j][1] = *(const f32x4*)(F.in[I_NFIN] + 8 * lane + 512 * j + 4); }
    for (int row0 = 2 * gw; row0 < NTOK; row0 += 2 * NGW) {
        f32x4 v[2][2][2]; v2u yv[2][2][4]; f32x4 g2v[2][2][2];
#pragma unroll
        for (int rr = 0; rr < 2; ++rr) { const int row = row0 + rr; const bf16* xr = (const bf16*)(F.ws + WS_XM) + (size_t)row * 1024; const float* g2 = mod + (size_t)(row >> 11) * 6144 + 5120;
            const int4 pp = *(const int4*)(pairpos + (size_t)row * 4);
#pragma unroll
            for (int j = 0; j < 2; ++j) { const int col = 8 * lane + 512 * j;
                { float xf[8]; pg8::unpack8(*(const pg8::u32x4*)(xr + col), xf); v[rr][j][0] = (f32x4){xf[0], xf[1], xf[2], xf[3]}; v[rr][j][1] = (f32x4){xf[4], xf[5], xf[6], xf[7]}; }
                g2v[rr][j][0] = *(const f32x4*)(g2 + col); g2v[rr][j][1] = *(const f32x4*)(g2 + col + 4);
                yv[rr][j][0] = *(const v2u*)(Y + (size_t)pp.x * 1024 + col); yv[rr][j][1] = *(const v2u*)(Y + (size_t)pp.y * 1024 + col);
                yv[rr][j][2] = *(const v2u*)(Y + (size_t)pp.z * 1024 + col); yv[rr][j][3] = *(const v2u*)(Y + (size_t)pp.w * 1024 + col); } }
#pragma unroll
        for (int rr = 0; rr < 2; ++rr) { float* xr = dst + (size_t)(row0 + rr) * 1024; float ss = 0.f;
#pragma unroll
            for (int j = 0; j < 2; ++j) { float m8[8];
#pragma unroll
                for (int q = 0; q < 8; ++q) m8[q] = 0.f;
#pragma unroll
                for (int k = 0; k < 4; ++k)
#pragma unroll
                    for (int d2 = 0; d2 < 2; ++d2) { const int wd = (int)yv[rr][j][k][d2];
                        const f32x2_ lo = __builtin_amdgcn_cvt_pk_f32_fp8(wd, false), hi = __builtin_amdgcn_cvt_pk_f32_fp8(wd, true);
                        m8[4 * d2] += lo[0]; m8[4 * d2 + 1] += lo[1]; m8[4 * d2 + 2] += hi[0]; m8[4 * d2 + 3] += hi[1]; }
#pragma unroll
                for (int q = 0; q < 8; ++q) { const float x = v[rr][j][q >> 2][q & 3] + g2v[rr][j][q >> 2][q & 3] * (m8[q] * pg8::YSCALE_INV); v[rr][j][q >> 2][q & 3] = x; ss += x * x; } }
            const float rs = __builtin_amdgcn_rsqf(wave_sum(ss) * (1.f / 1024.f) + EPS);
#pragma unroll
            for (int j = 0; j < 2; ++j) { const int col = 8 * lane + 512 * j; *(f32x4*)(xr + col) = (v[rr][j][0] * rs) * nf[j][0]; *(f32x4*)(xr + col + 4) = (v[rr][j][1] * rs) * nf[j][1]; } }
    }
}

constexpr int N_PHASES = 14;
struct Args { const float* in[35]; float* out; unsigned char* ws; int ph_lo, ph_hi, flags, pad; };
__global__ void __launch_bounds__(NWAVES * 64, 2) fwd(Args args) {
    extern __shared__ __attribute__((aligned(16))) unsigned char lds[];
    Frame F;
    F.lds = (LAS unsigned char*)lds;
    F.LC = (volatile LAS unsigned*)(F.lds + LDSCTL_OFF);
    F.tid = threadIdx.x; F.lane = F.tid & 63; F.wave = __builtin_amdgcn_readfirstlane(F.tid >> 6);
    F.G = gridDim.x; { const int bx = blockIdx.x; F.vcu = (F.G % 8 == 0) ? (bx % 8) * (F.G / 8) + bx / 8 : bx; }
    F.ws = args.ws; F.out = args.out; F.ctl = (unsigned*)(args.ws + WS_CTL);
#pragma unroll
    for (int i = 0; i < 35; ++i) F.in[i] = args.in[i];
    for (int u = F.tid; u < (LDS_BYTES - LDSCTL_OFF) / 4; u += NWAVES * 64) ((LAS unsigned*)(F.lds + LDSCTL_OFF))[u] = 0u;
    __syncthreads();
    const int lo = args.ph_lo, hi = args.ph_hi;
    XcdBarrier bar; bar.bar = F.ctl + CW_BAR; bar.x = 0; bar.st = nullptr;
    if (hi - lo > 1) bar = xcd_barrier_post(F.ctl + CW_BAR, F.LC + LC_BAR);
#define IN(k) (lo <= (k) && (k) < hi)
#define REP(k) _Pragma("unroll") for (int rep_ = 0; rep_ < (((k) == PROBE_PHASE) ? 2 : 1); ++rep_)
#define SEAM(k) do { if (IN(k) && IN((k) + 1)) xcd_barrier(bar); } while (0)
    unsigned char* ws = args.ws;
    LAS unsigned char* ring = F.lds;

    if (IN(0)) REP(0) { p0_prologue(F); } SEAM(0);
    if (IN(1)) REP(1) { p1_norm(F); } SEAM(1);
    if (PROBE_PHASE == 99) { _Pragma("nounroll") for (int r_ = 0; r_ < 10; ++r_) xcd_barrier(bar); }
    if (IN(2)) REP(2) {
        pg8::Sched1 S{(const char*)(ws + WS_HX), (const char*)(ws + WS_WB1), F.G, (int)blockIdx.x};
        pg8::Epi1 E{(bf16*)(ws + WS_KB), (bf16*)(ws + WS_VB), (bf16*)(ws + WS_QB), (bf16*)(ws + WS_OG), (bf16*)(ws + WS_HY), (bf16*)(ws + WS_MA), (bf16*)(ws + WS_MB), (float*)(ws + WS_RF)};
        pg8::gemm_phase<pg8::Epi1, pg8::Sched1, false, true>(ring, 1024, S, E);
        pg8::SchedG8 S8{(const char*)(ws + WS_HX8), (const char*)(ws + WS_WB8), F.G, (int)blockIdx.x};
        pg8::EpiG8 E8{ws + WS_OG, (bf16*)(ws + WS_MA), (bf16*)(ws + WS_MB), (bf16*)(ws + WS_HY), ws + WS_VB, (bf16*)(ws + WS_KB), (bf16*)(ws + WS_QB)};
        pg8::gemm_phase<pg8::EpiG8, pg8::SchedG8, true, true, true>(ring, 512, S8, E8);
    } SEAM(2);
    if (IN(3)) { REP(30) { gla_prep(F); } REP(31) { hy_prep(F); } } SEAM(3);
    if (IN(4)) {
        const bool cfirst = ((blockIdx.x >> 4) & 1) != 0;
        if (cfirst) { REP(4) { hy_conv(F); } }
        REP(40) { for (int ub = blockIdx.x; ub < 256; ub += F.G) {
            const int u = ((((ub >> 4) << 3) | (ub & 7)) << 1) | ((ub >> 3) & 1); gla_scan(F, u); } }
        if (!cfirst) { REP(4) { hy_conv(F); } } } SEAM(4);
    if (IN(5)) REP(5) { p5_post(F); } SEAM(5);
    if (IN(6)) REP(6) {
        pg8::SchedPair S{(const char*)ws, (const char*)ws, (unsigned)WS_GA, (unsigned)WS_YH, (unsigned)WS_WG, (unsigned)WS_WH, 128, 4, F.G, (int)blockIdx.x};
        pg8::EpiMix E{(const bf16*)(ws + WS_MA), (const bf16*)(ws + WS_MB), (bf16*)(ws + WS_YM)};
        pg8::gemm_phase<pg8::EpiMix, pg8::SchedPair, true, true>(ring, 1024, S, E);
    }
    SEAM(7);
    if (IN(8)) REP(8) {
        pg8::SchedStd S{(const char*)(ws + WS_YM), (const char*)(ws + WS_WO), 128, 4, F.G, (int)blockIdx.x};
        pg8::EpiRes E{F.in[I_X], (const float*)(ws + WS_MOD), (bf16*)(ws + WS_XM)};
        pg8::gemm_phase<pg8::EpiRes, pg8::SchedStd, true, true>(ring, 1024, S, E);
    } SEAM(8);
    if (IN(9)) {
REP(90) { p_expert_weights(F); } p9_router(F, args.flags == 0); } SEAM(9);
    if (IN(10)) {
_Pragma("nounroll") for (int rep_ = (PROBE_PHASE == 10 ? 0 : 1); rep_ < 2; ++rep_) { p10_scatter(F, rep_ == 1 ? CW_CUR : CW_CUR + 64); if (rep_ == 0) xcd_barrier(bar); } } SEAM(10);
    if (IN(11)) REP(11) {
        const int nt = moe_offsets(F);
        pg8::SchedMoEG S{(const char*)(ws + WS_H8), (const char*)(ws + WS_WUP), nt, 8, F.G, (int)blockIdx.x, 2048u * 1024u, (const volatile LAS unsigned*)(F.LC + LC_T2E), (const int*)(ws + WS_ROWTOK)};
        pg8::EpiUp E{F.in[I_BUP], ws + WS_ACT, ring};
        pg8::gemm_phase<pg8::EpiUp, pg8::SchedMoEG, true, true, true>(ring, 512, S, E);
    } SEAM(11);
    if (IN(12)) REP(12) {
        const int nt = moe_offsets(F);
        pg8::SchedMoE S{(const char*)(ws + WS_ACT), (const char*)(ws + WS_WDN), nt, 4, F.G, (int)blockIdx.x, 1024u * 1024u, (const volatile LAS unsigned*)(F.LC + LC_T2E), nullptr};
        pg8::EpiDown E{F.in[I_BDN], (const float*)(ws + WS_ROWW), ws + WS_Y, ring};
        pg8::gemm_phase<pg8::EpiDown, pg8::SchedMoE, true, true, true>(ring, 512, S, E);
    } SEAM(12);
    if (IN(13)) {
_Pragma("nounroll") for (int rep_ = (PROBE_PHASE == 13 ? 0 : 1); rep_ < 2; ++rep_) p13_final(F, rep_ == 1 ? F.out : (float*)(ws + WS_ACT)); }
#undef IN
#undef REP
#undef SEAM
}

extern "C" void kernel_launch(void* const* d_in, const int* in_sizes, int n_in, void* d_out, int out_size, void* d_ws, size_t ws_size, hipStream_t stream) {
    static int grid = 0;
    if (grid == 0) {
        if (n_in != 35 || in_sizes[0] != NTOK * D || out_size != NTOK * D || ws_size < WS_END) {
            fprintf(stderr, "kernel_launch: unexpected shapes (n_in %d, in0 %d, out %d, ws %zu < %zu); nothing launched\n", n_in, n_in > 0 ? in_sizes[0] : -1, out_size, ws_size, (size_t)WS_END); grid = -1; return; }
        int dev = 0, cus = 0, per_cu = 0;
        if (hipGetDevice(&dev) != hipSuccess || hipDeviceGetAttribute(&cus, hipDeviceAttributeMultiprocessorCount, dev) != hipSuccess) { grid = -1; return; }
        if (hipFuncSetAttribute((const void*)fwd, hipFuncAttributeMaxDynamicSharedMemorySize, LDS_BYTES) != hipSuccess) { fprintf(stderr, "kernel_launch: hipFuncSetAttribute failed\n"); grid = -1; return; }
        if (hipOccupancyMaxActiveBlocksPerMultiprocessor(&per_cu, (const void*)fwd, NWAVES * 64, LDS_BYTES) != hipSuccess || per_cu < 1)
            fprintf(stderr, "kernel_launch: note: occupancy query reports %d workgroups per CU\n", per_cu);
        (void)hipGetLastError();
        grid = cus;
    }
    if (grid < 0) return;
    if (hipMemsetAsync((char*)d_ws + WS_CTL, 0, CTL_ZERO_BYTES, stream) != hipSuccess) return;
    Args a{};
    for (int i = 0; i < 35; ++i) a.in[i] = (const float*)d_in[i];
    a.out = (float*)d_out; a.ws = (unsigned char*)d_ws;
#if MK_N_LAUNCHES == 1
    a.ph_lo = 0; a.ph_hi = N_PHASES;
    hipLaunchKernelGGL(fwd, dim3(grid), dim3(NWAVES * 64), LDS_BYTES, stream, a);
#else
    for (int k = 0; k < N_PHASES; ++k) { a.ph_lo = k; a.ph_hi = k + 1;
        if (k == PROBE_PHASE && k == 9) { a.flags = 1; hipLaunchKernelGGL(fwd, dim3(grid), dim3(NWAVES * 64), LDS_BYTES, stream, a); a.flags = 0; }
        hipLaunchKernelGGL(fwd, dim3(grid), dim3(NWAVES * 64), LDS_BYTES, stream, a); }
#endif
}
```
